# Optimizing an MI355X kernel written in HIP

```python
import jax, jax.numpy as jnp
from jax import lax
import numpy as np

D_MODEL = 1024
BATCH = 8
SEQ = 4096
DEPTH = 4

HEAD_DIM = 64
Q_BLOCK = 128
ROPE_THETA = 10000.0
H_A = D_MODEL // (2 * HEAD_DIM)
MOBA_BLOCK = 256
MOBA_TOPK = 3
MOBA_QCHUNK = 16
H_B = D_MODEL // (2 * HEAD_DIM)
MLA_NOPE = 64
MLA_ROPE = 32
MLA_V = 64
MLA_Q_LORA = D_MODEL // 4
MLA_KV_LORA = D_MODEL // 8
H_C = D_MODEL // (2 * HEAD_DIM)
H_C_KV = H_C // 4
SWA_WINDOW = 128
H_D = D_MODEL // (4 * HEAD_DIM)
N_EXPERTS = 64
N_GROUPS = 8
TOPK_GROUPS = 4
TOP_K = 8
D_EXPERT = D_MODEL // 4
D_SHARED = D_EXPERT
ROUTED_SCALE = 2.5
EXPERT_BLOCK = 128
N_EVEN = (DEPTH + 1) // 2
N_ODD = DEPTH // 2
DN_ALPHA = (2 * DEPTH) ** 0.25
DN_BETA = (8 * DEPTH) ** -0.25
EV_SPLITS = (H_A * HEAD_DIM, H_A * HEAD_DIM, H_A * HEAD_DIM, MLA_Q_LORA, MLA_KV_LORA, MLA_ROPE)
OD_SPLITS = (H_C * HEAD_DIM, H_C_KV * HEAD_DIM, H_C_KV * HEAD_DIM,
             2 * H_D * HEAD_DIM, 2 * H_D * HEAD_DIM, 2 * H_D * HEAD_DIM)
EV_IN = sum(EV_SPLITS)
OD_IN = sum(OD_SPLITS)
EV_MIX = H_A * HEAD_DIM + H_B * MLA_V
OD_MIX = H_C * HEAD_DIM + H_D * 2 * HEAD_DIM

kernel_name = 'hybrid_moba_mla_swa_diff_moe_deepnorm'

F32 = jnp.float32


def _split(h, widths):
    return jnp.split(h, [int(i) for i in np.cumsum(widths)[:-1]], axis=-1)


def layer_norm(x, g, b, eps=1e-5):
    xf = x.astype(F32)
    mu = jnp.mean(xf, -1, keepdims=True)
    var = jnp.mean(jnp.square(xf - mu), -1, keepdims=True)
    return ((xf - mu) * lax.rsqrt(var + eps) * g + b).astype(x.dtype)


def rms_norm(x, g, eps=1e-6):
    xf = x.astype(F32)
    return (xf * lax.rsqrt(jnp.mean(jnp.square(xf), -1, keepdims=True) + eps) * g).astype(x.dtype)


def rope(x, positions):
    d = x.shape[-1]
    inv = ROPE_THETA ** (-jnp.arange(0, d, 2, dtype=F32) / d)
    ang = positions.astype(F32)[..., None] * inv
    cos, sin = jnp.cos(ang)[:, :, None, :], jnp.sin(ang)[:, :, None, :]
    x1, x2 = jnp.split(x.astype(F32), 2, axis=-1)
    return jnp.concatenate([x1 * cos - x2 * sin, x2 * cos + x1 * sin], -1).astype(x.dtype)


def _heads(t, h):
    b, s = t.shape[:2]
    return t.reshape(b, s, h, -1).transpose(0, 2, 1, 3)


def _merge(o):
    b, h, s, d = o.shape
    return o.transpose(0, 2, 1, 3).reshape(b, s, h * d)


def _map_query_blocks(fn, qs, block):
    b, h, s = qs[0].shape[:3]
    nq = s // block
    xs = tuple(jnp.moveaxis(q.reshape(b, h, nq, block, q.shape[-1]), 2, 0) for q in qs)
    out = lax.map(lambda a: fn(a[0] * block, *a[1:]), (jnp.arange(nq, dtype=jnp.int32),) + xs)
    return jnp.moveaxis(out, 0, 2).reshape(b, h, s, out.shape[-1])


def causal_attention(q, k, v, scale):
    k_pos = jnp.arange(k.shape[2])

    def blk(start, qb):
        q_pos = start + jnp.arange(Q_BLOCK)
        logits = jnp.einsum('bhqd,bhkd->bhqk', qb, k, preferred_element_type=F32) * scale
        logits = jnp.where(k_pos[None, :] <= q_pos[:, None], logits, -jnp.inf)
        p = jax.nn.softmax(logits, axis=-1).astype(v.dtype)
        return jnp.einsum('bhqk,bhkd->bhqd', p, v)

    return _map_query_blocks(blk, (q,), Q_BLOCK)


def moba_attention(q, k, v):
    b, h, s, d = q.shape
    nb = -(-s // MOBA_BLOCK)
    pad = nb * MOBA_BLOCK - s
    kb = jnp.pad(k, ((0, 0), (0, 0), (0, pad), (0, 0))).reshape(b, h, nb, MOBA_BLOCK, d)
    vb = jnp.pad(v, ((0, 0), (0, 0), (0, pad), (0, 0))).reshape(b, h, nb, MOBA_BLOCK, d)
    k_mean = jnp.mean(kb.astype(F32), axis=3)
    gate = jnp.einsum('bhsd,bhnd->bhsn', q.astype(F32), k_mean)
    q_blk = jnp.arange(s) // MOBA_BLOCK
    past = jnp.arange(nb)[None, :] < q_blk[:, None]
    gate = jnp.where(past, gate, -jnp.inf)
    n_sel = min(MOBA_TOPK, nb)
    _, sel = lax.top_k(gate, n_sel)
    bi = jnp.arange(b)[:, None, None, None]
    hi = jnp.arange(h)[None, :, None, None]
    scale = d ** -0.5

    def blk(start, qc, sc):
        qblk = start // MOBA_BLOCK
        q_pos = start + jnp.arange(MOBA_QCHUNK)
        k_sel = kb[bi, hi, sc]
        v_sel = vb[bi, hi, sc]
        l_sel = jnp.einsum('bhqd,bhqnkd->bhqnk', qc, k_sel, preferred_element_type=F32) * scale
        l_sel = jnp.where((jnp.arange(n_sel) < qblk)[:, None], l_sel, -jnp.inf)
        k_own = lax.dynamic_index_in_dim(kb, qblk, axis=2, keepdims=False)
        v_own = lax.dynamic_index_in_dim(vb, qblk, axis=2, keepdims=False)
        l_own = jnp.einsum('bhqd,bhkd->bhqk', qc, k_own, preferred_element_type=F32) * scale
        own_pos = qblk * MOBA_BLOCK + jnp.arange(MOBA_BLOCK)
        l_own = jnp.where(own_pos[None, :] <= q_pos[:, None], l_own, -jnp.inf)
        logits = jnp.concatenate([l_sel.reshape(b, h, MOBA_QCHUNK, n_sel * MOBA_BLOCK), l_own], -1)
        p = jax.nn.softmax(logits, axis=-1).astype(v.dtype)
        p_sel = p[..., :n_sel * MOBA_BLOCK].reshape(b, h, MOBA_QCHUNK, n_sel, MOBA_BLOCK)
        p_own = p[..., n_sel * MOBA_BLOCK:]
        return (jnp.einsum('bhqnk,bhqnkd->bhqd', p_sel, v_sel)
                + jnp.einsum('bhqk,bhkd->bhqd', p_own, v_own))

    return _map_query_blocks(blk, (q, sel), MOBA_QCHUNK)


def swa_sinks_attention(q, k, v, sinks):
    b, hq, s, d = q.shape
    hkv = k.shape[1]
    g = hq // hkv
    w = SWA_WINDOW
    nb = s // w
    qb = q.reshape(b, hkv, g, nb, w, d)

    def band(t):
        tb = t.reshape(b, hkv, nb, w, d)
        prev = jnp.pad(tb, ((0, 0), (0, 0), (1, 0), (0, 0), (0, 0)))[:, :, :-1]
        return jnp.concatenate([prev, tb], axis=3)

    kk, vv = band(k), band(v)
    logits = jnp.einsum('bhgnqd,bhnkd->bhgnqk', qb, kk, preferred_element_type=F32) * d ** -0.5
    k_off = jnp.arange(2 * w) - w
    rel = jnp.arange(w)[:, None] - k_off[None, :]
    key_abs = jnp.arange(nb)[:, None, None] * w + k_off[None, None, :]
    mask = (rel >= 0) & (rel < SWA_WINDOW) & (key_abs >= 0)
    logits = jnp.where(mask, logits, -jnp.inf)
    sink = jnp.broadcast_to(sinks.astype(F32).reshape(hkv, g)[None, :, :, None, None, None],
                            logits.shape[:-1] + (1,))
    p = jax.nn.softmax(jnp.concatenate([logits, sink], -1), axis=-1)[..., :-1].astype(v.dtype)
    out = jnp.einsum('bhgnqk,bhnkd->bhgnqd', p, vv)
    return out.reshape(b, hq, s, d)


def diff_attention(q1, q2, k1, k2, v, lam, scale):
    k_pos = jnp.arange(k1.shape[2])

    def blk(start, q1b, q2b):
        q_pos = start + jnp.arange(Q_BLOCK)
        causal = k_pos[None, :] <= q_pos[:, None]
        l1 = jnp.einsum('bhqd,bhkd->bhqk', q1b, k1, preferred_element_type=F32) * scale
        l2 = jnp.einsum('bhqd,bhkd->bhqk', q2b, k2, preferred_element_type=F32) * scale
        p = (jax.nn.softmax(jnp.where(causal, l1, -jnp.inf), axis=-1)
             - lam * jax.nn.softmax(jnp.where(causal, l2, -jnp.inf), axis=-1))
        return jnp.einsum('bhqk,bhkd->bhqd', p.astype(v.dtype), v)

    return _map_query_blocks(blk, (q1, q2), Q_BLOCK)


def even_mixer(x, positions, w_in, w_out, g_qa, w_qb, g_kva, w_kvb):
    b, s, _ = x.shape
    h = x @ w_in
    qa, ka, va, q_lat, kv_lat, k_pe = _split(h, EV_SPLITS)
    qa = rope(qa.reshape(b, s, H_A, HEAD_DIM), positions).transpose(0, 2, 1, 3)
    ka = rope(ka.reshape(b, s, H_A, HEAD_DIM), positions).transpose(0, 2, 1, 3)
    o_a = moba_attention(qa, ka, _heads(va, H_A))
    q = (rms_norm(q_lat, g_qa) @ w_qb).reshape(b, s, H_B, MLA_NOPE + MLA_ROPE)
    q_nope, q_pe = jnp.split(q, [MLA_NOPE], axis=-1)
    kv = (rms_norm(kv_lat, g_kva) @ w_kvb).reshape(b, s, H_B, MLA_NOPE + MLA_V)
    k_nope, v_b = jnp.split(kv, [MLA_NOPE], axis=-1)
    k_pe = rope(k_pe[:, :, None, :], positions)
    q_b = jnp.concatenate([q_nope, rope(q_pe, positions)], -1)
    k_b = jnp.concatenate([k_nope, jnp.broadcast_to(k_pe, (b, s, H_B, MLA_ROPE))], -1)
    o_b = causal_attention(q_b.transpose(0, 2, 1, 3), k_b.transpose(0, 2, 1, 3),
                           v_b.transpose(0, 2, 1, 3), (MLA_NOPE + MLA_ROPE) ** -0.5)
    return jnp.concatenate([_merge(o_a), _merge(o_b)], -1) @ w_out


def odd_mixer(x, positions, w_in, w_out, sinks, lam_p, g_subln, lambda_init):
    b, s, _ = x.shape
    h = x @ w_in
    qc, kc, vc, qd, kd, vd = _split(h, OD_SPLITS)
    qc = rope(qc.reshape(b, s, H_C, HEAD_DIM), positions).transpose(0, 2, 1, 3)
    kc = rope(kc.reshape(b, s, H_C_KV, HEAD_DIM), positions).transpose(0, 2, 1, 3)
    o_c = swa_sinks_attention(qc, kc, _heads(vc, H_C_KV), sinks)
    qd = rope(qd.reshape(b, s, 2 * H_D, HEAD_DIM), positions).reshape(b, s, H_D, 2, HEAD_DIM)
    kd = rope(kd.reshape(b, s, 2 * H_D, HEAD_DIM), positions).reshape(b, s, H_D, 2, HEAD_DIM)
    lp = lam_p.astype(F32)
    lam = jnp.exp(jnp.sum(lp[0] * lp[1])) - jnp.exp(jnp.sum(lp[2] * lp[3])) + lambda_init
    t = lambda a: a.transpose(0, 2, 1, 3)
    o_d = diff_attention(t(qd[:, :, :, 0]), t(qd[:, :, :, 1]), t(kd[:, :, :, 0]), t(kd[:, :, :, 1]),
                         _heads(vd, H_D), lam, HEAD_DIM ** -0.5)
    o_d = rms_norm(o_d, g_subln, eps=1e-5) * (1.0 - lambda_init)
    return jnp.concatenate([_merge(o_c), _merge(o_d)], -1) @ w_out


def _swiglu(x, wg, wu, wd):
    return (jax.nn.silu(x @ wg) * (x @ wu)) @ wd


def routed_experts(xf, eidx, wts, w_gate, w_up, w_down):
    n, d = xf.shape
    a = n * TOP_K
    flat_e = eidx.reshape(-1)
    order = jnp.argsort(flat_e)
    sorted_e = flat_e[order]
    counts = jnp.bincount(flat_e, length=N_EXPERTS)
    padded = (counts + EXPERT_BLOCK - 1) // EXPERT_BLOCK * EXPERT_BLOCK
    start = jnp.cumsum(counts) - counts
    pend = jnp.cumsum(padded)
    pstart = pend - padded
    dest = pstart[sorted_e] + jnp.arange(a) - start[sorted_e]
    p_rows = (-(-a // EXPERT_BLOCK)) * EXPERT_BLOCK + N_EXPERTS * EXPERT_BLOCK
    nblk = p_rows // EXPERT_BLOCK
    tok = jnp.full((p_rows,), n, jnp.int32).at[dest].set((order // TOP_K).astype(jnp.int32))
    gate = jnp.zeros((p_rows,), xf.dtype).at[dest].set(wts.reshape(-1)[order].astype(xf.dtype))
    blk_expert = jnp.minimum(jnp.searchsorted(pend, jnp.arange(nblk) * EXPERT_BLOCK, side='right'),
                             N_EXPERTS - 1)
    xpad = jnp.concatenate([xf, jnp.zeros((1, d), xf.dtype)], 0)

    def one_block(args):
        t, g, e = args
        return _swiglu(xpad[t], w_gate[e], w_up[e], w_down[e]) * g[:, None]

    yb = lax.map(one_block, (tok.reshape(nblk, EXPERT_BLOCK), gate.reshape(nblk, EXPERT_BLOCK), blk_expert))
    y = jnp.zeros((n + 1, d), xf.dtype).at[tok].add(yb.reshape(p_rows, d))
    return y[:n]


def moe_ffn(x, w_router, e_bias, w_gate, w_up, w_down, ws_gate, ws_up, ws_down):
    b, s, d = x.shape
    xf = x.reshape(b * s, d)
    n = xf.shape[0]
    scores = jax.nn.sigmoid(jnp.einsum('nd,de->ne', xf, w_router, preferred_element_type=F32))
    biased = scores + e_bias.astype(F32)
    grp = biased.reshape(n, N_GROUPS, N_EXPERTS // N_GROUPS)
    grp_score = jnp.sum(lax.top_k(grp, 2)[0], -1)
    _, top_grp = lax.top_k(grp_score, TOPK_GROUPS)
    grp_ok = jnp.sum(jax.nn.one_hot(top_grp, N_GROUPS, dtype=F32), axis=1) > 0
    expert_ok = jnp.repeat(grp_ok, N_EXPERTS // N_GROUPS, axis=1)
    _, eidx = lax.top_k(jnp.where(expert_ok, biased, -jnp.inf), TOP_K)
    wts = jnp.take_along_axis(scores, eidx, axis=1)
    wts = wts / jnp.sum(wts, -1, keepdims=True) * ROUTED_SCALE
    y = routed_experts(xf, eidx, wts, w_gate, w_up, w_down) + _swiglu(xf, ws_gate, ws_up, ws_down)
    return y.reshape(b, s, d)


def setup_inputs(seed: int = 0) -> dict:
    key = jax.random.key(seed)
    ks = jax.random.split(key, 22)

    def nrm(k, shape, scale):
        return jax.random.normal(k, shape, F32) * scale

    return {
        'x': nrm(ks[0], (BATCH, SEQ, D_MODEL), 1.0),
        'positions': jnp.broadcast_to(jnp.arange(SEQ, dtype=jnp.int32), (BATCH, SEQ)),
        'ev_w_in': nrm(ks[1], (N_EVEN, D_MODEL, EV_IN), D_MODEL ** -0.5),
        'ev_w_out': nrm(ks[2], (N_EVEN, EV_MIX, D_MODEL), DN_BETA * EV_MIX ** -0.5),
        'mla_g_qa': 1.0 + nrm(ks[3], (N_EVEN, MLA_Q_LORA), 0.02),
        'mla_w_qb': nrm(ks[4], (N_EVEN, MLA_Q_LORA, H_B * (MLA_NOPE + MLA_ROPE)), MLA_Q_LORA ** -0.5),
        'mla_g_kva': 1.0 + nrm(ks[5], (N_EVEN, MLA_KV_LORA), 0.02),
        'mla_w_kvb': nrm(ks[6], (N_EVEN, MLA_KV_LORA, H_B * (MLA_NOPE + MLA_V)), MLA_KV_LORA ** -0.5),
        'od_w_in': nrm(ks[7], (N_ODD, D_MODEL, OD_IN), D_MODEL ** -0.5),
        'od_w_out': nrm(ks[8], (N_ODD, OD_MIX, D_MODEL), DN_BETA * OD_MIX ** -0.5),
        'swa_sinks': nrm(ks[9], (N_ODD, H_C), 0.5),
        'diff_lambda': nrm(ks[10], (N_ODD, 4, HEAD_DIM), 0.1),
        'diff_g_subln': 1.0 + nrm(ks[11], (N_ODD, 2 * HEAD_DIM), 0.02),
        'ln_g': 1.0 + nrm(ks[12], (DEPTH, 2, D_MODEL), 0.02),
        'ln_b': nrm(ks[13], (DEPTH, 2, D_MODEL), 0.02),
        'moe_w_router': nrm(ks[14], (DEPTH, D_MODEL, N_EXPERTS), D_MODEL ** -0.5),
        'moe_bias': nrm(ks[15], (DEPTH, N_EXPERTS), 0.01),
        'moe_w_gate': nrm(ks[16], (DEPTH, N_EXPERTS, D_MODEL, D_EXPERT), D_MODEL ** -0.5),
        'moe_w_up': nrm(ks[17], (DEPTH, N_EXPERTS, D_MODEL, D_EXPERT), D_MODEL ** -0.5),
        'moe_w_down': nrm(ks[18], (DEPTH, N_EXPERTS, D_EXPERT, D_MODEL), DN_BETA * D_EXPERT ** -0.5),
        'sh_w_gate': nrm(ks[19], (DEPTH, D_MODEL, D_SHARED), D_MODEL ** -0.5),
        'sh_w_up': nrm(ks[20], (DEPTH, D_MODEL, D_SHARED), D_MODEL ** -0.5),
        'sh_w_down': nrm(ks[21], (DEPTH, D_SHARED, D_MODEL), DN_BETA * D_SHARED ** -0.5),
    }


def reference(x, positions, ev_w_in, ev_w_out, mla_g_qa, mla_w_qb, mla_g_kva, mla_w_kvb,
              od_w_in, od_w_out, swa_sinks, diff_lambda, diff_g_subln, ln_g, ln_b,
              moe_w_router, moe_bias, moe_w_gate, moe_w_up, moe_w_down, sh_w_gate, sh_w_up, sh_w_down):
    for l in range(DEPTH):
        i = l // 2
        if l % 2 == 0:
            mix = even_mixer(x, positions, ev_w_in[i], ev_w_out[i], mla_g_qa[i], mla_w_qb[i],
                             mla_g_kva[i], mla_w_kvb[i])
        else:
            lambda_init = 0.8 - 0.6 * float(np.exp(-0.3 * l))
            mix = odd_mixer(x, positions, od_w_in[i], od_w_out[i], swa_sinks[i], diff_lambda[i],
                            diff_g_subln[i], lambda_init)
        x = layer_norm(DN_ALPHA * x + mix, ln_g[l, 0], ln_b[l, 0])
        ffn = moe_ffn(x, moe_w_router[l], moe_bias[l], moe_w_gate[l], moe_w_up[l], moe_w_down[l],
                      sh_w_gate[l], sh_w_up[l], sh_w_down[l])
        x = layer_norm(DN_ALPHA * x + ffn, ln_g[l, 1], ln_b[l, 1])
    return x
```

```cpp
#include <hip/hip_runtime.h>
#include <cstdio>
#include <cstdint>

#define GAS __attribute__((address_space(1)))
#define LAS __attribute__((address_space(3)))
typedef unsigned short bf16_t;
typedef short bf16x8 __attribute__((ext_vector_type(8)));
typedef short s16x4 __attribute__((ext_vector_type(4)));
typedef float f32x2 __attribute__((ext_vector_type(2)));
typedef float f32x4 __attribute__((ext_vector_type(4)));
typedef float f32x16 __attribute__((ext_vector_type(16)));
typedef unsigned u32x2 __attribute__((ext_vector_type(2)));
typedef unsigned u32x4 __attribute__((ext_vector_type(4)));

constexpr int NTOK = 32768, DM = 1024, SEQ = 4096, NBATCH = 8, DEPTH = 4;
constexpr int EV_IN = 1952, OD_IN = 2304, HB_LD = 2304;
constexpr int NE = 64, DE = 256, TOPK = 8, CAP = 32768;
constexpr int TR_MAX = 1088;
constexpr int SLOTS_R = TR_MAX * 256;
constexpr int SLOTS = SLOTS_R + NTOK;
constexpr float DN_ALPHA = 1.681792830507429f;
constexpr float LOG2E = 1.4426950408889634f;

__device__ __forceinline__ unsigned f2bf(float f) { unsigned u = __builtin_bit_cast(unsigned, f); return (u + 0x7fffu + ((u >> 16) & 1u)) >> 16; }
__device__ __forceinline__ float bf2f(unsigned b) { return __builtin_bit_cast(float, b << 16); }
__device__ __forceinline__ unsigned pk2(float lo, float hi) { return f2bf(lo) | (f2bf(hi) << 16); }
__device__ __forceinline__ float wave_sum(float v) {
#pragma unroll
    for (int o = 1; o < 64; o <<= 1) v += __shfl_xor(v, o);
    return v;
}
namespace pg8 {
constexpr int BM = 256, BK = 64, HALF = 128, HTB = HALF * BK * 2  , STAGE_BYTES = 8 * HTB, NXCD = 8, WGM = 8;
__host__ __device__ __forceinline__ int lds_byte(int r, int c) { const int st = (r >> 4) * 2 + (c >> 5), rr = r & 15, cc = c & 31, ob = rr * 64 + cc * 2; return st * 1024 + (ob ^ (((ob >> 9) & 1) << 5)); }
__host__ __device__ __forceinline__ void stage_rc(int b, int& R, int& C) { const int st = b / 1024, sb = b % 1024, swz = sb ^ (((sb >> 9) & 1) << 5); R = (st >> 1) * 16 + swz / 64; C = (st & 1) * 32 + (swz % 64) / 2; }
__host__ __device__ __forceinline__ int perm32(int rho) { const int n = rho >> 4, i = rho & 15; return 8 * (i >> 2) + 4 * n + (i & 3); }

struct Unit { int pm, pn, orow, ocol, e, lt; };
struct Gemm { const bf16_t* A; const bf16_t* Bt; int lda, K; };

struct StaticOrder {
    static constexpr bool GATHER = false;
    int nM, nN, nwg, G, c;
    __device__ void init(int M, int N, int G_, int c_) { nM = M / BM; nN = N / BM; nwg = nM * nN; G = G_; c = c_; }
    __device__ __forceinline__ bool next(int i, Unit& u) const {
        const long L = (long)i * G + c; if (L >= nwg) return false;
        int wgid = (int)L; { const int q = nwg / NXCD, r = nwg % NXCD, xcd = wgid % NXCD, off = wgid / NXCD; wgid = (xcd < r ? xcd * (q + 1) : r * (q + 1) + (xcd - r) * q) + off; }
        const int nig = WGM * nN, gid = wgid / nig, fm = gid * WGM, gsz = (nM - fm) < WGM ? (nM - fm) : WGM;
        u.pm = fm + ((wgid % nig) % gsz); u.pn = (wgid % nig) / gsz; u.orow = u.pm * BM; u.ocol = u.pn * BM; u.e = 0; u.lt = u.pm; return true;
    }
    __device__ __forceinline__ unsigned arow(const Unit& u, int r) const { return (unsigned)(u.pm * BM + r); }
};

__device__ __forceinline__ unsigned cvt_pk_bf16(float lo, float hi) { unsigned r; asm volatile("v_cvt_pk_bf16_f32 %0, %1, %2" : "=v"(r) : "v"(lo), "v"(hi)); return r; }

struct EpiBf16 {
    static constexpr bool PERM = true;
    bf16_t* O; int ldc;
    __device__ __forceinline__ void operator()(const f32x4 (&acc)[2][2][4][2], const Unit& u, int wr, int wc, int fr, int fq) const {
        const int row0 = u.orow + wr * 64 + fr, col0 = u.ocol + wc * 32 + 8 * fq;
#pragma unroll
        for (int ai = 0; ai < 2; ++ai)
#pragma unroll
            for (int m = 0; m < 4; ++m) { bf16_t* rowp = O + (size_t)(row0 + ai * HALF + m * 16) * ldc + col0;
#pragma unroll
                for (int bj = 0; bj < 2; ++bj) { const f32x4 v0 = acc[ai][bj][m][0], v1 = acc[ai][bj][m][1];
                    u32x4 w; w.x = cvt_pk_bf16(v0[0], v0[1]); w.y = cvt_pk_bf16(v0[2], v0[3]); w.z = cvt_pk_bf16(v1[0], v1[1]); w.w = cvt_pk_bf16(v1[2], v1[3]);
                    *(u32x4*)(rowp + bj * HALF) = w; } }
    }
};
struct EpiF32 {
    static constexpr bool PERM = false;
    float* C; int ldc;
    __device__ __forceinline__ void operator()(const f32x4 (&acc)[2][2][4][2], const Unit& u, int wr, int wc, int fr, int fq) const {
        const int row0 = u.orow + wr * 64 + fr, col0 = u.ocol + wc * 32 + 4 * fq;
#pragma unroll
        for (int ai = 0; ai < 2; ++ai)
#pragma unroll
            for (int m = 0; m < 4; ++m) { float* rowp = C + (size_t)(row0 + ai * HALF + m * 16) * ldc + col0;
#pragma unroll
                for (int bj = 0; bj < 2; ++bj)
#pragma unroll
                    for (int n = 0; n < 2; ++n) *(f32x4*)(rowp + bj * HALF + n * 16) = acc[ai][bj][m][n]; }
    }
};
struct EpiResid {
    static constexpr bool PERM = false;
    const float* src; float* dst; float alpha;
    __device__ __forceinline__ void operator()(const f32x4 (&acc)[2][2][4][2], const Unit& u, int wr, int wc, int fr, int fq) const {
        const int row0 = u.orow + wr * 64 + fr, col0 = u.ocol + wc * 32 + 4 * fq;
#pragma unroll
        for (int ai = 0; ai < 2; ++ai)
#pragma unroll
            for (int m = 0; m < 4; ++m) { const size_t ro = (size_t)(row0 + ai * HALF + m * 16) * DM + col0;
#pragma unroll
                for (int bj = 0; bj < 2; ++bj)
#pragma unroll
                    for (int n = 0; n < 2; ++n) { const f32x4 s = *(const f32x4*)(src + ro + bj * HALF + n * 16); *(f32x4*)(dst + ro + bj * HALF + n * 16) = s * alpha + acc[ai][bj][m][n]; } }
    }
};
struct EpiSwiGLU {
    static constexpr bool PERM = true;
    bf16_t* H;
    __device__ __forceinline__ void operator()(const f32x4 (&acc)[2][2][4][2], const Unit& u, int wr, int wc, int fr, int fq) const {
        const int row0 = u.orow + wr * 64 + fr, col0 = u.ocol + wc * 32 + 8 * fq;
#pragma unroll
        for (int ai = 0; ai < 2; ++ai)
#pragma unroll
            for (int m = 0; m < 4; ++m) { bf16_t* rowp = H + (size_t)(row0 + ai * HALF + m * 16) * DE + col0;
                float h[8];
#pragma unroll
                for (int n = 0; n < 2; ++n)
#pragma unroll
                    for (int j = 0; j < 4; ++j) { const float g = acc[ai][0][m][n][j], up = acc[ai][1][m][n][j]; h[n * 4 + j] = g / (1.0f + __expf(-g)) * up; }
                u32x4 w; w.x = cvt_pk_bf16(h[0], h[1]); w.y = cvt_pk_bf16(h[2], h[3]); w.z = cvt_pk_bf16(h[4], h[5]); w.w = cvt_pk_bf16(h[6], h[7]);
                *(u32x4*)rowp = w; }
    }
};
struct EpiDown {
    static constexpr bool PERM = true;
    bf16_t* Y; const float* wslot; const LAS int* cnt;
    __device__ __forceinline__ void operator()(const f32x4 (&acc)[2][2][4][2], const Unit& u, int wr, int wc, int fr, int fq) const {
        const int rl0 = wr * 64 + fr, col0 = u.ocol + wc * 32 + 8 * fq; const int ce = cnt[u.e];
#pragma unroll
        for (int ai = 0; ai < 2; ++ai)
#pragma unroll
            for (int m = 0; m < 4; ++m) { const int rl = rl0 + ai * HALF + m * 16, loc = u.lt * BM + rl;
                const float gw = loc < ce ? wslot[(size_t)u.e * CAP + loc] : 0.f;
                bf16_t* rowp = Y + (size_t)(u.orow + rl) * DM + col0;
#pragma unroll
                for (int bj = 0; bj < 2; ++bj) { const f32x4 v0 = acc[ai][bj][m][0] * gw, v1 = acc[ai][bj][m][1] * gw;
                    u32x4 w; w.x = cvt_pk_bf16(v0[0], v0[1]); w.y = cvt_pk_bf16(v0[2], v0[3]); w.z = cvt_pk_bf16(v1[0], v1[1]); w.w = cvt_pk_bf16(v1[2], v1[3]);
                    *(u32x4*)(rowp + bj * HALF) = w; } }
    }
};

template <class Epi, class Sched, bool ALIGN_EPI>
__device__ __forceinline__ void gemm_phase(LAS unsigned char* lds, const Gemm g, const Sched& S, const Epi& E, const int tid) {
    const int wid = __builtin_amdgcn_readfirstlane(tid >> 6), lane = tid & 63, wr = wid >> 2, wc = wid & 3, fr = lane & 15, fq = lane >> 4;
    const int K = g.K, nt = K / BK;
    constexpr bool GATHER = Sched::GATHER;
    int Ra[2]; unsigned Ca[2], voffA[2], voffB[2];
    const unsigned ldab = (unsigned)g.lda * 2u;
#pragma unroll
    for (int i = 0; i < 2; ++i) { int R, C; stage_rc(tid * 16 + i * 8192, R, C); const int Rb = Epi::PERM ? ((R & ~31) + perm32(R & 31)) : R;
        Ra[i] = R; Ca[i] = (unsigned)C * 2u; voffA[i] = (unsigned)R * ldab + (unsigned)C * 2u; voffB[i] = (unsigned)(Rb * K + C) * 2u; }
    const size_t hstepA = (size_t)HALF * ldab;
    const size_t kstep = (size_t)(BK * 2);
    const size_t hstep = (size_t)HALF * K * 2;
    const size_t tstep = 2 * hstep;
    const unsigned ldsw = (unsigned)wid * 1024u;
    const int aoff = lds_byte(wr * 64 + fr, fq * 8), boff = lds_byte(wc * 32 + fr, fq * 8);
    const char* Ab = (const char*)g.A;
#define PG8_SA(b, h) (((b) * 2 + (h)) * HTB)
#define PG8_SB(b, h) ((4 + (b) * 2 + (h)) * HTB)
#define PG8_STAGE(bufoff, gbase, voff) do { _Pragma("unroll") for (int _i = 0; _i < 2; ++_i) \
        __builtin_amdgcn_global_load_lds((const unsigned*)((const char*)(gbase) + (voff)[_i]), (LAS unsigned*)(lds + (bufoff) + ldsw + _i * 8192), 16, 0, 0); } while (0)
#define PG8_STAGEA(bufoff, offs, ubase, h, kbyte) do { _Pragma("unroll") for (int _i = 0; _i < 2; ++_i) { \
        const char* _src = GATHER ? Ab + (size_t)(offs)[h][_i] + (size_t)(kbyte) : (ubase) + (size_t)(h) * hstepA + (size_t)(kbyte) + voffA[_i]; \
        __builtin_amdgcn_global_load_lds((const unsigned*)_src, (LAS unsigned*)(lds + (bufoff) + ldsw + _i * 8192), 16, 0, 0); } } while (0)
#define PG8_OFFS(dst, u) do { if constexpr (GATHER) { _Pragma("unroll") for (int _h = 0; _h < 2; ++_h) _Pragma("unroll") for (int _i = 0; _i < 2; ++_i) dst[_h][_i] = S.arow(u, _h * HALF + Ra[_i]) * ldab + Ca[_i]; } } while (0)
#define PG8_LDA(dst, b, h) do { _Pragma("unroll") for (int m = 0; m < 4; ++m) _Pragma("unroll") for (int k = 0; k < 2; ++k) dst[m][k] = *(const LAS bf16x8*)(lds + PG8_SA(b, h) + aoff + m * 2048 + k * 1024); } while (0)
#define PG8_LDB(dst, b, h) do { _Pragma("unroll") for (int n = 0; n < 2; ++n) _Pragma("unroll") for (int k = 0; k < 2; ++k) dst[n][k] = *(const LAS bf16x8*)(lds + PG8_SB(b, h) + boff + n * 2048 + k * 1024); } while (0)
#define PG8_MMA(ai, bj, At, Bt) do { __builtin_amdgcn_s_setprio(1); _Pragma("unroll") for (int m = 0; m < 4; ++m) _Pragma("unroll") for (int n = 0; n < 2; ++n) _Pragma("unroll") for (int k = 0; k < 2; ++k) \
        acc[ai][bj][m][n] = __builtin_amdgcn_mfma_f32_16x16x32_bf16(Bt[n][k], At[m][k], acc[ai][bj][m][n], 0, 0, 0); __builtin_amdgcn_s_setprio(0); } while (0)
#define PG8_WAIT_V(n) asm volatile("s_waitcnt vmcnt(" #n ")" ::: "memory")
#define PG8_WAIT_L(n) asm volatile("s_waitcnt lgkmcnt(" #n ")" ::: "memory")
#define PG8_BAR __builtin_amdgcn_s_barrier()
#define PG8_SCHED __builtin_amdgcn_sched_barrier(0)
    Unit cur, nxt; int ui = 0;
    if (!S.next(0, cur)) return;
    f32x4 acc[2][2][4][2];
#pragma unroll
    for (int a = 0; a < 2; ++a)
#pragma unroll
        for (int b = 0; b < 2; ++b)
#pragma unroll
            for (int m = 0; m < 4; ++m)
#pragma unroll
                for (int n = 0; n < 2; ++n) acc[a][b][m][n] = (f32x4){0.f, 0.f, 0.f, 0.f};
    bf16x8 At[4][2], B0[2][2], B1[2][2];
    unsigned oc[2][2] = {{0u, 0u}, {0u, 0u}}, on[2][2] = {{0u, 0u}, {0u, 0u}};
    PG8_OFFS(oc, cur);
    const char* cA = Ab + (size_t)S.arow(cur, 0) * ldab;
    const char* cB = (const char*)g.Bt + (size_t)cur.pn * tstep;
    PG8_STAGE(PG8_SB(0, 0), cB, voffB); PG8_STAGE(PG8_SB(0, 1), cB + hstep, voffB); PG8_STAGEA(PG8_SA(0, 0), oc, cA, 0, 0); PG8_STAGEA(PG8_SA(0, 1), oc, cA, 1, 0);
    if (wr == 1) PG8_BAR;
    PG8_WAIT_V(2); PG8_BAR;
    PG8_STAGE(PG8_SB(1, 0), cB + kstep, voffB); PG8_STAGEA(PG8_SA(1, 0), oc, cA, 0, kstep); PG8_STAGE(PG8_SB(1, 1), cB + hstep + kstep, voffB);
    PG8_WAIT_V(6); PG8_BAR;
    for (;;) {
        const bool has_next = S.next(ui + 1, nxt);
        if (has_next) { PG8_OFFS(on, nxt); } else {
#pragma unroll
            for (int h = 0; h < 2; ++h)
#pragma unroll
                for (int i = 0; i < 2; ++i) on[h][i] = oc[h][i]; }
        const char* nB = has_next ? (const char*)g.Bt + (size_t)nxt.pn * tstep : cB;
        const char* nA = has_next ? Ab + (size_t)S.arow(nxt, 0) * ldab : cA;
        for (int t = 0; t < nt; t += 2) {
            const bool last = (t == nt - 2);
            const size_t k1 = (size_t)(t + 1) * kstep;
            const size_t k2 = last ? 0 : (size_t)(t + 2) * kstep, k3 = k2 + kstep;
            const char* b2 = last ? nB : cB + (size_t)(t + 2) * kstep; const char* b3 = b2 + kstep;
            unsigned o2[2][2]; const char* a2 = last ? nA : cA;
#pragma unroll
            for (int h = 0; h < 2; ++h)
#pragma unroll
                for (int i = 0; i < 2; ++i) o2[h][i] = last ? on[h][i] : oc[h][i];
            PG8_LDB(B0, 0, 0); PG8_LDB(B1, 0, 1); PG8_SCHED; PG8_LDA(At, 0, 0); PG8_STAGEA(PG8_SA(1, 1), oc, cA, 1, k1);
            PG8_WAIT_V(8); PG8_WAIT_L(0); PG8_BAR; PG8_MMA(0, 0, At, B0); PG8_MMA(0, 1, At, B1); PG8_BAR; PG8_SCHED;
            PG8_LDA(At, 0, 1); PG8_STAGE(PG8_SB(0, 0), b2, voffB); PG8_STAGE(PG8_SB(0, 1), b2 + hstep, voffB); PG8_STAGEA(PG8_SA(0, 0), o2, a2, 0, k2);
            PG8_WAIT_V(8); PG8_WAIT_L(0); PG8_BAR; PG8_MMA(1, 0, At, B0); PG8_MMA(1, 1, At, B1); PG8_BAR; PG8_SCHED;
            PG8_LDB(B0, 1, 0); PG8_LDB(B1, 1, 1); PG8_SCHED; PG8_LDA(At, 1, 0); PG8_STAGEA(PG8_SA(0, 1), o2, a2, 1, k2);
            PG8_WAIT_V(8); PG8_WAIT_L(0); PG8_BAR; PG8_MMA(0, 0, At, B0); PG8_MMA(0, 1, At, B1); PG8_BAR; PG8_SCHED;
            PG8_LDA(At, 1, 1); PG8_STAGE(PG8_SB(1, 0), b3, voffB); PG8_STAGE(PG8_SB(1, 1), b3 + hstep, voffB); PG8_STAGEA(PG8_SA(1, 0), o2, a2, 0, k3);
            PG8_WAIT_V(8); PG8_WAIT_L(0); PG8_BAR; PG8_MMA(1, 0, At, B0); PG8_MMA(1, 1, At, B1); PG8_BAR; PG8_SCHED;
        }
        if constexpr (ALIGN_EPI) { if (wr == 0) PG8_BAR; }
        { int l2; asm volatile("v_mbcnt_lo_u32_b32 %0, -1, 0\n\tv_mbcnt_hi_u32_b32 %0, -1, %0" : "=v"(l2)); E(acc, cur, wr, wc, l2 & 15, l2 >> 4); }
        if (!has_next) break;
#pragma unroll
        for (int a = 0; a < 2; ++a)
#pragma unroll
            for (int b = 0; b < 2; ++b)
#pragma unroll
                for (int m = 0; m < 4; ++m)
#pragma unroll
                    for (int n = 0; n < 2; ++n) acc[a][b][m][n] = (f32x4){0.f, 0.f, 0.f, 0.f};
        cur = nxt; cB = nB; cA = nA; ++ui;
#pragma unroll
        for (int h = 0; h < 2; ++h)
#pragma unroll
            for (int i = 0; i < 2; ++i) oc[h][i] = on[h][i];
        if constexpr (ALIGN_EPI) { if (wr == 1) PG8_BAR; }
    }
    PG8_WAIT_V(0);
    if constexpr (!ALIGN_EPI) { if (wr == 0) PG8_BAR; }
    PG8_BAR;
#undef PG8_SA
#undef PG8_SB
#undef PG8_STAGE
#undef PG8_STAGEA
#undef PG8_OFFS
#undef PG8_LDA
#undef PG8_LDB
#undef PG8_MMA
#undef PG8_WAIT_V
#undef PG8_WAIT_L
#undef PG8_BAR
#undef PG8_SCHED
}
}
namespace att {
constexpr int MODE_CAUSAL = 0, MODE_MOBA = 1, MODE_SWA = 2;
constexpr int KPAD = 8;
__device__ __forceinline__ unsigned cvtpk(float lo, float hi) { unsigned r; asm volatile("v_cvt_pk_bf16_f32 %0, %1, %2" : "=v"(r) : "v"(lo), "v"(hi)); return r; }
template <int DK, int DV> struct Geo {
    static constexpr int KP = DK + KPAD, VP = DV + KPAD;
    static constexpr int KB = 64 * KP * 2, VB = 64 * VP * 2;
    static constexpr int KCH = 64 * DK / 8, VCH = 64 * DV / 8;
    static constexpr int KPT = (KCH + 511) / 512, VPT = (VCH + 511) / 512;
    static constexpr int LDS_BYTES = KB + VB;
};
struct Tens { const bf16_t* Q; const bf16_t* K; const bf16_t* V; void* O; int ldq, ldk, ldv, ldo; };

template <int DK, int DV, int MODE, bool OF32>
__device__ __forceinline__ void unit(const Tens& T, int b, int qb, const float* kmean, float sink, LAS unsigned char* lds, const int tid) {
    typedef Geo<DK, DV> G;
    const int lane = tid & 63, r32 = lane & 31, hi = lane >> 5; const int wid = __builtin_amdgcn_readfirstlane(tid >> 6);
    const size_t rowbase = (size_t)b * SEQ;
    const int q0 = qb * 256, qw0 = q0 + wid * 32, qabs = qw0 + r32;
    LAS unsigned char* Ks = lds; LAS unsigned char* Vs = lds + G::KB;
    bf16x8 qf[DK / 16];
    { const bf16_t* qp = T.Q + (rowbase + qabs) * T.ldq + 8 * hi;
#pragma unroll
      for (int d0 = 0; d0 < DK / 16; ++d0) qf[d0] = *(const bf16x8*)(qp + 16 * d0); }
    int sel0 = -1, sel1 = -1, sel2 = -1;
    if constexpr (MODE == MODE_MOBA) {
        float gate[16];
#pragma unroll
        for (int j = 0; j < 16; ++j) gate[j] = -INFINITY;
#pragma unroll
        for (int j = 0; j < 15; ++j) if (j < qb) {
            float a = 0.f;
#pragma unroll
            for (int d0 = 0; d0 < 4; ++d0) { const float* kmp = kmean + j * 64 + 16 * d0 + 8 * hi; const f32x4 k0 = *(const f32x4*)kmp, k1 = *(const f32x4*)(kmp + 4);
#pragma unroll
                for (int e = 0; e < 4; ++e) { a += bf2f((unsigned short)qf[d0][e]) * k0[e]; a += bf2f((unsigned short)qf[d0][4 + e]) * k1[e]; } }
            a += __shfl_xor(a, 32);
            gate[j] = a; }
        const int nsel = qb < 3 ? qb : 3;
#pragma unroll
        for (int s = 0; s < 3; ++s) if (s < nsel) {
            float best = -INFINITY; int bi = 0;
#pragma unroll
            for (int j = 0; j < 15; ++j) if (gate[j] > best) { best = gate[j]; bi = j; }
            if (s == 0) sel0 = bi; else if (s == 1) sel1 = bi; else sel2 = bi;
#pragma unroll
            for (int j = 0; j < 15; ++j) if (j == bi) gate[j] = -INFINITY; }
    }
    int t_lo, t_hi;
    if constexpr (MODE == MODE_SWA) { t_lo = qb == 0 ? 0 : qb * 4 - 2; t_hi = qb * 4 + 4; } else { t_lo = 0; t_hi = qb * 4 + 4; }
    u32x4 kreg[G::KPT], vreg[G::VPT];
    const bf16_t* Kg = T.K + rowbase * T.ldk; const bf16_t* Vg = T.V + rowbase * T.ldv;
#define ATT_LOAD(t) do { \
        _Pragma("unroll") for (int i_ = 0; i_ < G::KPT; ++i_) { const int c_ = tid + 512 * i_; if (c_ < G::KCH) { const int row_ = c_ / (DK / 8), cc_ = c_ % (DK / 8); kreg[i_] = *(const u32x4*)(Kg + (size_t)((t) * 64 + row_) * T.ldk + cc_ * 8); } } \
        _Pragma("unroll") for (int i_ = 0; i_ < G::VPT; ++i_) { const int c_ = tid + 512 * i_; if (c_ < G::VCH) { const int row_ = c_ / (DV / 8), cc_ = c_ % (DV / 8); vreg[i_] = *(const u32x4*)(Vg + (size_t)((t) * 64 + row_) * T.ldv + cc_ * 8); } } } while (0)
#define ATT_STORE() do { \
        _Pragma("unroll") for (int i_ = 0; i_ < G::KPT; ++i_) { const int c_ = tid + 512 * i_; if (c_ < G::KCH) { const int row_ = c_ / (DK / 8), cc_ = c_ % (DK / 8); *(LAS u32x4*)(Ks + row_ * (G::KP * 2) + cc_ * 16) = kreg[i_]; } } \
        _Pragma("unroll") for (int i_ = 0; i_ < G::VPT; ++i_) { const int c_ = tid + 512 * i_; if (c_ < G::VCH) { const int row_ = c_ / (DV / 8), cc_ = c_ % (DV / 8); *(LAS u32x4*)(Vs + row_ * (G::VP * 2) + cc_ * 16) = vreg[i_]; } } } while (0)
    float mrun = -1e30f, lrun = 0.f;
    if constexpr (MODE == MODE_SWA) { mrun = sink; lrun = hi == 0 ? 1.f : 0.f; }
    f32x16 o[DV / 32];
#pragma unroll
    for (int d = 0; d < DV / 32; ++d) o[d] = f32x16{};
    const int krow = (r32 & 0x13) | ((r32 & 4) << 1) | ((r32 & 8) >> 1);
    const LAS unsigned char* kfb = Ks + krow * (G::KP * 2) + hi * 16;
    const int i16 = lane & 15;
    const LAS unsigned char* vfb = Vs + (8 * hi + (i16 >> 2)) * (G::VP * 2) + (16 * (r32 >> 4) + 4 * (i16 & 3)) * 2;
    ATT_LOAD(t_lo);
    for (int t = t_lo; t < t_hi; ++t) {
        __syncthreads();
        ATT_STORE();
        __syncthreads();
        if (t + 1 < t_hi) ATT_LOAD(t + 1);
        const int kv0 = t * 64;
        bool skip = kv0 > qw0 + 31;
        if constexpr (MODE == MODE_SWA) skip = skip || (kv0 + 63 < qw0 - 127);
        if (skip) continue;
        f32x16 p0 = f32x16{}, p1 = f32x16{};
#pragma unroll
        for (int d0 = 0; d0 < DK / 16; ++d0) {
            const bf16x8 k0 = *(const LAS bf16x8*)(kfb + d0 * 32);
            const bf16x8 k1 = *(const LAS bf16x8*)(kfb + 32 * (G::KP * 2) + d0 * 32);
            p0 = __builtin_amdgcn_mfma_f32_32x32x16_bf16(k0, qf[d0], p0, 0, 0, 0);
            p1 = __builtin_amdgcn_mfma_f32_32x32x16_bf16(k1, qf[d0], p1, 0, 0, 0);
        }
        bool need_mask = kv0 + 63 > qw0;
        if constexpr (MODE == MODE_SWA) need_mask = true;
        if constexpr (MODE == MODE_MOBA) { if (kv0 < q0) { const int jb = kv0 >> 8; if (!(jb == sel0 || jb == sel1 || jb == sel2)) {
#pragma unroll
            for (int i = 0; i < 16; ++i) { p0[i] = -INFINITY; p1[i] = -INFINITY; } } } }
        if (need_mask) {
#pragma unroll
            for (int i = 0; i < 16; ++i) { const int kv = kv0 + 16 * (i >> 3) + 8 * hi + (i & 7);
                bool m0 = kv > qabs, m1 = kv + 32 > qabs;
                if constexpr (MODE == MODE_SWA) { m0 = m0 || (kv < qabs - 127); m1 = m1 || (kv + 32 < qabs - 127); }
                if (m0) p0[i] = -INFINITY; if (m1) p1[i] = -INFINITY; }
        }
        float mx = p0[0];
#pragma unroll
        for (int i = 1; i < 16; ++i) mx = fmaxf(mx, p0[i]);
#pragma unroll
        for (int i = 0; i < 16; ++i) mx = fmaxf(mx, p1[i]);
        mx = fmaxf(mx, __shfl_xor(mx, 32));
        const float mnew = fmaxf(mrun, mx);
        const float alpha = __builtin_amdgcn_exp2f(mrun - mnew);
        mrun = mnew;
        float ls = 0.f;
#pragma unroll
        for (int i = 0; i < 16; ++i) { p0[i] = __builtin_amdgcn_exp2f(p0[i] - mnew); p1[i] = __builtin_amdgcn_exp2f(p1[i] - mnew); ls += p0[i] + p1[i]; }
        lrun = lrun * alpha + ls;
#pragma unroll
        for (int d = 0; d < DV / 32; ++d)
#pragma unroll
            for (int i = 0; i < 16; ++i) o[d][i] *= alpha;
        bf16x8 pf[4];
#pragma unroll
        for (int s2 = 0; s2 < 4; ++s2) { const f32x16& pp = (s2 >> 1) ? p1 : p0; const int b0 = 8 * (s2 & 1);
            u32x4 w; w.x = cvtpk(pp[b0 + 0], pp[b0 + 1]); w.y = cvtpk(pp[b0 + 2], pp[b0 + 3]); w.z = cvtpk(pp[b0 + 4], pp[b0 + 5]); w.w = cvtpk(pp[b0 + 6], pp[b0 + 7]);
            pf[s2] = __builtin_bit_cast(bf16x8, w); }
#pragma unroll
        for (int d = 0; d < DV / 32; ++d)
#pragma unroll
            for (int s2 = 0; s2 < 4; ++s2) {
                const LAS unsigned char* vp = vfb + (16 * s2) * (G::VP * 2) + d * 64;
                const s16x4 lo = __builtin_bit_cast(s16x4, __builtin_amdgcn_ds_read_tr16_b64_v4i16((LAS s16x4*)(vp)));
                const s16x4 hh = __builtin_bit_cast(s16x4, __builtin_amdgcn_ds_read_tr16_b64_v4i16((LAS s16x4*)(vp + 4 * (G::VP * 2))));
                const bf16x8 vf = (bf16x8){lo[0], lo[1], lo[2], lo[3], hh[0], hh[1], hh[2], hh[3]};
                o[d] = __builtin_amdgcn_mfma_f32_32x32x16_bf16(vf, pf[s2], o[d], 0, 0, 0);
            }
    }
#undef ATT_LOAD
#undef ATT_STORE
    const float ltot = lrun + __shfl_xor(lrun, 32);
    const float inv = 1.0f / ltot;
    if constexpr (OF32) {
        float* op = (float*)T.O + (rowbase + qabs) * T.ldo + 4 * hi;
#pragma unroll
        for (int d = 0; d < DV / 32; ++d)
#pragma unroll
            for (int g4 = 0; g4 < 4; ++g4) { f32x4 v = {o[d][4 * g4] * inv, o[d][4 * g4 + 1] * inv, o[d][4 * g4 + 2] * inv, o[d][4 * g4 + 3] * inv}; *(f32x4*)(op + 32 * d + 8 * g4) = v; }
    } else {
        bf16_t* op = (bf16_t*)T.O + (rowbase + qabs) * T.ldo + 4 * hi;
#pragma unroll
        for (int d = 0; d < DV / 32; ++d)
#pragma unroll
            for (int g4 = 0; g4 < 4; ++g4) { u32x2 w; w.x = cvtpk(o[d][4 * g4] * inv, o[d][4 * g4 + 1] * inv); w.y = cvtpk(o[d][4 * g4 + 2] * inv, o[d][4 * g4 + 3] * inv); *(u32x2*)(op + 32 * d + 8 * g4) = w; }
    }
}
}
constexpr int NWAVES = 8, NTHREADS = 512;
constexpr size_t MiB = 1u << 20;
constexpr size_t WS_CTL = 0, CTL_ZERO_BYTES = 1 * MiB;
constexpr size_t WS_SMALLW = 1 * MiB;
constexpr size_t SW_LAYER = 8 * MiB, SW_WOUT = 4608 * 1024, SW_WQB = SW_WOUT + 2 * MiB, SW_WKVB = SW_WQB + 384 * 1024;
static_assert(SW_WKVB + 512 * 1024 <= SW_LAYER, "small weights");
constexpr size_t WS_WR = WS_SMALLW + 4 * SW_LAYER;
constexpr size_t WS_ROPE = WS_WR + 4 * MiB;
constexpr size_t WS_KMEAN = WS_ROPE + 8 * MiB;
constexpr size_t WS_WGU = WS_KMEAN + 1 * MiB;
constexpr size_t WS_WD = WS_WGU + 65 * MiB;
constexpr size_t WS_ROWTOK = WS_WD + 33 * MiB;
constexpr size_t WS_WSLOT = WS_ROWTOK + 8 * MiB;
constexpr size_t WS_TOKE = WS_WSLOT + 8 * MiB;
constexpr size_t WS_TOKP = WS_TOKE + 1 * MiB;
constexpr size_t WS_XF = WS_TOKP + 1 * MiB;
constexpr size_t WS_HS = WS_XF + 128 * MiB;
constexpr size_t WS_YS = WS_HS + 152 * MiB;
constexpr size_t WS_END = WS_YS + 544 * MiB;
static_assert(WS_END <= 1024 * MiB, "workspace map exceeds 1 GiB");
constexpr size_t A_HB = WS_YS;
constexpr size_t A_QF = A_HB, A_KVF = A_HB + 48 * MiB;
constexpr size_t A_Q1 = A_HB + 144 * MiB;
constexpr size_t A_K1 = A_Q1 + 32 * MiB;
constexpr size_t A_V1 = A_K1 + 32 * MiB;
constexpr size_t A_X1 = A_V1 + 32 * MiB;
constexpr size_t A_X2 = A_X1 + 32 * MiB;
constexpr size_t A_Q2 = A_X2 + 32 * MiB;
constexpr size_t A_OB = A_Q2 + 128 * MiB;
static_assert(A_OB + 64 * MiB <= WS_END, "attention overlay");
constexpr size_t A_XS = WS_YS;
constexpr size_t A_LOG = WS_YS + 128 * MiB;
constexpr int CW_BAR = 4096;
constexpr int CW_CNT = 16384;
constexpr int RING_BYTES = 131072;
constexpr int LX_BAR = RING_BYTES;
constexpr int LX_CNT = RING_BYTES + 64;
constexpr int LX_TST = LX_CNT + 256;
constexpr int LX_TEXP = LX_TST + 320;
constexpr int LDS_BYTES = 147456;
static_assert(LX_TEXP + 1280 <= LDS_BYTES, "LDS map");

#define XB_TMO      128
#define XB_XCNT(j)  (256  + 64 * (j))
#define XB_XSUB(j)  (1280 + 64 * (j))
#define XB_XGEN(j)  (2304 + 64 * (j))
#define XB_TOP      3328
#define XB_TOPGEN   3392
#define XCD_BAR_WORDS 3456
#define XB_SPIN_CAP (1u << 20)
__device__ __forceinline__ unsigned xb_ld(unsigned* p)              { return __hip_atomic_load(p, __ATOMIC_RELAXED, __HIP_MEMORY_SCOPE_AGENT); }
__device__ __forceinline__ unsigned xb_add(unsigned* p, unsigned v) { return __hip_atomic_fetch_add(p, v, __ATOMIC_RELAXED, __HIP_MEMORY_SCOPE_AGENT); }
__device__ __forceinline__ unsigned xb_xcc_id() { return (unsigned)__builtin_amdgcn_s_getreg((3 << 11) | 20) & 0xFu; }
#define XB_SPIN(cond, bar) do { unsigned _sp = 0; while (cond) { __builtin_amdgcn_s_sleep(1); \
    if ((++_sp & 255u) == 0u) { if (xb_ld(&(bar)[XB_TMO])) break; if (_sp > XB_SPIN_CAP) { atomicAdd(&(bar)[XB_TMO], 1u); break; } } } } while (0)
struct XcdBarrier { unsigned* bar; unsigned x; volatile LAS unsigned* st; };
__device__ __forceinline__ XcdBarrier xcd_barrier_post(unsigned* bar, volatile LAS unsigned* st) {
    XcdBarrier b; b.bar = bar; b.x = xb_xcc_id(); b.st = st;
    if (threadIdx.x == 0) (void)xb_add(&bar[XB_XCNT(b.x)], 1u);
    return b;
}
__device__ __forceinline__ void xcd_barrier_complete(unsigned* bar, unsigned x, unsigned& nloc, unsigned& nx) {
    const unsigned G = gridDim.x * gridDim.y * gridDim.z;
    unsigned sum, cnt, mine, sp = 0u;
    for (;;) {
        sum = 0u; cnt = 0u; mine = 0u;
#pragma unroll
        for (unsigned j = 0; j < 16; ++j) { const unsigned c = xb_ld(&bar[XB_XCNT(j)]); sum += c; cnt += (c > 0u) ? 1u : 0u; mine = (j == x) ? c : mine; }
        if (sum == G) break;
        __builtin_amdgcn_s_sleep(1);
        if ((++sp & 255u) == 0u) { if (xb_ld(&bar[XB_TMO])) break; if (sp > XB_SPIN_CAP) { atomicAdd(&bar[XB_TMO], 1u); break; } }
    }
    nloc = mine > 0u ? mine : 1u; nx = cnt > 0u ? cnt : 1u;
}
__device__ __forceinline__ void xcd_barrier(const XcdBarrier& b, const bool leader) {
    asm volatile("s_waitcnt vmcnt(0)" ::: "memory");
    __syncthreads();
    if (leader) {
        unsigned* bar = b.bar; const unsigned bx = xb_xcc_id();
        __builtin_amdgcn_s_waitcnt(0);
        unsigned nloc = b.st[0], nx = b.st[1];
        if (nloc == 0u) { xcd_barrier_complete(bar, bx, nloc, nx); b.st[0] = nloc; b.st[1] = nx; }
        const unsigned old = xb_add(&bar[XB_XSUB(bx)], 1u);
        const unsigned gen = old / nloc;
        if (old + 1u == (gen + 1u) * nloc) {
            __builtin_amdgcn_fence(__ATOMIC_RELEASE, "agent");
            asm volatile("s_waitcnt vmcnt(0)" ::: "memory");
            const unsigned og = xb_add(&bar[XB_TOP], 1u);
            const unsigned tg = og / nx;
            if (og + 1u == (tg + 1u) * nx) xb_add(&bar[XB_TOPGEN], 1u);
            else XB_SPIN(xb_ld(&bar[XB_TOPGEN]) == tg, bar);
            __builtin_amdgcn_fence(__ATOMIC_ACQUIRE, "agent");
            xb_add(&bar[XB_XGEN(bx)], 1u);
            asm volatile("s_waitcnt vmcnt(0)" ::: "memory");
        } else {
            XB_SPIN(xb_ld(&bar[XB_XGEN(bx)]) == gen, bar);
            __builtin_amdgcn_fence(__ATOMIC_ACQUIRE, "agent");
            asm volatile("s_waitcnt vmcnt(0)" ::: "memory");
        }
    }
    __syncthreads();
}

struct Args {
    const float* x; const int* pos;
    const float *ev_w_in, *ev_w_out, *mla_g_qa, *mla_w_qb, *mla_g_kva, *mla_w_kvb, *od_w_in, *od_w_out, *swa_sinks, *diff_lambda, *diff_g_subln, *ln_g, *ln_b,
                *moe_w_router, *moe_bias, *moe_w_gate, *moe_w_up, *moe_w_down, *sh_w_gate, *sh_w_up, *sh_w_down;
    float* out; unsigned char* ws;
    int st_lo, st_hi, use_bar, pad;
};

__device__ __forceinline__ void transpose_item(const float* W, int N, int k0, int n0, bf16_t* WT, int ldk, int dst_row0, LAS float* scr, int lane) {
#pragma unroll 8
    for (int i = 0; i < 32; ++i) { const int kk = 2 * i + (lane >> 5); scr[kk * 33 + (lane & 31)] = W[(size_t)(k0 + kk) * N + n0 + (lane & 31)]; }
    asm volatile("s_waitcnt lgkmcnt(0)" ::: "memory");
    const int c = lane & 7;
#pragma unroll
    for (int j = 0; j < 4; ++j) { const int n = (lane >> 3) + 8 * j; const LAS float* s = scr + (8 * c) * 33 + n;
        u32x4 o; o.x = pk2(s[0 * 33], s[1 * 33]); o.y = pk2(s[2 * 33], s[3 * 33]); o.z = pk2(s[4 * 33], s[5 * 33]); o.w = pk2(s[6 * 33], s[7 * 33]);
        *(u32x4*)(WT + (size_t)(dst_row0 + n) * ldk + k0 + 8 * c) = o; }
    asm volatile("s_waitcnt lgkmcnt(0)" ::: "memory");
}
__device__ __forceinline__ void sincos_acc(float angf, float& c, float& s) {
    const double x = (double)angf;
    const double n = __builtin_rint(x * 0.63661977236758134308);
    double r = x - n * 1.57079632679489655800; r -= n * 6.12323399573676603587e-17;
    const long q = (long)n;
    const double r2 = r * r;
    double sp = -2.5052108385441718775e-08; sp = sp * r2 + 2.7557319223985890653e-06; sp = sp * r2 - 1.9841269841269841270e-04; sp = sp * r2 + 8.3333333333333333333e-03; sp = sp * r2 - 1.6666666666666666667e-01;
    const double sn = r + r * r2 * sp;
    double cp = 2.0876756987868098979e-09; cp = cp * r2 - 2.7557319223985890653e-07; cp = cp * r2 + 2.4801587301587301587e-05; cp = cp * r2 - 1.3888888888888888889e-03; cp = cp * r2 + 4.1666666666666666667e-02; cp = cp * r2 - 0.5;
    const double cs = 1.0 + r2 * cp;
    double so, co;
    switch ((int)(q & 3)) { case 0: so = sn; co = cs; break; case 1: so = cs; co = -sn; break; case 2: so = -sn; co = -cs; break; default: so = -cs; co = sn; break; }
    s = (float)so; c = (float)co;
}
struct Ctx {
    LAS unsigned char* lds; unsigned char* ws; int tid, lane, wave, G, bid, gw, NGW;
};
#define WSP(T, off) ((T*)(C.ws + (off)))

__device__ __forceinline__ void phase_convert(const Ctx& C, const Args& a, int L) {
    LAS float* scr = (LAS float*)(C.lds + C.wave * 16384);
    {
        constexpr int IT_G = (1024 / 64) * (256 / 32);
        constexpr int IT_D = (256 / 64) * (1024 / 32);
        const int total = 65 * (2 * IT_G + IT_D);
        bf16_t* Wgu = WSP(bf16_t, WS_WGU); bf16_t* Wd = WSP(bf16_t, WS_WD);
        for (int it = C.gw; it < total; it += C.NGW) {
            const int e = it / (2 * IT_G + IT_D); int r = it % (2 * IT_G + IT_D);
            if (r < 2 * IT_G) {
                const int up = r >= IT_G; if (up) r -= IT_G;
                const float* W = e < 64 ? (up ? a.moe_w_up : a.moe_w_gate) + ((size_t)L * 64 + e) * 1024 * 256 : (up ? a.sh_w_up : a.sh_w_gate) + (size_t)L * 1024 * 256;
                const int kb = r / 8, nb = r % 8, n0 = nb * 32;
                transpose_item(W, 256, kb * 64, n0, Wgu + (size_t)e * 512 * 1024, 1024, (n0 >> 7) * 256 + up * 128 + (n0 & 127), scr, C.lane);
            } else {
                r -= 2 * IT_G;
                const float* W = e < 64 ? a.moe_w_down + ((size_t)L * 64 + e) * 256 * 1024 : a.sh_w_down + (size_t)L * 256 * 1024;
                const int kb = r / 32, nb = r % 32, n0 = nb * 32;
                transpose_item(W, 1024, kb * 64, n0, Wd + (size_t)e * 1024 * 256, 256, n0, scr, C.lane);
            }
        }
    }
}
__device__ __forceinline__ void phase_init(const Ctx& C, const Args& a) {
    LAS float* scr = (LAS float*)(C.lds + C.wave * 16384);
    for (int l = 0; l < DEPTH; ++l) {
        const int i = l >> 1; const bool even = !(l & 1);
        bf16_t* Win = WSP(bf16_t, WS_SMALLW + l * SW_LAYER); bf16_t* Wout = WSP(bf16_t, WS_SMALLW + l * SW_LAYER + SW_WOUT);
        const int nin = even ? EV_IN : OD_IN;
        const float* win = even ? a.ev_w_in + (size_t)i * 1024 * EV_IN : a.od_w_in + (size_t)i * 1024 * OD_IN;
        const float* wout = even ? a.ev_w_out + (size_t)i * 1024 * 1024 : a.od_w_out + (size_t)i * 1024 * 1024;
        const int it_in = 16 * (nin / 32), it_out = 16 * 32;
        for (int it = C.gw; it < it_in + it_out; it += C.NGW) {
            if (it < it_in) { const int kb = it / (nin / 32), nb = it % (nin / 32); transpose_item(win, nin, kb * 64, nb * 32, Win, 1024, nb * 32, scr, C.lane); }
            else { const int r = it - it_in, kb = r / 32, nb = r % 32; transpose_item(wout, 1024, kb * 64, nb * 32, Wout, 1024, nb * 32, scr, C.lane); }
        }
        if (even) {
            for (int idx = C.bid * NTHREADS + C.tid; idx < (2048 - EV_IN) * 1024 / 8; idx += C.G * NTHREADS) *(u32x4*)(Win + (size_t)EV_IN * 1024 + (size_t)idx * 8) = (u32x4){0u, 0u, 0u, 0u};
            bf16_t* Wqb = WSP(bf16_t, WS_SMALLW + l * SW_LAYER + SW_WQB); bf16_t* Wkvb = WSP(bf16_t, WS_SMALLW + l * SW_LAYER + SW_WKVB);
            const float* wqb = a.mla_w_qb + (size_t)i * 256 * 768; const float* wkvb = a.mla_w_kvb + (size_t)i * 128 * 1024;
            const int it_q = 4 * 24, it_kv = 2 * 32;
            for (int it = C.gw; it < it_q + it_kv; it += C.NGW) {
                if (it < it_q) { const int kb = it / 24, nb = it % 24; transpose_item(wqb, 768, kb * 64, nb * 32, Wqb, 256, nb * 32, scr, C.lane); }
                else { const int r = it - it_q, kb = r / 32, nb = r % 32; transpose_item(wkvb, 1024, kb * 64, nb * 32, Wkvb, 256, nb * 32, scr, C.lane); }
            }
            for (int idx = C.bid * NTHREADS + C.tid; idx < 1024 * 16; idx += C.G * NTHREADS) { const int row = idx >> 4, ch = idx & 15; *(u32x4*)(Wkvb + (size_t)row * 256 + 128 + ch * 8) = (u32x4){0u, 0u, 0u, 0u}; }
        }
        bf16_t* Wr = WSP(bf16_t, WS_WR + (size_t)l * MiB); const float* wr = a.moe_w_router + (size_t)l * 1024 * 64;
        for (int idx = C.bid * NTHREADS + C.tid; idx < 256 * 2048; idx += C.G * NTHREADS) {
            const int n = idx >> 11, k = idx & 2047; unsigned v = 0;
            if (n < 128) { const int e = n & 63, kk = k & 1023; const float w = wr[(size_t)kk * 64 + e]; const unsigned wh = f2bf(w);
                if (n < 64) v = wh; else if (k < 1024) v = f2bf(w - bf2f(wh)); }
            Wr[idx] = (bf16_t)v;
        }
    }
    { f32x2* rope = WSP(f32x2, WS_ROPE);
      for (int idx = C.bid * NTHREADS + C.tid; idx < NTOK * 32; idx += C.G * NTHREADS) { const int tok = idx >> 5, j = idx & 31;
          const float inv = (float)exp2(-(double)j * (13.287712379549449 / 32.0));
          const float ang = (float)a.pos[tok] * inv; float cs, sn; sincos_acc(ang, cs, sn); rope[idx] = (f32x2){cs, sn}; } }
    { bf16_t* xb = WSP(bf16_t, WS_HS);
      for (size_t idx = (size_t)C.bid * NTHREADS + C.tid; idx < (size_t)NTOK * DM / 8; idx += (size_t)C.G * NTHREADS) { const f32x4 v0 = *(const f32x4*)(a.x + idx * 8), v1 = *(const f32x4*)(a.x + idx * 8 + 4);
          u32x4 o; o.x = pk2(v0[0], v0[1]); o.y = pk2(v0[2], v0[3]); o.z = pk2(v1[0], v1[1]); o.w = pk2(v1[2], v1[3]); *(u32x4*)(xb + idx * 8) = o; } }
}

template <int HW>
__device__ __forceinline__ void rope_heads(const bf16_t* src, bf16_t* dst, int nh, const f32x2* rope_tok, float scale, int lane) {
    const int npairs = nh * HW;
    for (int p = lane; p < npairs; p += 64) { const int hh = p / HW, i = p % HW;
        const float x1 = bf2f(src[hh * 2 * HW + i]), x2 = bf2f(src[hh * 2 * HW + i + HW]); const f32x2 cs = rope_tok[i * (32 / HW)];
        dst[hh * 2 * HW + i] = (bf16_t)f2bf((x1 * cs.x - x2 * cs.y) * scale); dst[hh * 2 * HW + i + HW] = (bf16_t)f2bf((x2 * cs.x + x1 * cs.y) * scale); }
}
__device__ __forceinline__ void copy_cols(const bf16_t* src, bf16_t* dst, int n, int lane) { for (int c = lane; c < n / 8; c += 64) *(u32x4*)(dst + c * 8) = *(const u32x4*)(src + c * 8); }

__device__ __forceinline__ void phase_prep_even(const Ctx& C, const Args& a, int i) {
    const bf16_t* hb = WSP(bf16_t, A_HB); const f32x2* rope = WSP(f32x2, WS_ROPE);
    bf16_t *Qa = WSP(bf16_t, A_Q1), *Ka = WSP(bf16_t, A_K1), *Va = WSP(bf16_t, A_V1), *qlat = WSP(bf16_t, A_X1), *kvlat = WSP(bf16_t, A_X1 + 16 * MiB), *kpe = WSP(bf16_t, A_X2);
    const float* gqa = a.mla_g_qa + i * 256; const float* gkva = a.mla_g_kva + i * 128;
    const float sc = 0.125f * LOG2E;
    for (int tok = C.gw; tok < NTOK; tok += C.NGW) {
        const bf16_t* h = hb + (size_t)tok * HB_LD; const f32x2* rt = rope + (size_t)tok * 32;
        rope_heads<32>(h, Qa + (size_t)tok * 512, 8, rt, sc, C.lane);
        rope_heads<32>(h + 512, Ka + (size_t)tok * 512, 8, rt, 1.0f, C.lane);
        copy_cols(h + 1024, Va + (size_t)tok * 512, 512, C.lane);
        { float v[4]; float ss = 0.f;
#pragma unroll
          for (int j = 0; j < 4; ++j) { v[j] = bf2f(h[1536 + C.lane + 64 * j]); ss += v[j] * v[j]; }
          const float r = 1.0f / sqrtf(wave_sum(ss) * (1.0f / 256.0f) + 1e-6f);
#pragma unroll
          for (int j = 0; j < 4; ++j) qlat[(size_t)tok * 256 + C.lane + 64 * j] = (bf16_t)f2bf(v[j] * r * gqa[C.lane + 64 * j]); }
        { float v[2]; float ss = 0.f;
#pragma unroll
          for (int j = 0; j < 2; ++j) { v[j] = bf2f(h[1792 + C.lane + 64 * j]); ss += v[j] * v[j]; }
          const float r = 1.0f / sqrtf(wave_sum(ss) * (1.0f / 128.0f) + 1e-6f);
#pragma unroll
          for (int j = 0; j < 2; ++j) { kvlat[(size_t)tok * 256 + C.lane + 64 * j] = (bf16_t)f2bf(v[j] * r * gkva[C.lane + 64 * j]); kvlat[(size_t)tok * 256 + 128 + C.lane + 64 * j] = 0; } }
        rope_heads<16>(h + 1920, kpe + (size_t)tok * 32, 1, rt, 1.0f, C.lane);
    }
}
__device__ __forceinline__ void phase_kmean(const Ctx& C) {
    const bf16_t* Ka = WSP(bf16_t, A_K1); float* km = WSP(float, WS_KMEAN);
    for (int idx = C.bid * NTHREADS + C.tid; idx < NBATCH * 16 * 512; idx += C.G * NTHREADS) {
        const int c = idx & 511, bj = idx >> 9, b = bj >> 4, j = bj & 15; const bf16_t* p = Ka + ((size_t)b * SEQ + j * 256) * 512 + c;
        float s = 0.f;
        for (int r = 0; r < 256; ++r) s += bf2f(p[(size_t)r * 512]);
        km[(((size_t)b * 8 + (c >> 6)) * 16 + j) * 64 + (c & 63)] = s * (1.0f / 256.0f);
    }
}
__device__ __forceinline__ void phase_prep_mla(const Ctx& C) {
    const bf16_t *qf = WSP(bf16_t, A_QF), *kvf = WSP(bf16_t, A_KVF), *kpe = WSP(bf16_t, A_X2); const f32x2* rope = WSP(f32x2, WS_ROPE);
    bf16_t *Qb = WSP(bf16_t, A_Q2), *Kb = WSP(bf16_t, A_Q2 + 48 * MiB), *Vb = WSP(bf16_t, A_Q2 + 96 * MiB);
    const float sc = 0.10206207261596577f * LOG2E;
    for (int tok = C.gw; tok < NTOK; tok += C.NGW) {
        const bf16_t* q = qf + (size_t)tok * 768; const bf16_t* kv = kvf + (size_t)tok * 1024; const f32x2* rt = rope + (size_t)tok * 32;
        bf16_t* qo = Qb + (size_t)tok * 768; bf16_t* ko = Kb + (size_t)tok * 768; bf16_t* vo = Vb + (size_t)tok * 512;
        for (int p = C.lane; p < 512; p += 64) { const int hh = p >> 6, d = p & 63; qo[hh * 96 + d] = (bf16_t)f2bf(bf2f(q[hh * 96 + d]) * sc); ko[hh * 96 + d] = kv[hh * 128 + d]; vo[hh * 64 + d] = kv[hh * 128 + 64 + d]; }
        for (int p = C.lane; p < 128; p += 64) { const int hh = p >> 4, i2 = p & 15;
            const float x1 = bf2f(q[hh * 96 + 64 + i2]), x2 = bf2f(q[hh * 96 + 80 + i2]); const f32x2 cs = rt[2 * i2];
            qo[hh * 96 + 64 + i2] = (bf16_t)f2bf((x1 * cs.x - x2 * cs.y) * sc); qo[hh * 96 + 80 + i2] = (bf16_t)f2bf((x2 * cs.x + x1 * cs.y) * sc); }
        for (int p = C.lane; p < 256; p += 64) { const int hh = p >> 5, d = p & 31; ko[hh * 96 + 64 + d] = kpe[(size_t)tok * 32 + d]; }
    }
}
__device__ __forceinline__ void phase_prep_odd(const Ctx& C) {
    const bf16_t* hb = WSP(bf16_t, A_HB); const f32x2* rope = WSP(f32x2, WS_ROPE);
    bf16_t *Qc = WSP(bf16_t, A_Q1), *Kc = WSP(bf16_t, A_K1), *Vc = WSP(bf16_t, A_K1 + 8 * MiB), *Qd = WSP(bf16_t, A_V1), *Kd = WSP(bf16_t, A_X1), *Vd = WSP(bf16_t, A_X2);
    const float sc = 0.125f * LOG2E;
    for (int tok = C.gw; tok < NTOK; tok += C.NGW) {
        const bf16_t* h = hb + (size_t)tok * HB_LD; const f32x2* rt = rope + (size_t)tok * 32;
        rope_heads<32>(h, Qc + (size_t)tok * 512, 8, rt, sc, C.lane);
        rope_heads<32>(h + 512, Kc + (size_t)tok * 128, 2, rt, 1.0f, C.lane);
        copy_cols(h + 640, Vc + (size_t)tok * 128, 128, C.lane);
        rope_heads<32>(h + 768, Qd + (size_t)tok * 512, 8, rt, sc, C.lane);
        rope_heads<32>(h + 1280, Kd + (size_t)tok * 512, 8, rt, 1.0f, C.lane);
        copy_cols(h + 1792, Vd + (size_t)tok * 512, 512, C.lane);
    }
}
__device__ __forceinline__ void phase_attn_even(const Ctx& C) {
    const bf16_t *Qa = WSP(bf16_t, A_Q1), *Ka = WSP(bf16_t, A_K1), *Va = WSP(bf16_t, A_V1), *Qb = WSP(bf16_t, A_Q2), *Kb = WSP(bf16_t, A_Q2 + 48 * MiB), *Vb = WSP(bf16_t, A_Q2 + 96 * MiB);
    bf16_t* ob = WSP(bf16_t, A_OB); const float* km = WSP(float, WS_KMEAN);
    for (int P = C.bid; P < 512; P += C.G) { const int bh = P >> 3, pi = P & 7, b = bh >> 3, h = bh & 7;
#pragma unroll 1
        for (int s = 0; s < 2; ++s) { const int qb = s ? pi : 15 - pi;
            att::Tens T{Qb + 96 * h, Kb + 96 * h, Vb + 64 * h, ob + 512 + 64 * h, 768, 768, 512, 1024};
            att::unit<96, 64, att::MODE_CAUSAL, false>(T, b, qb, nullptr, 0.f, C.lds, C.tid); } }
    for (int P = C.bid; P < 512; P += C.G) { const int bh = P >> 3, pi = P & 7, b = bh >> 3, h = bh & 7;
#pragma unroll 1
        for (int s = 0; s < 2; ++s) { const int qb = s ? pi : 15 - pi;
            att::Tens T{Qa + 64 * h, Ka + 64 * h, Va + 64 * h, ob + 64 * h, 512, 512, 512, 1024};
            att::unit<64, 64, att::MODE_MOBA, false>(T, b, qb, km + ((size_t)b * 8 + h) * 1024, 0.f, C.lds, C.tid); } }
}
__device__ __forceinline__ void phase_attn_odd(const Ctx& C, const Args& a, int i) {
    const bf16_t *Qc = WSP(bf16_t, A_Q1), *Kc = WSP(bf16_t, A_K1), *Vc = WSP(bf16_t, A_K1 + 8 * MiB), *Qd = WSP(bf16_t, A_V1), *Kd = WSP(bf16_t, A_X1), *Vd = WSP(bf16_t, A_X2);
    bf16_t* ob = WSP(bf16_t, A_OB); float* Od = WSP(float, A_Q2);
    for (int P = C.bid; P < 512; P += C.G) { const int bh = P >> 3, pi = P & 7, b = bh >> 3, st = bh & 7;
#pragma unroll 1
        for (int s = 0; s < 2; ++s) { const int qb = s ? pi : 15 - pi;
            att::Tens T{Qd + 64 * st, Kd + 64 * st, Vd + 128 * (st >> 1), Od + 128 * st, 512, 512, 512, 1024};
            att::unit<64, 128, att::MODE_CAUSAL, true>(T, b, qb, nullptr, 0.f, C.lds, C.tid); } }
    for (int P = C.bid; P < 512; P += C.G) { const int bh = P >> 3, pi = P & 7, b = bh >> 3, h = bh & 7;
        const float sink = a.swa_sinks[i * 8 + h] * LOG2E;
#pragma unroll 1
        for (int s = 0; s < 2; ++s) { const int qb = s ? pi : 15 - pi;
            att::Tens T{Qc + 64 * h, Kc + 64 * (h >> 2), Vc + 64 * (h >> 2), ob + 64 * h, 512, 128, 128, 1024};
            att::unit<64, 64, att::MODE_SWA, false>(T, b, qb, nullptr, sink, C.lds, C.tid); } }
}
__device__ __forceinline__ void phase_diff_combine(const Ctx& C, const Args& a, int i, int l) {
    const float* Od = WSP(float, A_Q2); bf16_t* ob = WSP(bf16_t, A_OB);
    const float* lp = a.diff_lambda + i * 256;
    const float d01 = wave_sum(lp[C.lane] * lp[64 + C.lane]), d23 = wave_sum(lp[128 + C.lane] * lp[192 + C.lane]);
    const float lam_init = 0.8f - 0.6f * expf(-0.3f * (float)l);
    const float lam = expf(d01) - expf(d23) + lam_init;
    const float g0 = a.diff_g_subln[i * 128 + C.lane] * (1.0f - lam_init), g1 = a.diff_g_subln[i * 128 + 64 + C.lane] * (1.0f - lam_init);
    for (int tok = C.gw; tok < NTOK; tok += C.NGW) {
#pragma unroll
        for (int h = 0; h < 4; ++h) { const float* o1 = Od + (size_t)tok * 1024 + 256 * h; const float* o2 = o1 + 128;
            const float v0 = o1[C.lane] - lam * o2[C.lane], v1 = o1[64 + C.lane] - lam * o2[64 + C.lane];
            const float r = 1.0f / sqrtf(wave_sum(v0 * v0 + v1 * v1) * (1.0f / 128.0f) + 1e-5f);
            bf16_t* o = ob + (size_t)tok * 1024 + 512 + 128 * h; o[C.lane] = (bf16_t)f2bf(v0 * r * g0); o[64 + C.lane] = (bf16_t)f2bf(v1 * r * g1); }
    }
}
__device__ __forceinline__ void ln_row(f32x4 (&v)[4], const float* g, const float* bb, int lane) {
    float s = 0.f;
#pragma unroll
    for (int j = 0; j < 4; ++j) s += (v[j][0] + v[j][1]) + (v[j][2] + v[j][3]);
    const float mean = wave_sum(s) * (1.0f / DM); float s2 = 0.f;
#pragma unroll
    for (int j = 0; j < 4; ++j) { v[j] = v[j] - mean; s2 += (v[j][0] * v[j][0] + v[j][1] * v[j][1]) + (v[j][2] * v[j][2] + v[j][3] * v[j][3]); }
    const float rstd = 1.0f / sqrtf(wave_sum(s2) * (1.0f / DM) + 1e-5f);
#pragma unroll
    for (int j = 0; j < 4; ++j) { const f32x4 gg = *(const f32x4*)(g + 4 * lane + 256 * j), b4 = *(const f32x4*)(bb + 4 * lane + 256 * j); v[j] = v[j] * rstd * gg + b4; }
}
__device__ __forceinline__ void phase_ln1(const Ctx& C, const Args& a, int l) {
    float* xf = WSP(float, WS_XF); bf16_t* xs = WSP(bf16_t, A_XS);
    const float* g = a.ln_g + (size_t)(l * 2) * DM; const float* bb = a.ln_b + (size_t)(l * 2) * DM;
    for (int tok = C.gw; tok < NTOK; tok += C.NGW) {
        f32x4 v[4]; float* xr = xf + (size_t)tok * DM + 4 * C.lane;
#pragma unroll
        for (int j = 0; j < 4; ++j) v[j] = *(const f32x4*)(xr + 256 * j);
        ln_row(v, g, bb, C.lane);
        bf16_t* xo = xs + (size_t)tok * 2048 + 4 * C.lane;
#pragma unroll
        for (int j = 0; j < 4; ++j) { *(f32x4*)(xr + 256 * j) = v[j];
            const unsigned h0 = f2bf(v[j][0]), h1 = f2bf(v[j][1]), h2 = f2bf(v[j][2]), h3 = f2bf(v[j][3]);
            u32x2 hi2 = {h0 | (h1 << 16), h2 | (h3 << 16)}; *(u32x2*)(xo + 256 * j) = hi2;
            u32x2 lo2 = {pk2(v[j][0] - bf2f(h0), v[j][1] - bf2f(h1)), pk2(v[j][2] - bf2f(h2), v[j][3] - bf2f(h3))}; *(u32x2*)(xo + 1024 + 256 * j) = lo2; }
    }
}
__device__ __forceinline__ void phase_route(const Ctx& C, const Args& a, int l) {
    const float* lg = WSP(float, A_LOG);
    int* rowtok = WSP(int, WS_ROWTOK); float* tokw = WSP(float, WS_WSLOT); int* toke = WSP(int, WS_TOKE); int* tokp = WSP(int, WS_TOKP);
    unsigned* cnt = WSP(unsigned, WS_CTL) + CW_CNT + 64 * l;
    LAS int* cntw = (LAS int*)C.lds; LAS int* base = cntw + 64; LAS int* ent_e = base + 64; LAS int* ent_r = ent_e + 2048; LAS float* ent_w = (LAS float*)(ent_r + 2048);
    const int tpb = NTOK / C.G, tok0 = C.bid * tpb;
    if (C.tid < 64) cntw[C.tid] = 0;
    __syncthreads();
    const float bias = a.moe_bias[l * 64 + C.lane];
    const int g = C.lane >> 3;
    for (int tl = C.wave; tl < tpb; tl += NWAVES) {
        const int tok = tok0 + tl;
        const float z = lg[(size_t)tok * 256 + C.lane] + lg[(size_t)tok * 256 + 64 + C.lane];
        const float s = 1.0f / (1.0f + expf(-z));
        const float c = s + bias;
        float m1 = c; m1 = fmaxf(m1, __shfl_xor(m1, 1)); m1 = fmaxf(m1, __shfl_xor(m1, 2)); m1 = fmaxf(m1, __shfl_xor(m1, 4));
        const unsigned long long eq = __ballot(c == m1);
        const unsigned geq = (unsigned)(eq >> (8 * g)) & 0xffu;
        const bool is_first = (C.lane & 7) == (int)__builtin_ctz(geq);
        float m2 = is_first ? -INFINITY : c; m2 = fmaxf(m2, __shfl_xor(m2, 1)); m2 = fmaxf(m2, __shfl_xor(m2, 2)); m2 = fmaxf(m2, __shfl_xor(m2, 4));
        const float gs = m1 + m2;
        int grank = 0;
#pragma unroll
        for (int j = 0; j < 8; ++j) { const float gj = __builtin_bit_cast(float, __builtin_amdgcn_readlane(__builtin_bit_cast(int, gs), 8 * j)); grank += (gj > gs || (gj == gs && j < g)) ? 1 : 0; }
        const float v = grank < 4 ? c : -INFINITY;
        int rank = 0;
#pragma unroll
        for (int j = 0; j < 64; ++j) { const float vj = __builtin_bit_cast(float, __builtin_amdgcn_readlane(__builtin_bit_cast(int, v), j)); rank += (vj > v || (vj == v && j < C.lane)) ? 1 : 0; }
        const bool sel = rank < 8;
        const float ssum = wave_sum(sel ? s : 0.f);
        if (sel) { const int r = __hip_atomic_fetch_add(&cntw[C.lane], 1, __ATOMIC_RELAXED, __HIP_MEMORY_SCOPE_WORKGROUP);
            ent_e[tl * 8 + rank] = C.lane; ent_r[tl * 8 + rank] = r; ent_w[tl * 8 + rank] = s / ssum * 2.5f; }
    }
    __syncthreads();
    if (C.tid < 64) base[C.tid] = (int)atomicAdd(&cnt[C.tid], (unsigned)cntw[C.tid]);
    __syncthreads();
    for (int idx = C.tid; idx < tpb * 8; idx += NTHREADS) { const int e = ent_e[idx], pos = base[e] + ent_r[idx], tok = tok0 + (idx >> 3);
        if (pos < CAP) rowtok[(size_t)e * CAP + pos] = tok;
        toke[(size_t)tok0 * 8 + idx] = e; tokp[(size_t)tok0 * 8 + idx] = pos; tokw[(size_t)tok0 * 8 + idx] = ent_w[idx]; }
    __syncthreads();
}
__device__ __forceinline__ void moe_tables(const Ctx& C, int l) {
    const unsigned* cnt = WSP(unsigned, WS_CTL) + CW_CNT + 64 * l;
    LAS int* lcnt = (LAS int*)(C.lds + LX_CNT); LAS int* tst = (LAS int*)(C.lds + LX_TST); LAS unsigned char* texp = (LAS unsigned char*)(C.lds + LX_TEXP);
    __syncthreads();
    if (C.tid < 64) { int c = (int)__hip_atomic_load(cnt + C.tid, __ATOMIC_RELAXED, __HIP_MEMORY_SCOPE_AGENT); if (c > CAP) c = CAP; lcnt[C.tid] = c; }
    __syncthreads();
    if (C.tid == 0) { int acc = 0; for (int e = 0; e < 64; ++e) { tst[e] = acc; acc += (lcnt[e] + 255) >> 8; } tst[64] = acc; }
    __syncthreads();
    if (C.tid < 64) { const int t0 = tst[C.tid], t1 = tst[C.tid + 1]; for (int t = t0; t < t1; ++t) texp[t] = (unsigned char)C.tid; }
    __syncthreads();
}
template <bool GATHER_> struct MoeOrder {
    static constexpr bool GATHER = GATHER_;
    const LAS int* lcnt; const LAS int* tst; const LAS unsigned char* texp; const int* rowtok;
    int TR, nsh, NC, G, c; int sh_orow0;
    __device__ __forceinline__ bool next(int i, pg8::Unit& u) const {
        const long L = (long)i * G + c; if (L >= (long)(TR + nsh) * NC) return false;
        const int r = (int)(L / NC), cn = (int)(L % NC);
        if (r < TR) { const int e = __builtin_amdgcn_readfirstlane((int)texp[r]); u.e = e; u.lt = r - __builtin_amdgcn_readfirstlane(tst[e]); u.pm = r; u.orow = r * 256; }
        else { u.e = 64; u.lt = r - TR; u.pm = TR_MAX + (r - TR); u.orow = sh_orow0 + u.lt * 256; }
        u.pn = u.e * NC + cn; u.ocol = cn * (NC == 2 ? 128 : 256);
        return true;
    }
    __device__ __forceinline__ unsigned arow(const pg8::Unit& u, int r) const {
        if (!GATHER) return (unsigned)(u.pm * 256 + r);
        const int loc = u.lt * 256 + r;
        if (u.e == 64) return (unsigned)loc;
        return loc < __builtin_amdgcn_readfirstlane(lcnt[u.e]) ? (unsigned)rowtok[(size_t)u.e * CAP + loc] : 0u;
    }
};
__device__ __forceinline__ void phase_combine_ln2(const Ctx& C, const Args& a, int l) {
    float* xf = WSP(float, WS_XF); bf16_t* xb = WSP(bf16_t, WS_HS); const bf16_t* Ys = WSP(bf16_t, WS_YS);
    const int* toke = WSP(int, WS_TOKE); const int* tokp = WSP(int, WS_TOKP); const float* tokw = WSP(float, WS_WSLOT);
    const LAS int* tst = (const LAS int*)(C.lds + LX_TST);
    const float* g = a.ln_g + (size_t)(l * 2 + 1) * DM; const float* bb = a.ln_b + (size_t)(l * 2 + 1) * DM;
    for (int tok = C.gw; tok < NTOK; tok += C.NGW) {
        f32x4 v[4]; float* xr = xf + (size_t)tok * DM + 4 * C.lane;
#pragma unroll
        for (int j = 0; j < 4; ++j) v[j] = *(const f32x4*)(xr + 256 * j);
#pragma unroll
        for (int k = 0; k < 8; ++k) { const int e = toke[(size_t)tok * 8 + k], pos = tokp[(size_t)tok * 8 + k]; const float gw = tokw[(size_t)tok * 8 + k]; const size_t slot = (size_t)tst[e] * 256 + pos;
            const bf16_t* yr = Ys + slot * DM + 4 * C.lane;
#pragma unroll
            for (int j = 0; j < 4; ++j) { const u32x2 w = *(const u32x2*)(yr + 256 * j); v[j][0] += gw * bf2f(w.x & 0xffffu); v[j][1] += gw * bf2f(w.x >> 16); v[j][2] += gw * bf2f(w.y & 0xffffu); v[j][3] += gw * bf2f(w.y >> 16); } }
        ln_row(v, g, bb, C.lane);
        bf16_t* xo = xb + (size_t)tok * DM + 4 * C.lane;
#pragma unroll
        for (int j = 0; j < 4; ++j) { *(f32x4*)(xr + 256 * j) = v[j]; u32x2 w = {pk2(v[j][0], v[j][1]), pk2(v[j][2], v[j][3])}; *(u32x2*)(xo + 256 * j) = w;
            if (l == DEPTH - 1) *(f32x4*)(a.out + (size_t)tok * DM + 4 * C.lane + 256 * j) = v[j]; }
    }
}
constexpr int STEPS_PER_LAYER = 15, NSTEPS = 1 + STEPS_PER_LAYER * DEPTH;
#define CAS __attribute__((address_space(4)))
template <int STEP> __device__ __forceinline__ void step_fn(const CAS Args* ka, LAS unsigned char* lds_base, int l, int wv) {
#if defined(__HIP_DEVICE_COMPILE__)
    const Args a = *ka;
#else
    const Args a{};
#endif
    int lane_; asm volatile("v_mbcnt_lo_u32_b32 %0, -1, 0\n\tv_mbcnt_hi_u32_b32 %0, -1, %0" : "=v"(lane_)); asm volatile("" : "+s"(wv)); int tid_ = wv * 64 + lane_; asm volatile("" : "+v"(tid_));
    LAS unsigned char* lds_l = lds_base; asm volatile("" : "+s"(lds_l));
    Ctx C; C.lds = lds_l; C.ws = a.ws; C.tid = tid_; C.lane = C.tid & 63; C.wave = __builtin_amdgcn_readfirstlane(C.tid >> 6);
    int G_ = gridDim.x, bid_ = blockIdx.x; asm volatile("" : "+s"(G_), "+s"(bid_));
    C.G = G_; C.bid = bid_; C.gw = C.bid * NWAVES + C.wave; C.NGW = C.G * NWAVES;
    asm volatile("; STEP_BEGIN %0" :: "n"(STEP));
    const int i = l >> 1; const bool even = !(l & 1);
    const size_t swl = WS_SMALLW + (size_t)l * SW_LAYER;
    if constexpr (STEP == 99) phase_init(C, a);
    if constexpr (STEP == 0) phase_convert(C, a, l);
    if constexpr (STEP == 1) { pg8::Gemm g{WSP(bf16_t, WS_HS), WSP(bf16_t, swl), DM, DM}; pg8::StaticOrder S; S.init(NTOK, even ? 2048 : 2304, C.G, C.bid);
        pg8::EpiBf16 E{WSP(bf16_t, A_HB), HB_LD}; pg8::gemm_phase<pg8::EpiBf16, pg8::StaticOrder, true>(C.lds, g, S, E, C.tid); }
    if constexpr (STEP == 2) { if (even) phase_prep_even(C, a, i); else phase_prep_odd(C); }
    if constexpr (STEP == 3) { phase_kmean(C);
        { pg8::Gemm g{WSP(bf16_t, A_X1), WSP(bf16_t, swl + SW_WQB), 256, 256}; pg8::StaticOrder S; S.init(NTOK, 768, C.G, C.bid);
          pg8::EpiBf16 E{WSP(bf16_t, A_QF), 768}; pg8::gemm_phase<pg8::EpiBf16, pg8::StaticOrder, true>(C.lds, g, S, E, C.tid); }
        { pg8::Gemm g{WSP(bf16_t, A_X1 + 16 * MiB), WSP(bf16_t, swl + SW_WKVB), 256, 256}; pg8::StaticOrder S; S.init(NTOK, 1024, C.G, C.bid);
          pg8::EpiBf16 E{WSP(bf16_t, A_KVF), 1024}; pg8::gemm_phase<pg8::EpiBf16, pg8::StaticOrder, true>(C.lds, g, S, E, C.tid); } }
    if constexpr (STEP == 4) phase_prep_mla(C);
    if constexpr (STEP == 5) { if (even) phase_attn_even(C); else phase_attn_odd(C, a, i); }
    if constexpr (STEP == 6) phase_diff_combine(C, a, i, l);
    if constexpr (STEP == 7) { pg8::Gemm g{WSP(bf16_t, A_OB), WSP(bf16_t, swl + SW_WOUT), DM, DM}; pg8::StaticOrder S; S.init(NTOK, DM, C.G, C.bid);
        pg8::EpiResid E{l == 0 ? a.x : WSP(float, WS_XF), WSP(float, WS_XF), DN_ALPHA}; pg8::gemm_phase<pg8::EpiResid, pg8::StaticOrder, true>(C.lds, g, S, E, C.tid); }
    if constexpr (STEP == 8) phase_ln1(C, a, l);
    if constexpr (STEP == 9) { pg8::Gemm g{WSP(bf16_t, A_XS), WSP(bf16_t, WS_WR + (size_t)l * MiB), 2048, 2048}; pg8::StaticOrder S; S.init(NTOK, 256, C.G, C.bid);
        pg8::EpiF32 E{WSP(float, A_LOG), 256}; pg8::gemm_phase<pg8::EpiF32, pg8::StaticOrder, true>(C.lds, g, S, E, C.tid); }
    if constexpr (STEP == 10) phase_route(C, a, l);
    if constexpr (STEP == 11) { moe_tables(C, l);
        const LAS int* tst = (const LAS int*)(C.lds + LX_TST);
        MoeOrder<true> S{(const LAS int*)(C.lds + LX_CNT), tst, (const LAS unsigned char*)(C.lds + LX_TEXP), WSP(int, WS_ROWTOK), __builtin_amdgcn_readfirstlane(tst[64]), 128, 2, C.G, C.bid, SLOTS_R};
        pg8::Gemm g{WSP(bf16_t, A_XS), WSP(bf16_t, WS_WGU), 2048, DM}; pg8::EpiSwiGLU E{WSP(bf16_t, WS_HS)};
        pg8::gemm_phase<pg8::EpiSwiGLU, MoeOrder<true>, true>(C.lds, g, S, E, C.tid); }
    if constexpr (STEP == 12) { moe_tables(C, l);
        const LAS int* tst = (const LAS int*)(C.lds + LX_TST);
        MoeOrder<false> S{(const LAS int*)(C.lds + LX_CNT), tst, (const LAS unsigned char*)(C.lds + LX_TEXP), WSP(int, WS_ROWTOK), __builtin_amdgcn_readfirstlane(tst[64]), 0, 4, C.G, C.bid, 0};
        pg8::Gemm g{WSP(bf16_t, WS_HS), WSP(bf16_t, WS_WD), DE, DE}; pg8::EpiBf16 E{WSP(bf16_t, WS_YS), DM};
        pg8::gemm_phase<pg8::EpiBf16, MoeOrder<false>, true>(C.lds, g, S, E, C.tid); }
    if constexpr (STEP == 13) { moe_tables(C, l);
        const LAS int* tst = (const LAS int*)(C.lds + LX_TST);
        MoeOrder<false> S{(const LAS int*)(C.lds + LX_CNT), tst, (const LAS unsigned char*)(C.lds + LX_TEXP), WSP(int, WS_ROWTOK), 0, 128, 4, C.G, C.bid, 0};
        pg8::Gemm g{WSP(bf16_t, WS_HS), WSP(bf16_t, WS_WD), DE, DE}; pg8::EpiResid E{WSP(float, WS_XF), WSP(float, WS_XF), DN_ALPHA};
        pg8::gemm_phase<pg8::EpiResid, MoeOrder<false>, true>(C.lds, g, S, E, C.tid); }
    if constexpr (STEP == 14) { moe_tables(C, l); phase_combine_ln2(C, a, l); }
}
__global__ void __launch_bounds__(NTHREADS, 2) mega_fwd(Args a) {
    extern __shared__ __attribute__((aligned(16))) unsigned char lds_raw[];
    LAS unsigned char* lds = (LAS unsigned char*)lds_raw;
    const CAS Args* ka = (const CAS Args*)__builtin_amdgcn_kernarg_segment_ptr();
    const int wv = __builtin_amdgcn_readfirstlane(threadIdx.x >> 6);
    if (threadIdx.x < 4) ((LAS unsigned*)(lds + LX_BAR))[threadIdx.x] = 0u;
    __syncthreads();
    unsigned* barw = (unsigned*)(a.ws + WS_CTL) + CW_BAR;
    XcdBarrier bar; bar.bar = barw; bar.x = 0; bar.st = nullptr;
    if (a.use_bar) bar = xcd_barrier_post(barw, (volatile LAS unsigned*)(lds + LX_BAR));
    int step = 0;
#define RUN(K, cond) do { if (step >= a.st_lo && step < a.st_hi) { if (cond) { const CAS Args* kp = ka; asm volatile("" : "+s"(kp)); step_fn<K>(kp, lds, l, wv); } if (a.use_bar && step + 1 < a.st_hi) { XcdBarrier b2 = bar; asm volatile("" : "+s"(b2.bar)); int w2 = wv; asm volatile("" : "+s"(w2)); int l2_; asm volatile("v_mbcnt_lo_u32_b32 %0, -1, 0\n\tv_mbcnt_hi_u32_b32 %0, -1, %0" : "=v"(l2_)); xcd_barrier(b2, w2 == 0 && l2_ == 0); } } ++step; } while (0)
    { const int l = 0; RUN(99, true); }
#pragma unroll 1
    for (int l = 0; l < DEPTH; ++l) {
        const bool even = !(l & 1);
        RUN(0, true); RUN(1, true); RUN(2, true); RUN(3, even); RUN(4, even); RUN(5, true); RUN(6, !even); RUN(7, true);
        RUN(8, true); RUN(9, true); RUN(10, true); RUN(11, true); RUN(12, true); RUN(13, true); RUN(14, true);
    }
#undef RUN
}

extern "C" void kernel_launch(void* const* d_in, const int* in_sizes, int n_in, void* d_out, int out_size, void* d_ws, size_t ws_size, hipStream_t stream) {
    static int grid = 0;
    if (grid == 0) {
        if (n_in != 23 || out_size != NTOK * DM || ws_size < WS_END) { fprintf(stderr, "kernel_launch: unexpected problem shape (n_in %d out %d ws %zu)\n", n_in, out_size, ws_size); grid = -1; return; }
        int dev = 0, cus = 0;
        if (hipGetDevice(&dev) != hipSuccess || hipDeviceGetAttribute(&cus, hipDeviceAttributeMultiprocessorCount, dev) != hipSuccess) { grid = -1; return; }
        if (hipFuncSetAttribute((const void*)mega_fwd, hipFuncAttributeMaxDynamicSharedMemorySize, LDS_BYTES) != hipSuccess) { fprintf(stderr, "kernel_launch: hipFuncSetAttribute failed\n"); grid = -1; return; }
        int per_cu = 0;
        if (hipOccupancyMaxActiveBlocksPerMultiprocessor(&per_cu, (const void*)mega_fwd, NTHREADS, LDS_BYTES) != hipSuccess || per_cu < 1) { fprintf(stderr, "kernel_launch: occupancy query says %d\n", per_cu); }
        (void)hipGetLastError();
        grid = cus;
    }
    if (grid < 0) return;
    if (hipMemsetAsync((char*)d_ws + WS_CTL, 0, CTL_ZERO_BYTES, stream) != hipSuccess) return;
    Args a{};
    a.x = (const float*)d_in[0]; a.pos = (const int*)d_in[1];
    a.ev_w_in = (const float*)d_in[2]; a.ev_w_out = (const float*)d_in[3]; a.mla_g_qa = (const float*)d_in[4]; a.mla_w_qb = (const float*)d_in[5]; a.mla_g_kva = (const float*)d_in[6]; a.mla_w_kvb = (const float*)d_in[7];
    a.od_w_in = (const float*)d_in[8]; a.od_w_out = (const float*)d_in[9]; a.swa_sinks = (const float*)d_in[10]; a.diff_lambda = (const float*)d_in[11]; a.diff_g_subln = (const float*)d_in[12];
    a.ln_g = (const float*)d_in[13]; a.ln_b = (const float*)d_in[14]; a.moe_w_router = (const float*)d_in[15]; a.moe_bias = (const float*)d_in[16];
    a.moe_w_gate = (const float*)d_in[17]; a.moe_w_up = (const float*)d_in[18]; a.moe_w_down = (const float*)d_in[19]; a.sh_w_gate = (const float*)d_in[20]; a.sh_w_up = (const float*)d_in[21]; a.sh_w_down = (const float*)d_in[22];
    a.out = (float*)d_out; a.ws = (unsigned char*)d_ws;
#ifndef MK_ONE_LAUNCH
#define MK_ONE_LAUNCH 0
#endif
    if (MK_ONE_LAUNCH) {
        a.st_lo = 0; a.st_hi = NSTEPS; a.use_bar = 1;
        hipLaunchKernelGGL(mega_fwd, dim3(grid), dim3(NTHREADS), LDS_BYTES, stream, a);
    } else {
        for (int s = 0; s < NSTEPS; ++s) {
            if (s > 0) { const int ls = (s - 1) % STEPS_PER_LAYER, l = (s - 1) / STEPS_PER_LAYER; const bool even = !(l & 1);
                if (even && ls == 6) continue; if (!even && (ls == 3 || ls == 4)) continue; }
            a.st_lo = s; a.st_hi = s + 1; a.use_bar = 0;
            hipLaunchKernelGGL(mega_fwd, dim3(grid), dim3(NTHREADS), LDS_BYTES, stream, a);
        }
    }
}
```

```cpp
#include <hip/hip_runtime.h>
#include <cstdio>
#include <cstdint>

#define GAS __attribute__((address_space(1)))
#define LAS __attribute__((address_space(3)))
typedef unsigned short bf16_t;
typedef short bf16x8 __attribute__((ext_vector_type(8)));
typedef short s16x4 __attribute__((ext_vector_type(4)));
typedef float f32x2 __attribute__((ext_vector_type(2)));
typedef float f32x4 __attribute__((ext_vector_type(4)));
typedef float f32x16 __attribute__((ext_vector_type(16)));
typedef unsigned u32x2 __attribute__((ext_vector_type(2)));
typedef unsigned u32x4 __attribute__((ext_vector_type(4)));

constexpr int NTOK = 32768, DM = 1024, SEQ = 4096, NBATCH = 8, DEPTH = 4;
constexpr int EV_IN = 1952, OD_IN = 2304, HB_LD = 2304;
constexpr int NE = 64, DE = 256, TOPK = 8, CAP = 32768;
constexpr int TR_MAX = 1088;
constexpr int SLOTS_R = TR_MAX * 256;
constexpr int SLOTS = SLOTS_R + NTOK;
constexpr float DN_ALPHA = 1.681792830507429f;
constexpr float LOG2E = 1.4426950408889634f;

__device__ __forceinline__ unsigned f2bf(float f) { unsigned u = __builtin_bit_cast(unsigned, f); return (u + 0x7fffu + ((u >> 16) & 1u)) >> 16; }
__device__ __forceinline__ float bf2f(unsigned b) { return __builtin_bit_cast(float, b << 16); }
__device__ __forceinline__ unsigned pk2(float lo, float hi) { return f2bf(lo) | (f2bf(hi) << 16); }
__device__ __forceinline__ float wave_sum(float v) {
#pragma unroll
    for (int o = 1; o < 64; o <<= 1) v += __shfl_xor(v, o);
    return v;
}
namespace pg8 {
constexpr int BM = 256, BK = 64, HALF = 128, HTB = HALF * BK * 2  , STAGE_BYTES = 8 * HTB, NXCD = 8, WGM = 8;
__host__ __device__ __forceinline__ int lds_byte(int r, int c) { const int st = (r >> 4) * 2 + (c >> 5), rr = r & 15, cc = c & 31, ob = rr * 64 + cc * 2; return st * 1024 + (ob ^ (((ob >> 9) & 1) << 5)); }
__host__ __device__ __forceinline__ void stage_rc(int b, int& R, int& C) { const int st = b / 1024, sb = b % 1024, swz = sb ^ (((sb >> 9) & 1) << 5); R = (st >> 1) * 16 + swz / 64; C = (st & 1) * 32 + (swz % 64) / 2; }
__host__ __device__ __forceinline__ int perm32(int rho) { const int n = rho >> 4, i = rho & 15; return 8 * (i >> 2) + 4 * n + (i & 3); }

struct Unit { int pm, pn, orow, ocol, e, lt; };
struct Gemm { const bf16_t* A; const bf16_t* Bt; int lda, K; };

struct StaticOrder {
    static constexpr bool GATHER = false;
    int nM, nN, nwg, G, c;
    __device__ void init(int M, int N, int G_, int c_) { nM = M / BM; nN = N / BM; nwg = nM * nN; G = G_; c = c_; }
    __device__ __forceinline__ bool next(int i, Unit& u) const {
        const long L = (long)i * G + c; if (L >= nwg) return false;
        int wgid = (int)L; { const int q = nwg / NXCD, r = nwg % NXCD, xcd = wgid % NXCD, off = wgid / NXCD; wgid = (xcd < r ? xcd * (q + 1) : r * (q + 1) + (xcd - r) * q) + off; }
        const int nig = WGM * nN, gid = wgid / nig, fm = gid * WGM, gsz = (nM - fm) < WGM ? (nM - fm) : WGM;
        u.pm = fm + ((wgid % nig) % gsz); u.pn = (wgid % nig) / gsz; u.orow = u.pm * BM; u.ocol = u.pn * BM; u.e = 0; u.lt = u.pm; return true;
    }
    __device__ __forceinline__ unsigned arow(const Unit& u, int r) const { return (unsigned)(u.pm * BM + r); }
};

__device__ __forceinline__ unsigned cvt_pk_bf16(float lo, float hi) { unsigned r; asm volatile("v_cvt_pk_bf16_f32 %0, %1, %2" : "=v"(r) : "v"(lo), "v"(hi)); return r; }

struct EpiBf16 {
    static constexpr bool PERM = true;
    bf16_t* O; int ldc;
    __device__ __forceinline__ void operator()(const f32x4 (&acc)[2][2][4][2], const Unit& u, int wr, int wc, int fr, int fq) const {
        const int row0 = u.orow + wr * 64 + fr, col0 = u.ocol + wc * 32 + 8 * fq;
#pragma unroll
        for (int ai = 0; ai < 2; ++ai)
#pragma unroll
            for (int m = 0; m < 4; ++m) { bf16_t* rowp = O + (size_t)(row0 + ai * HALF + m * 16) * ldc + col0;
#pragma unroll
                for (int bj = 0; bj < 2; ++bj) { const f32x4 v0 = acc[ai][bj][m][0], v1 = acc[ai][bj][m][1];
                    u32x4 w; w.x = cvt_pk_bf16(v0[0], v0[1]); w.y = cvt_pk_bf16(v0[2], v0[3]); w.z = cvt_pk_bf16(v1[0], v1[1]); w.w = cvt_pk_bf16(v1[2], v1[3]);
                    *(u32x4*)(rowp + bj * HALF) = w; } }
    }
};
struct EpiF32 {
    static constexpr bool PERM = false;
    float* C; int ldc;
    __device__ __forceinline__ void operator()(const f32x4 (&acc)[2][2][4][2], const Unit& u, int wr, int wc, int fr, int fq) const {
        const int row0 = u.orow + wr * 64 + fr, col0 = u.ocol + wc * 32 + 4 * fq;
#pragma unroll
        for (int ai = 0; ai < 2; ++ai)
#pragma unroll
            for (int m = 0; m < 4; ++m) { float* rowp = C + (size_t)(row0 + ai * HALF + m * 16) * ldc + col0;
#pragma unroll
                for (int bj = 0; bj < 2; ++bj)
#pragma unroll
                    for (int n = 0; n < 2; ++n) *(f32x4*)(rowp + bj * HALF + n * 16) = acc[ai][bj][m][n]; }
    }
};
struct EpiResid {
    static constexpr bool PERM = false;
    const float* src; float* dst; float alpha;
    __device__ __forceinline__ void operator()(const f32x4 (&acc)[2][2][4][2], const Unit& u, int wr, int wc, int fr, int fq) const {
        const int row0 = u.orow + wr * 64 + fr, col0 = u.ocol + wc * 32 + 4 * fq;
#pragma unroll
        for (int ai = 0; ai < 2; ++ai)
#pragma unroll
            for (int m = 0; m < 4; ++m) { const size_t ro = (size_t)(row0 + ai * HALF + m * 16) * DM + col0;
#pragma unroll
                for (int bj = 0; bj < 2; ++bj)
#pragma unroll
                    for (int n = 0; n < 2; ++n) { const f32x4 s = *(const f32x4*)(src + ro + bj * HALF + n * 16); *(f32x4*)(dst + ro + bj * HALF + n * 16) = s * alpha + acc[ai][bj][m][n]; } }
    }
};
struct EpiSwiGLU {
    static constexpr bool PERM = true;
    bf16_t* H;
    __device__ __forceinline__ void operator()(const f32x4 (&acc)[2][2][4][2], const Unit& u, int wr, int wc, int fr, int fq) const {
        const int row0 = u.orow + wr * 64 + fr, col0 = u.ocol + wc * 32 + 8 * fq;
#pragma unroll
        for (int ai = 0; ai < 2; ++ai)
#pragma unroll
            for (int m = 0; m < 4; ++m) { bf16_t* rowp = H + (size_t)(row0 + ai * HALF + m * 16) * DE + col0;
                float h[8];
#pragma unroll
                for (int n = 0; n < 2; ++n)
#pragma unroll
                    for (int j = 0; j < 4; ++j) { const float g = acc[ai][0][m][n][j], up = acc[ai][1][m][n][j]; h[n * 4 + j] = g / (1.0f + __expf(-g)) * up; }
                u32x4 w; w.x = cvt_pk_bf16(h[0], h[1]); w.y = cvt_pk_bf16(h[2], h[3]); w.z = cvt_pk_bf16(h[4], h[5]); w.w = cvt_pk_bf16(h[6], h[7]);
                *(u32x4*)rowp = w; }
    }
};
struct EpiDown {
    static constexpr bool PERM = true;
    bf16_t* Y; const float* wslot; const LAS int* cnt;
    __device__ __forceinline__ void operator()(const f32x4 (&acc)[2][2][4][2], const Unit& u, int wr, int wc, int fr, int fq) const {
        const int rl0 = wr * 64 + fr, col0 = u.ocol + wc * 32 + 8 * fq; const int ce = cnt[u.e];
#pragma unroll
        for (int ai = 0; ai < 2; ++ai)
#pragma unroll
            for (int m = 0; m < 4; ++m) { const int rl = rl0 + ai * HALF + m * 16, loc = u.lt * BM + rl;
                const float gw = loc < ce ? wslot[(size_t)u.e * CAP + loc] : 0.f;
                bf16_t* rowp = Y + (size_t)(u.orow + rl) * DM + col0;
#pragma unroll
                for (int bj = 0; bj < 2; ++bj) { const f32x4 v0 = acc[ai][bj][m][0] * gw, v1 = acc[ai][bj][m][1] * gw;
                    u32x4 w; w.x = cvt_pk_bf16(v0[0], v0[1]); w.y = cvt_pk_bf16(v0[2], v0[3]); w.z = cvt_pk_bf16(v1[0], v1[1]); w.w = cvt_pk_bf16(v1[2], v1[3]);
                    *(u32x4*)(rowp + bj * HALF) = w; } }
    }
};

template <class Epi, class Sched, bool ALIGN_EPI>
__device__ __forceinline__ void gemm_phase(LAS unsigned char* lds, const Gemm g, const Sched& S, const Epi& E, const int tid) {
    const int wid = __builtin_amdgcn_readfirstlane(tid >> 6), lane = tid & 63, wr = wid >> 2, wc = wid & 3, fr = lane & 15, fq = lane >> 4;
    const int K = g.K, nt = K / BK;
    constexpr bool GATHER = Sched::GATHER;
    int Ra[2]; unsigned Ca[2], voffA[2], voffB[2];
    const unsigned ldab = (unsigned)g.lda * 2u;
#pragma unroll
    for (int i = 0; i < 2; ++i) { int R, C; stage_rc(tid * 16 + i * 8192, R, C); const int Rb = Epi::PERM ? ((R & ~31) + perm32(R & 31)) : R;
        Ra[i] = R; Ca[i] = (unsigned)C * 2u; voffA[i] = (unsigned)R * ldab + (unsigned)C * 2u; voffB[i] = (unsigned)(Rb * K + C) * 2u; }
    const size_t hstepA = (size_t)HALF * ldab;
    const size_t kstep = (size_t)(BK * 2);
    const size_t hstep = (size_t)HALF * K * 2;
    const size_t tstep = 2 * hstep;
    const unsigned ldsw = (unsigned)wid * 1024u;
    const int aoff = lds_byte(wr * 64 + fr, fq * 8), boff = lds_byte(wc * 32 + fr, fq * 8);
    const char* Ab = (const char*)g.A;
#define PG8_SA(b, h) (((b) * 2 + (h)) * HTB)
#define PG8_SB(b, h) ((4 + (b) * 2 + (h)) * HTB)
#define PG8_STAGE(bufoff, gbase, voff) do { _Pragma("unroll") for (int _i = 0; _i < 2; ++_i) \
        __builtin_amdgcn_global_load_lds((const unsigned*)((const char*)(gbase) + (voff)[_i]), (LAS unsigned*)(lds + (bufoff) + ldsw + _i * 8192), 16, 0, 0); } while (0)
#define PG8_STAGEA(bufoff, offs, ubase, h, kbyte) do { _Pragma("unroll") for (int _i = 0; _i < 2; ++_i) { \
        const char* _src = GATHER ? Ab + (size_t)(offs)[h][_i] + (size_t)(kbyte) : (ubase) + (size_t)(h) * hstepA + (size_t)(kbyte) + voffA[_i]; \
        __builtin_amdgcn_global_load_lds((const unsigned*)_src, (LAS unsigned*)(lds + (bufoff) + ldsw + _i * 8192), 16, 0, 0); } } while (0)
#define PG8_OFFS(dst, u) do { if constexpr (GATHER) { _Pragma("unroll") for (int _h = 0; _h < 2; ++_h) _Pragma("unroll") for (int _i = 0; _i < 2; ++_i) dst[_h][_i] = S.arow(u, _h * HALF + Ra[_i]) * ldab + Ca[_i]; } } while (0)
#define PG8_LDA(dst, b, h) do { _Pragma("unroll") for (int m = 0; m < 4; ++m) _Pragma("unroll") for (int k = 0; k < 2; ++k) dst[m][k] = *(const LAS bf16x8*)(lds + PG8_SA(b, h) + aoff + m * 2048 + k * 1024); } while (0)
#define PG8_LDB(dst, b, h) do { _Pragma("unroll") for (int n = 0; n < 2; ++n) _Pragma("unroll") for (int k = 0; k < 2; ++k) dst[n][k] = *(const LAS bf16x8*)(lds + PG8_SB(b, h) + boff + n * 2048 + k * 1024); } while (0)
#define PG8_MMA(ai, bj, At, Bt) do { __builtin_amdgcn_s_setprio(1); _Pragma("unroll") for (int m = 0; m < 4; ++m) _Pragma("unroll") for (int n = 0; n < 2; ++n) _Pragma("unroll") for (int k = 0; k < 2; ++k) \
        acc[ai][bj][m][n] = __builtin_amdgcn_mfma_f32_16x16x32_bf16(Bt[n][k], At[m][k], acc[ai][bj][m][n], 0, 0, 0); __builtin_amdgcn_s_setprio(0); } while (0)
#define PG8_WAIT_V(n) asm volatile("s_waitcnt vmcnt(" #n ")" ::: "memory")
#define PG8_WAIT_L(n) asm volatile("s_waitcnt lgkmcnt(" #n ")" ::: "memory")
#define PG8_BAR __builtin_amdgcn_s_barrier()
#define PG8_SCHED __builtin_amdgcn_sched_barrier(0)
    Unit cur, nxt; int ui = 0;
    if (!S.next(0, cur)) return;
    f32x4 acc[2][2][4][2];
#pragma unroll
    for (int a = 0; a < 2; ++a)
#pragma unroll
        for (int b = 0; b < 2; ++b)
#pragma unroll
            for (int m = 0; m < 4; ++m)
#pragma unroll
                for (int n = 0; n < 2; ++n) acc[a][b][m][n] = (f32x4){0.f, 0.f, 0.f, 0.f};
    bf16x8 At[4][2], B0[2][2], B1[2][2];
    unsigned oc[2][2] = {{0u, 0u}, {0u, 0u}}, on[2][2] = {{0u, 0u}, {0u, 0u}};
    PG8_OFFS(oc, cur);
    const char* cA = Ab + (size_t)S.arow(cur, 0) * ldab;
    const char* cB = (const char*)g.Bt + (size_t)cur.pn * tstep;
    PG8_STAGE(PG8_SB(0, 0), cB, voffB); PG8_STAGE(PG8_SB(0, 1), cB + hstep, voffB); PG8_STAGEA(PG8_SA(0, 0), oc, cA, 0, 0); PG8_STAGEA(PG8_SA(0, 1), oc, cA, 1, 0);
    if (wr == 1) PG8_BAR;
    PG8_WAIT_V(2); PG8_BAR;
    PG8_STAGE(PG8_SB(1, 0), cB + kstep, voffB); PG8_STAGEA(PG8_SA(1, 0), oc, cA, 0, kstep); PG8_STAGE(PG8_SB(1, 1), cB + hstep + kstep, voffB);
    PG8_WAIT_V(6); PG8_BAR;
    for (;;) {
        const bool has_next = S.next(ui + 1, nxt);
        if (has_next) { PG8_OFFS(on, nxt); } else {
#pragma unroll
            for (int h = 0; h < 2; ++h)
#pragma unroll
                for (int i = 0; i < 2; ++i) on[h][i] = oc[h][i]; }
        const char* nB = has_next ? (const char*)g.Bt + (size_t)nxt.pn * tstep : cB;
        const char* nA = has_next ? Ab + (size_t)S.arow(nxt, 0) * ldab : cA;
        for (int t = 0; t < nt; t += 2) {
            const bool last = (t == nt - 2);
            const size_t k1 = (size_t)(t + 1) * kstep;
            const size_t k2 = last ? 0 : (size_t)(t + 2) * kstep, k3 = k2 + kstep;
            const char* b2 = last ? nB : cB + (size_t)(t + 2) * kstep; const char* b3 = b2 + kstep;
            unsigned o2[2][2]; const char* a2 = last ? nA : cA;
#pragma unroll
            for (int h = 0; h < 2; ++h)
#pragma unroll
                for (int i = 0; i < 2; ++i) o2[h][i] = last ? on[h][i] : oc[h][i];
            PG8_LDB(B0, 0, 0); PG8_LDB(B1, 0, 1); PG8_SCHED; PG8_LDA(At, 0, 0); PG8_STAGEA(PG8_SA(1, 1), oc, cA, 1, k1);
            PG8_WAIT_V(8); PG8_WAIT_L(0); PG8_BAR; PG8_MMA(0, 0, At, B0); PG8_MMA(0, 1, At, B1); PG8_BAR; PG8_SCHED;
            PG8_LDA(At, 0, 1); PG8_STAGE(PG8_SB(0, 0), b2, voffB); PG8_STAGE(PG8_SB(0, 1), b2 + hstep, voffB); PG8_STAGEA(PG8_SA(0, 0), o2, a2, 0, k2);
            PG8_WAIT_V(8); PG8_WAIT_L(0); PG8_BAR; PG8_MMA(1, 0, At, B0); PG8_MMA(1, 1, At, B1); PG8_BAR; PG8_SCHED;
            PG8_LDB(B0, 1, 0); PG8_LDB(B1, 1, 1); PG8_SCHED; PG8_LDA(At, 1, 0); PG8_STAGEA(PG8_SA(0, 1), o2, a2, 1, k2);
            PG8_WAIT_V(8); PG8_WAIT_L(0); PG8_BAR; PG8_MMA(0, 0, At, B0); PG8_MMA(0, 1, At, B1); PG8_BAR; PG8_SCHED;
            PG8_LDA(At, 1, 1); PG8_STAGE(PG8_SB(1, 0), b3, voffB); PG8_STAGE(PG8_SB(1, 1), b3 + hstep, voffB); PG8_STAGEA(PG8_SA(1, 0), o2, a2, 0, k3);
            PG8_WAIT_V(8); PG8_WAIT_L(0); PG8_BAR; PG8_MMA(1, 0, At, B0); PG8_MMA(1, 1, At, B1); PG8_BAR; PG8_SCHED;
        }
        if constexpr (ALIGN_EPI) { if (wr == 0) PG8_BAR; }
        { int l2; asm volatile("v_mbcnt_lo_u32_b32 %0, -1, 0\n\tv_mbcnt_hi_u32_b32 %0, -1, %0" : "=v"(l2)); E(acc, cur, wr, wc, l2 & 15, l2 >> 4); }
        if (!has_next) break;
#pragma unroll
        for (int a = 0; a < 2; ++a)
#pragma unroll
            for (int b = 0; b < 2; ++b)
#pragma unroll
                for (int m = 0; m < 4; ++m)
#pragma unroll
                    for (int n = 0; n < 2; ++n) acc[a][b][m][n] = (f32x4){0.f, 0.f, 0.f, 0.f};
        cur = nxt; cB = nB; cA = nA; ++ui;
#pragma unroll
        for (int h = 0; h < 2; ++h)
#pragma unroll
            for (int i = 0; i < 2; ++i) oc[h][i] = on[h][i];
        if constexpr (ALIGN_EPI) { if (wr == 1) PG8_BAR; }
    }
    PG8_WAIT_V(0);
    if constexpr (!ALIGN_EPI) { if (wr == 0) PG8_BAR; }
    PG8_BAR;
#undef PG8_SA
#undef PG8_SB
#undef PG8_STAGE
#undef PG8_STAGEA
#undef PG8_OFFS
#undef PG8_LDA
#undef PG8_LDB
#undef PG8_MMA
#undef PG8_WAIT_V
#undef PG8_WAIT_L
#undef PG8_BAR
#undef PG8_SCHED
}
}
namespace att {
constexpr int MODE_CAUSAL = 0, MODE_MOBA = 1, MODE_SWA = 2;
constexpr int KPAD = 8;
__device__ __forceinline__ unsigned cvtpk(float lo, float hi) { unsigned r; asm volatile("v_cvt_pk_bf16_f32 %0, %1, %2" : "=v"(r) : "v"(lo), "v"(hi)); return r; }
template <int DK, int DV> struct Geo {
    static constexpr int KP = DK + KPAD, VP = DV + KPAD;
    static constexpr int KB = 64 * KP * 2, VB = 64 * VP * 2;
    static constexpr int KCH = 64 * DK / 8, VCH = 64 * DV / 8;
    static constexpr int KPT = (KCH + 511) / 512, VPT = (VCH + 511) / 512;
    static constexpr int LDS_BYTES = KB + VB;
};
struct Tens { const bf16_t* Q; const bf16_t* K; const bf16_t* V; void* O; int ldq, ldk, ldv, ldo; };

template <int DK, int DV, int MODE, bool OF32>
__device__ __forceinline__ void unit(const Tens& T, int b, int qb, const float* kmean, float sink, LAS unsigned char* lds, const int tid) {
    typedef Geo<DK, DV> G;
    const int lane = tid & 63, r32 = lane & 31, hi = lane >> 5; const int wid = __builtin_amdgcn_readfirstlane(tid >> 6);
    const size_t rowbase = (size_t)b * SEQ;
    const int q0 = qb * 256, qw0 = q0 + wid * 32, qabs = qw0 + r32;
    LAS unsigned char* Ks = lds; LAS unsigned char* Vs = lds + G::KB;
    bf16x8 qf[DK / 16];
    { const bf16_t* qp = T.Q + (rowbase + qabs) * T.ldq + 8 * hi;
#pragma unroll
      for (int d0 = 0; d0 < DK / 16; ++d0) qf[d0] = *(const bf16x8*)(qp + 16 * d0); }
    int sel0 = -1, sel1 = -1, sel2 = -1;
    if constexpr (MODE == MODE_MOBA) {
        float gate[16];
#pragma unroll
        for (int j = 0; j < 16; ++j) gate[j] = -INFINITY;
#pragma unroll
        for (int j = 0; j < 15; ++j) if (j < qb) {
            float a = 0.f;
#pragma unroll
            for (int d0 = 0; d0 < 4; ++d0) { const float* kmp = kmean + j * 64 + 16 * d0 + 8 * hi; const f32x4 k0 = *(const f32x4*)kmp, k1 = *(const f32x4*)(kmp + 4);
#pragma unroll
                for (int e = 0; e < 4; ++e) { a += bf2f((unsigned short)qf[d0][e]) * k0[e]; a += bf2f((unsigned short)qf[d0][4 + e]) * k1[e]; } }
            a += __shfl_xor(a, 32);
            gate[j] = a; }
        const int nsel = qb < 3 ? qb : 3;
#pragma unroll
        for (int s = 0; s < 3; ++s) if (s < nsel) {
            float best = -INFINITY; int bi = 0;
#pragma unroll
            for (int j = 0; j < 15; ++j) if (gate[j] > best) { best = gate[j]; bi = j; }
            if (s == 0) sel0 = bi; else if (s == 1) sel1 = bi; else sel2 = bi;
#pragma unroll
            for (int j = 0; j < 15; ++j) if (j == bi) gate[j] = -INFINITY; }
    }
    int t_lo, t_hi;
    if constexpr (MODE == MODE_SWA) { t_lo = qb == 0 ? 0 : qb * 4 - 2; t_hi = qb * 4 + 4; } else { t_lo = 0; t_hi = qb * 4 + 4; }
    u32x4 kreg[G::KPT], vreg[G::VPT];
    const bf16_t* Kg = T.K + rowbase * T.ldk; const bf16_t* Vg = T.V + rowbase * T.ldv;
#define ATT_LOAD(t) do { \
        _Pragma("unroll") for (int i_ = 0; i_ < G::KPT; ++i_) { const int c_ = tid + 512 * i_; if (c_ < G::KCH) { const int row_ = c_ / (DK / 8), cc_ = c_ % (DK / 8); kreg[i_] = *(const u32x4*)(Kg + (size_t)((t) * 64 + row_) * T.ldk + cc_ * 8); } } \
        _Pragma("unroll") for (int i_ = 0; i_ < G::VPT; ++i_) { const int c_ = tid + 512 * i_; if (c_ < G::VCH) { const int row_ = c_ / (DV / 8), cc_ = c_ % (DV / 8); vreg[i_] = *(const u32x4*)(Vg + (size_t)((t) * 64 + row_) * T.ldv + cc_ * 8); } } } while (0)
#define ATT_STORE() do { \
        _Pragma("unroll") for (int i_ = 0; i_ < G::KPT; ++i_) { const int c_ = tid + 512 * i_; if (c_ < G::KCH) { const int row_ = c_ / (DK / 8), cc_ = c_ % (DK / 8); *(LAS u32x4*)(Ks + row_ * (G::KP * 2) + cc_ * 16) = kreg[i_]; } } \
        _Pragma("unroll") for (int i_ = 0; i_ < G::VPT; ++i_) { const int c_ = tid + 512 * i_; if (c_ < G::VCH) { const int row_ = c_ / (DV / 8), cc_ = c_ % (DV / 8); *(LAS u32x4*)(Vs + row_ * (G::VP * 2) + cc_ * 16) = vreg[i_]; } } } while (0)
    float mrun = -1e30f, lrun = 0.f;
    if constexpr (MODE == MODE_SWA) { mrun = sink; lrun = hi == 0 ? 1.f : 0.f; }
    f32x16 o[DV / 32];
#pragma unroll
    for (int d = 0; d < DV / 32; ++d) o[d] = f32x16{};
    const int krow = (r32 & 0x13) | ((r32 & 4) << 1) | ((r32 & 8) >> 1);
    const LAS unsigned char* kfb = Ks + krow * (G::KP * 2) + hi * 16;
    const int i16 = lane & 15;
    const LAS unsigned char* vfb = Vs + (8 * hi + (i16 >> 2)) * (G::VP * 2) + (16 * (r32 >> 4) + 4 * (i16 & 3)) * 2;
    ATT_LOAD(t_lo);
    for (int t = t_lo; t < t_hi; ++t) {
        __syncthreads();
        ATT_STORE();
        __syncthreads();
        if (t + 1 < t_hi) ATT_LOAD(t + 1);
        const int kv0 = t * 64;
        bool skip = kv0 > qw0 + 31;
        if constexpr (MODE == MODE_SWA) skip = skip || (kv0 + 63 < qw0 - 127);
        if (skip) continue;
        f32x16 p0 = f32x16{}, p1 = f32x16{};
#pragma unroll
        for (int d0 = 0; d0 < DK / 16; ++d0) {
            const bf16x8 k0 = *(const LAS bf16x8*)(kfb + d0 * 32);
            const bf16x8 k1 = *(const LAS bf16x8*)(kfb + 32 * (G::KP * 2) + d0 * 32);
            p0 = __builtin_amdgcn_mfma_f32_32x32x16_bf16(k0, qf[d0], p0, 0, 0, 0);
            p1 = __builtin_amdgcn_mfma_f32_32x32x16_bf16(k1, qf[d0], p1, 0, 0, 0);
        }
        bool need_mask = kv0 + 63 > qw0;
        if constexpr (MODE == MODE_SWA) need_mask = true;
        if constexpr (MODE == MODE_MOBA) { if (kv0 < q0) { const int jb = kv0 >> 8; if (!(jb == sel0 || jb == sel1 || jb == sel2)) {
#pragma unroll
            for (int i = 0; i < 16; ++i) { p0[i] = -INFINITY; p1[i] = -INFINITY; } } } }
        if (need_mask) {
#pragma unroll
            for (int i = 0; i < 16; ++i) { const int kv = kv0 + 16 * (i >> 3) + 8 * hi + (i & 7);
                bool m0 = kv > qabs, m1 = kv + 32 > qabs;
                if constexpr (MODE == MODE_SWA) { m0 = m0 || (kv < qabs - 127); m1 = m1 || (kv + 32 < qabs - 127); }
                if (m0) p0[i] = -INFINITY; if (m1) p1[i] = -INFINITY; }
        }
        float mx = p0[0];
#pragma unroll
        for (int i = 1; i < 16; ++i) mx = fmaxf(mx, p0[i]);
#pragma unroll
        for (int i = 0; i < 16; ++i) mx = fmaxf(mx, p1[i]);
        mx = fmaxf(mx, __shfl_xor(mx, 32));
        const float mnew = fmaxf(mrun, mx);
        const float alpha = __builtin_amdgcn_exp2f(mrun - mnew);
        mrun = mnew;
        float ls = 0.f;
#pragma unroll
        for (int i = 0; i < 16; ++i) { p0[i] = __builtin_amdgcn_exp2f(p0[i] - mnew); p1[i] = __builtin_amdgcn_exp2f(p1[i] - mnew); ls += p0[i] + p1[i]; }
        lrun = lrun * alpha + ls;
#pragma unroll
        for (int d = 0; d < DV / 32; ++d)
#pragma unroll
            for (int i = 0; i < 16; ++i) o[d][i] *= alpha;
        bf16x8 pf[4];
#pragma unroll
        for (int s2 = 0; s2 < 4; ++s2) { const f32x16& pp = (s2 >> 1) ? p1 : p0; const int b0 = 8 * (s2 & 1);
            u32x4 w; w.x = cvtpk(pp[b0 + 0], pp[b0 + 1]); w.y = cvtpk(pp[b0 + 2], pp[b0 + 3]); w.z = cvtpk(pp[b0 + 4], pp[b0 + 5]); w.w = cvtpk(pp[b0 + 6], pp[b0 + 7]);
            pf[s2] = __builtin_bit_cast(bf16x8, w); }
#pragma unroll
        for (int d = 0; d < DV / 32; ++d)
#pragma unroll
            for (int s2 = 0; s2 < 4; ++s2) {
                const LAS unsigned char* vp = vfb + (16 * s2) * (G::VP * 2) + d * 64;
                const s16x4 lo = __builtin_bit_cast(s16x4, __builtin_amdgcn_ds_read_tr16_b64_v4i16((LAS s16x4*)(vp)));
                const s16x4 hh = __builtin_bit_cast(s16x4, __builtin_amdgcn_ds_read_tr16_b64_v4i16((LAS s16x4*)(vp + 4 * (G::VP * 2))));
                const bf16x8 vf = (bf16x8){lo[0], lo[1], lo[2], lo[3], hh[0], hh[1], hh[2], hh[3]};
                o[d] = __builtin_amdgcn_mfma_f32_32x32x16_bf16(vf, pf[s2], o[d], 0, 0, 0);
            }
    }
#undef ATT_LOAD
#undef ATT_STORE
    const float ltot = lrun + __shfl_xor(lrun, 32);
    const float inv = 1.0f / ltot;
    if constexpr (OF32) {
        float* op = (float*)T.O + (rowbase + qabs) * T.ldo + 4 * hi;
#pragma unroll
        for (int d = 0; d < DV / 32; ++d)
#pragma unroll
            for (int g4 = 0; g4 < 4; ++g4) { f32x4 v = {o[d][4 * g4] * inv, o[d][4 * g4 + 1] * inv, o[d][4 * g4 + 2] * inv, o[d][4 * g4 + 3] * inv}; *(f32x4*)(op + 32 * d + 8 * g4) = v; }
    } else {
        bf16_t* op = (bf16_t*)T.O + (rowbase + qabs) * T.ldo + 4 * hi;
#pragma unroll
        for (int d = 0; d < DV / 32; ++d)
#pragma unroll
            for (int g4 = 0; g4 < 4; ++g4) { u32x2 w; w.x = cvtpk(o[d][4 * g4] * inv, o[d][4 * g4 + 1] * inv); w.y = cvtpk(o[d][4 * g4 + 2] * inv, o[d][4 * g4 + 3] * inv); *(u32x2*)(op + 32 * d + 8 * g4) = w; }
    }
}
}
constexpr int NWAVES = 8, NTHREADS = 512;
constexpr size_t MiB = 1u << 20;
constexpr size_t WS_CTL = 0, CTL_ZERO_BYTES = 1 * MiB;
constexpr size_t WS_SMALLW = 1 * MiB;
constexpr size_t SW_LAYER = 8 * MiB, SW_WOUT = 4608 * 1024, SW_WQB = SW_WOUT + 2 * MiB, SW_WKVB = SW_WQB + 384 * 1024;
static_assert(SW_WKVB + 512 * 1024 <= SW_LAYER, "small weights");
constexpr size_t WS_WR = WS_SMALLW + 4 * SW_LAYER;
constexpr size_t WS_ROPE = WS_WR + 4 * MiB;
constexpr size_t WS_KMEAN = WS_ROPE + 8 * MiB;
constexpr size_t WS_WGU = WS_KMEAN + 1 * MiB;
constexpr size_t WS_WD = WS_WGU + 65 * MiB;
constexpr size_t WS_ROWTOK = WS_WD + 33 * MiB;
constexpr size_t WS_WSLOT = WS_ROWTOK + 8 * MiB;
constexpr size_t WS_TOKE = WS_WSLOT + 8 * MiB;
constexpr size_t WS_TOKP = WS_TOKE + 1 * MiB;
constexpr size_t WS_XF = WS_TOKP + 1 * MiB;
constexpr size_t WS_HS = WS_XF + 128 * MiB;
constexpr size_t WS_YS = WS_HS + 152 * MiB;
constexpr size_t WS_END = WS_YS + 544 * MiB;
static_assert(WS_END <= 1024 * MiB, "workspace map exceeds 1 GiB");
constexpr size_t A_HB = WS_YS;
constexpr size_t A_QF = A_HB, A_KVF = A_HB + 48 * MiB;
constexpr size_t A_Q1 = A_HB + 144 * MiB;
constexpr size_t A_K1 = A_Q1 + 32 * MiB;
constexpr size_t A_V1 = A_K1 + 32 * MiB;
constexpr size_t A_X1 = A_V1 + 32 * MiB;
constexpr size_t A_X2 = A_X1 + 32 * MiB;
constexpr size_t A_Q2 = A_X2 + 32 * MiB;
constexpr size_t A_OB = A_Q2 + 128 * MiB;
static_assert(A_OB + 64 * MiB <= WS_END, "attention overlay");
constexpr size_t A_XS = WS_YS;
constexpr size_t A_LOG = WS_YS + 128 * MiB;
constexpr int CW_BAR = 4096;
constexpr int CW_CNT = 16384;
constexpr int RING_BYTES = 131072;
constexpr int LX_BAR = RING_BYTES;
constexpr int LX_CNT = RING_BYTES + 64;
constexpr int LX_TST = LX_CNT + 256;
constexpr int LX_TEXP = LX_TST + 320;
constexpr int LDS_BYTES = 147456;
static_assert(LX_TEXP + 1280 <= LDS_BYTES, "LDS map");

#define XB_TMO      128
#define XB_XCNT(j)  (256  + 64 * (j))
#define XB_XSUB(j)  (1280 + 64 * (j))
#define XB_XGEN(j)  (2304 + 64 * (j))
#define XB_TOP      3328
#define XB_TOPGEN   3392
#define XCD_BAR_WORDS 3456
#define XB_SPIN_CAP (1u << 20)
__device__ __forceinline__ unsigned xb_ld(unsigned* p)              { return __hip_atomic_load(p, __ATOMIC_RELAXED, __HIP_MEMORY_SCOPE_AGENT); }
__device__ __forceinline__ unsigned xb_add(unsigned* p, unsigned v) { return __hip_atomic_fetch_add(p, v, __ATOMIC_RELAXED, __HIP_MEMORY_SCOPE_AGENT); }
__device__ __forceinline__ unsigned xb_xcc_id() { return (unsigned)__builtin_amdgcn_s_getreg((3 << 11) | 20) & 0xFu; }
#define XB_SPIN(cond, bar) do { unsigned _sp = 0; while (cond) { __builtin_amdgcn_s_sleep(1); \
    if ((++_sp & 255u) == 0u) { if (xb_ld(&(bar)[XB_TMO])) break; if (_sp > XB_SPIN_CAP) { atomicAdd(&(bar)[XB_TMO], 1u); break; } } } } while (0)
struct XcdBarrier { unsigned* bar; unsigned x; volatile LAS unsigned* st; };
__device__ __forceinline__ XcdBarrier xcd_barrier_post(unsigned* bar, volatile LAS unsigned* st) {
    XcdBarrier b; b.bar = bar; b.x = xb_xcc_id(); b.st = st;
    if (threadIdx.x == 0) (void)xb_add(&bar[XB_XCNT(b.x)], 1u);
    return b;
}
__device__ __forceinline__ void xcd_barrier_complete(unsigned* bar, unsigned x, unsigned& nloc, unsigned& nx) {
    const unsigned G = gridDim.x * gridDim.y * gridDim.z;
    unsigned sum, cnt, mine, sp = 0u;
    for (;;) {
        sum = 0u; cnt = 0u; mine = 0u;
#pragma unroll
        for (unsigned j = 0; j < 16; ++j) { const unsigned c = xb_ld(&bar[XB_XCNT(j)]); sum += c; cnt += (c > 0u) ? 1u : 0u; mine = (j == x) ? c : mine; }
        if (sum == G) break;
        __builtin_amdgcn_s_sleep(1);
        if ((++sp & 255u) == 0u) { if (xb_ld(&bar[XB_TMO])) break; if (sp > XB_SPIN_CAP) { atomicAdd(&bar[XB_TMO], 1u); break; } }
    }
    nloc = mine > 0u ? mine : 1u; nx = cnt > 0u ? cnt : 1u;
}
__device__ __forceinline__ void xcd_barrier(const XcdBarrier& b, const bool leader) {
    asm volatile("s_waitcnt vmcnt(0)" ::: "memory");
    __syncthreads();
    if (leader) {
        unsigned* bar = b.bar; const unsigned bx = xb_xcc_id();
        __builtin_amdgcn_s_waitcnt(0);
        unsigned nloc = b.st[0], nx = b.st[1];
        if (nloc == 0u) { xcd_barrier_complete(bar, bx, nloc, nx); b.st[0] = nloc; b.st[1] = nx; }
        const unsigned old = xb_add(&bar[XB_XSUB(bx)], 1u);
        const unsigned gen = old / nloc;
        if (old + 1u == (gen + 1u) * nloc) {
            __builtin_amdgcn_fence(__ATOMIC_RELEASE, "agent");
            asm volatile("s_waitcnt vmcnt(0)" ::: "memory");
            const unsigned og = xb_add(&bar[XB_TOP], 1u);
            const unsigned tg = og / nx;
            if (og + 1u == (tg + 1u) * nx) xb_add(&bar[XB_TOPGEN], 1u);
            else XB_SPIN(xb_ld(&bar[XB_TOPGEN]) == tg, bar);
            __builtin_amdgcn_fence(__ATOMIC_ACQUIRE, "agent");
            xb_add(&bar[XB_XGEN(bx)], 1u);
            asm volatile("s_waitcnt vmcnt(0)" ::: "memory");
        } else {
            XB_SPIN(xb_ld(&bar[XB_XGEN(bx)]) == gen, bar);
            __builtin_amdgcn_fence(__ATOMIC_ACQUIRE, "agent");
            asm volatile("s_waitcnt vmcnt(0)" ::: "memory");
        }
    }
    __syncthreads();
}

struct Args {
    const float* x; const int* pos;
    const float *ev_w_in, *ev_w_out, *mla_g_qa, *mla_w_qb, *mla_g_kva, *mla_w_kvb, *od_w_in, *od_w_out, *swa_sinks, *diff_lambda, *diff_g_subln, *ln_g, *ln_b,
                *moe_w_router, *moe_bias, *moe_w_gate, *moe_w_up, *moe_w_down, *sh_w_gate, *sh_w_up, *sh_w_down;
    float* out; unsigned char* ws;
    int st_lo, st_hi, use_bar, pad;
};

__device__ __forceinline__ void transpose_item(const float* W, int N, int k0, int n0, bf16_t* WT, int ldk, int dst_row0, LAS float* scr, int lane) {
#pragma unroll 8
    for (int i = 0; i < 32; ++i) { const int kk = 2 * i + (lane >> 5); scr[kk * 33 + (lane & 31)] = W[(size_t)(k0 + kk) * N + n0 + (lane & 31)]; }
    asm volatile("s_waitcnt lgkmcnt(0)" ::: "memory");
    const int c = lane & 7;
#pragma unroll
    for (int j = 0; j < 4; ++j) { const int n = (lane >> 3) + 8 * j; const LAS float* s = scr + (8 * c) * 33 + n;
        u32x4 o; o.x = pk2(s[0 * 33], s[1 * 33]); o.y = pk2(s[2 * 33], s[3 * 33]); o.z = pk2(s[4 * 33], s[5 * 33]); o.w = pk2(s[6 * 33], s[7 * 33]);
        *(u32x4*)(WT + (size_t)(dst_row0 + n) * ldk + k0 + 8 * c) = o; }
    asm volatile("s_waitcnt lgkmcnt(0)" ::: "memory");
}
__device__ __forceinline__ void sincos_acc(float angf, float& c, float& s) {
    const double x = (double)angf;
    const double n = __builtin_rint(x * 0.63661977236758134308);
    double r = x - n * 1.57079632679489655800; r -= n * 6.12323399573676603587e-17;
    const long q = (long)n;
    const double r2 = r * r;
    double sp = -2.5052108385441718775e-08; sp = sp * r2 + 2.7557319223985890653e-06; sp = sp * r2 - 1.9841269841269841270e-04; sp = sp * r2 + 8.3333333333333333333e-03; sp = sp * r2 - 1.6666666666666666667e-01;
    const double sn = r + r * r2 * sp;
    double cp = 2.0876756987868098979e-09; cp = cp * r2 - 2.7557319223985890653e-07; cp = cp * r2 + 2.4801587301587301587e-05; cp = cp * r2 - 1.3888888888888888889e-03; cp = cp * r2 + 4.1666666666666666667e-02; cp = cp * r2 - 0.5;
    const double cs = 1.0 + r2 * cp;
    double so, co;
    switch ((int)(q & 3)) { case 0: so = sn; co = cs; break; case 1: so = cs; co = -sn; break; case 2: so = -sn; co = -cs; break; default: so = -cs; co = sn; break; }
    s = (float)so; c = (float)co;
}
struct Ctx {
    LAS unsigned char* lds; unsigned char* ws; int tid, lane, wave, G, bid, gw, NGW;
};
#define WSP(T, off) ((T*)(C.ws + (off)))

__device__ __forceinline__ void phase_convert(const Ctx& C, const Args& a, int L) {
    LAS float* scr = (LAS float*)(C.lds + C.wave * 16384);
    {
        constexpr int IT_G = (1024 / 64) * (256 / 32);
        constexpr int IT_D = (256 / 64) * (1024 / 32);
        const int total = 65 * (2 * IT_G + IT_D);
        bf16_t* Wgu = WSP(bf16_t, WS_WGU); bf16_t* Wd = WSP(bf16_t, WS_WD);
        for (int it = C.gw; it < total; it += C.NGW) {
            const int e = it / (2 * IT_G + IT_D); int r = it % (2 * IT_G + IT_D);
            if (r < 2 * IT_G) {
                const int up = r >= IT_G; if (up) r -= IT_G;
                const float* W = e < 64 ? (up ? a.moe_w_up : a.moe_w_gate) + ((size_t)L * 64 + e) * 1024 * 256 : (up ? a.sh_w_up : a.sh_w_gate) + (size_t)L * 1024 * 256;
                const int kb = r / 8, nb = r % 8, n0 = nb * 32;
                transpose_item(W, 256, kb * 64, n0, Wgu + (size_t)e * 512 * 1024, 1024, (n0 >> 7) * 256 + up * 128 + (n0 & 127), scr, C.lane);
            } else {
                r -= 2 * IT_G;
                const float* W = e < 64 ? a.moe_w_down + ((size_t)L * 64 + e) * 256 * 1024 : a.sh_w_down + (size_t)L * 256 * 1024;
                const int kb = r / 32, nb = r % 32, n0 = nb * 32;
                transpose_item(W, 1024, kb * 64, n0, Wd + (size_t)e * 1024 * 256, 256, n0, scr, C.lane);
            }
        }
    }
}
__device__ __forceinline__ void phase_init(const Ctx& C, const Args& a) {
    LAS float* scr = (LAS float*)(C.lds + C.wave * 16384);
    for (int l = 0; l < DEPTH; ++l) {
        const int i = l >> 1; const bool even = !(l & 1);
        bf16_t* Win = WSP(bf16_t, WS_SMALLW + l * SW_LAYER); bf16_t* Wout = WSP(bf16_t, WS_SMALLW + l * SW_LAYER + SW_WOUT);
        const int nin = even ? EV_IN : OD_IN;
        const float* win = even ? a.ev_w_in + (size_t)i * 1024 * EV_IN : a.od_w_in + (size_t)i * 1024 * OD_IN;
        const float* wout = even ? a.ev_w_out + (size_t)i * 1024 * 1024 : a.od_w_out + (size_t)i * 1024 * 1024;
        const int it_in = 16 * (nin / 32), it_out = 16 * 32;
        for (int it = C.gw; it < it_in + it_out; it += C.NGW) {
            if (it < it_in) { const int kb = it / (nin / 32), nb = it % (nin / 32); transpose_item(win, nin, kb * 64, nb * 32, Win, 1024, nb * 32, scr, C.lane); }
            else { const int r = it - it_in, kb = r / 32, nb = r % 32; transpose_item(wout, 1024, kb * 64, nb * 32, Wout, 1024, nb * 32, scr, C.lane); }
        }
        if (even) {
            for (int idx = C.bid * NTHREADS + C.tid; idx < (2048 - EV_IN) * 1024 / 8; idx += C.G * NTHREADS) *(u32x4*)(Win + (size_t)EV_IN * 1024 + (size_t)idx * 8) = (u32x4){0u, 0u, 0u, 0u};
            bf16_t* Wqb = WSP(bf16_t, WS_SMALLW + l * SW_LAYER + SW_WQB); bf16_t* Wkvb = WSP(bf16_t, WS_SMALLW + l * SW_LAYER + SW_WKVB);
            const float* wqb = a.mla_w_qb + (size_t)i * 256 * 768; const float* wkvb = a.mla_w_kvb + (size_t)i * 128 * 1024;
            const int it_q = 4 * 24, it_kv = 2 * 32;
            for (int it = C.gw; it < it_q + it_kv; it += C.NGW) {
                if (it < it_q) { const int kb = it / 24, nb = it % 24; transpose_item(wqb, 768, kb * 64, nb * 32, Wqb, 256, nb * 32, scr, C.lane); }
                else { const int r = it - it_q, kb = r / 32, nb = r % 32; transpose_item(wkvb, 1024, kb * 64, nb * 32, Wkvb, 256, nb * 32, scr, C.lane); }
            }
            for (int idx = C.bid * NTHREADS + C.tid; idx < 1024 * 16; idx += C.G * NTHREADS) { const int row = idx >> 4, ch = idx & 15; *(u32x4*)(Wkvb + (size_t)row * 256 + 128 + ch * 8) = (u32x4){0u, 0u, 0u, 0u}; }
        }
        bf16_t* Wr = WSP(bf16_t, WS_WR + (size_t)l * MiB); const float* wr = a.moe_w_router + (size_t)l * 1024 * 64;
        for (int idx = C.bid * NTHREADS + C.tid; idx < 256 * 2048; idx += C.G * NTHREADS) {
            const int n = idx >> 11, k = idx & 2047; unsigned v = 0;
            if (n < 128) { const int e = n & 63, kk = k & 1023; const float w = wr[(size_t)kk * 64 + e]; const unsigned wh = f2bf(w);
                if (n < 64) v = wh; else if (k < 1024) v = f2bf(w - bf2f(wh)); }
            Wr[idx] = (bf16_t)v;
        }
    }
    { f32x2* rope = WSP(f32x2, WS_ROPE);
      for (int idx = C.bid * NTHREADS + C.tid; idx < NTOK * 32; idx += C.G * NTHREADS) { const int tok = idx >> 5, j = idx & 31;
          const float inv = (float)exp2(-(double)j * (13.287712379549449 / 32.0));
          const float ang = (float)a.pos[tok] * inv; float cs, sn; sincos_acc(ang, cs, sn); rope[idx] = (f32x2){cs, sn}; } }
    { bf16_t* xb = WSP(bf16_t, WS_HS);
      for (size_t idx = (size_t)C.bid * NTHREADS + C.tid; idx < (size_t)NTOK * DM / 8; idx += (size_t)C.G * NTHREADS) { const f32x4 v0 = *(const f32x4*)(a.x + idx * 8), v1 = *(const f32x4*)(a.x + idx * 8 + 4);
          u32x4 o; o.x = pk2(v0[0], v0[1]); o.y = pk2(v0[2], v0[3]); o.z = pk2(v1[0], v1[1]); o.w = pk2(v1[2], v1[3]); *(u32x4*)(xb + idx * 8) = o; } }
}

template <int HW>
__device__ __forceinline__ void rope_heads(const bf16_t* src, bf16_t* dst, int nh, const f32x2* rope_tok, float scale, int lane) {
    const int npairs = nh * HW;
    for (int p = lane; p < npairs; p += 64) { const int hh = p / HW, i = p % HW;
        const float x1 = bf2f(src[hh * 2 * HW + i]), x2 = bf2f(src[hh * 2 * HW + i + HW]); const f32x2 cs = rope_tok[i * (32 / HW)];
        dst[hh * 2 * HW + i] = (bf16_t)f2bf((x1 * cs.x - x2 * cs.y) * scale); dst[hh * 2 * HW + i + HW] = (bf16_t)f2bf((x2 * cs.x + x1 * cs.y) * scale); }
}
__device__ __forceinline__ void copy_cols(const bf16_t* src, bf16_t* dst, int n, int lane) { for (int c = lane; c < n / 8; c += 64) *(u32x4*)(dst + c * 8) = *(const u32x4*)(src + c * 8); }

__device__ __forceinline__ void phase_prep_even(const Ctx& C, const Args& a, int i) {
    const bf16_t* hb = WSP(bf16_t, A_HB); const f32x2* rope = WSP(f32x2, WS_ROPE);
    bf16_t *Qa = WSP(bf16_t, A_Q1), *Ka = WSP(bf16_t, A_K1), *Va = WSP(bf16_t, A_V1), *qlat = WSP(bf16_t, A_X1), *kvlat = WSP(bf16_t, A_X1 + 16 * MiB), *kpe = WSP(bf16_t, A_X2);
    const float* gqa = a.mla_g_qa + i * 256; const float* gkva = a.mla_g_kva + i * 128;
    const float sc = 0.125f * LOG2E;
    for (int tok = C.gw; tok < NTOK; tok += C.NGW) {
        const bf16_t* h = hb + (size_t)tok * HB_LD; const f32x2* rt = rope + (size_t)tok * 32;
        rope_heads<32>(h, Qa + (size_t)tok * 512, 8, rt, sc, C.lane);
        rope_heads<32>(h + 512, Ka + (size_t)tok * 512, 8, rt, 1.0f, C.lane);
        copy_cols(h + 1024, Va + (size_t)tok * 512, 512, C.lane);
        { float v[4]; float ss = 0.f;
#pragma unroll
          for (int j = 0; j < 4; ++j) { v[j] = bf2f(h[1536 + C.lane + 64 * j]); ss += v[j] * v[j]; }
          const float r = 1.0f / sqrtf(wave_sum(ss) * (1.0f / 256.0f) + 1e-6f);
#pragma unroll
          for (int j = 0; j < 4; ++j) qlat[(size_t)tok * 256 + C.lane + 64 * j] = (bf16_t)f2bf(v[j] * r * gqa[C.lane + 64 * j]); }
        { float v[2]; float ss = 0.f;
#pragma unroll
          for (int j = 0; j < 2; ++j) { v[j] = bf2f(h[1792 + C.lane + 64 * j]); ss += v[j] * v[j]; }
          const float r = 1.0f / sqrtf(wave_sum(ss) * (1.0f / 128.0f) + 1e-6f);
#pragma unroll
          for (int j = 0; j < 2; ++j) { kvlat[(size_t)tok * 256 + C.lane + 64 * j] = (bf16_t)f2bf(v[j] * r * gkva[C.lane + 64 * j]); kvlat[(size_t)tok * 256 + 128 + C.lane + 64 * j] = 0; } }
        rope_heads<16>(h + 1920, kpe + (size_t)tok * 32, 1, rt, 1.0f, C.lane);
    }
}
__device__ __forceinline__ void phase_kmean(const Ctx& C) {
    const bf16_t* Ka = WSP(bf16_t, A_K1); float* km = WSP(float, WS_KMEAN);
    for (int idx = C.bid * NTHREADS + C.tid; idx < NBATCH * 16 * 512; idx += C.G * NTHREADS) {
        const int c = idx & 511, bj = idx >> 9, b = bj >> 4, j = bj & 15; const bf16_t* p = Ka + ((size_t)b * SEQ + j * 256) * 512 + c;
        float s = 0.f;
        for (int r = 0; r < 256; ++r) s += bf2f(p[(size_t)r * 512]);
        km[(((size_t)b * 8 + (c >> 6)) * 16 + j) * 64 + (c & 63)] = s * (1.0f / 256.0f);
    }
}
__device__ __forceinline__ void phase_prep_mla(const Ctx& C) {
    const bf16_t *qf = WSP(bf16_t, A_QF), *kvf = WSP(bf16_t, A_KVF), *kpe = WSP(bf16_t, A_X2); const f32x2* rope = WSP(f32x2, WS_ROPE);
    bf16_t *Qb = WSP(bf16_t, A_Q2), *Kb = WSP(bf16_t, A_Q2 + 48 * MiB), *Vb = WSP(bf16_t, A_Q2 + 96 * MiB);
    const float sc = 0.10206207261596577f * LOG2E;
    for (int tok = C.gw; tok < NTOK; tok += C.NGW) {
        const bf16_t* q = qf + (size_t)tok * 768; const bf16_t* kv = kvf + (size_t)tok * 1024; const f32x2* rt = rope + (size_t)tok * 32;
        bf16_t* qo = Qb + (size_t)tok * 768; bf16_t* ko = Kb + (size_t)tok * 768; bf16_t* vo = Vb + (size_t)tok * 512;
        for (int p = C.lane; p < 512; p += 64) { const int hh = p >> 6, d = p & 63; qo[hh * 96 + d] = (bf16_t)f2bf(bf2f(q[hh * 96 + d]) * sc); ko[hh * 96 + d] = kv[hh * 128 + d]; vo[hh * 64 + d] = kv[hh * 128 + 64 + d]; }
        for (int p = C.lane; p < 128; p += 64) { const int hh = p >> 4, i2 = p & 15;
            const float x1 = bf2f(q[hh * 96 + 64 + i2]), x2 = bf2f(q[hh * 96 + 80 + i2]); const f32x2 cs = rt[2 * i2];
            qo[hh * 96 + 64 + i2] = (bf16_t)f2bf((x1 * cs.x - x2 * cs.y) * sc); qo[hh * 96 + 80 + i2] = (bf16_t)f2bf((x2 * cs.x + x1 * cs.y) * sc); }
        for (int p = C.lane; p < 256; p += 64) { const int hh = p >> 5, d = p & 31; ko[hh * 96 + 64 + d] = kpe[(size_t)tok * 32 + d]; }
    }
}
__device__ __forceinline__ void phase_prep_odd(const Ctx& C) {
    const bf16_t* hb = WSP(bf16_t, A_HB); const f32x2* rope = WSP(f32x2, WS_ROPE);
    bf16_t *Qc = WSP(bf16_t, A_Q1), *Kc = WSP(bf16_t, A_K1), *Vc = WSP(bf16_t, A_K1 + 8 * MiB), *Qd = WSP(bf16_t, A_V1), *Kd = WSP(bf16_t, A_X1), *Vd = WSP(bf16_t, A_X2);
    const float sc = 0.125f * LOG2E;
    for (int tok = C.gw; tok < NTOK; tok += C.NGW) {
        const bf16_t* h = hb + (size_t)tok * HB_LD; const f32x2* rt = rope + (size_t)tok * 32;
        rope_heads<32>(h, Qc + (size_t)tok * 512, 8, rt, sc, C.lane);
        rope_heads<32>(h + 512, Kc + (size_t)tok * 128, 2, rt, 1.0f, C.lane);
        copy_cols(h + 640, Vc + (size_t)tok * 128, 128, C.lane);
        rope_heads<32>(h + 768, Qd + (size_t)tok * 512, 8, rt, sc, C.lane);
        rope_heads<32>(h + 1280, Kd + (size_t)tok * 512, 8, rt, 1.0f, C.lane);
        copy_cols(h + 1792, Vd + (size_t)tok * 512, 512, C.lane);
    }
}
__device__ __forceinline__ void phase_attn_even(const Ctx& C) {
    const bf16_t *Qa = WSP(bf16_t, A_Q1), *Ka = WSP(bf16_t, A_K1), *Va = WSP(bf16_t, A_V1), *Qb = WSP(bf16_t, A_Q2), *Kb = WSP(bf16_t, A_Q2 + 48 * MiB), *Vb = WSP(bf16_t, A_Q2 + 96 * MiB);
    bf16_t* ob = WSP(bf16_t, A_OB); const float* km = WSP(float, WS_KMEAN);
    for (int P = C.bid; P < 512; P += C.G) { const int bh = P >> 3, pi = P & 7, b = bh >> 3, h = bh & 7;
#pragma unroll 1
        for (int s = 0; s < 2; ++s) { const int qb = s ? pi : 15 - pi;
            att::Tens T{Qb + 96 * h, Kb + 96 * h, Vb + 64 * h, ob + 512 + 64 * h, 768, 768, 512, 1024};
            att::unit<96, 64, att::MODE_CAUSAL, false>(T, b, qb, nullptr, 0.f, C.lds, C.tid); } }
    for (int P = C.bid; P < 512; P += C.G) { const int bh = P >> 3, pi = P & 7, b = bh >> 3, h = bh & 7;
#pragma unroll 1
        for (int s = 0; s < 2; ++s) { const int qb = s ? pi : 15 - pi;
            att::Tens T{Qa + 64 * h, Ka + 64 * h, Va + 64 * h, ob + 64 * h, 512, 512, 512, 1024};
            att::unit<64, 64, att::MODE_MOBA, false>(T, b, qb, km + ((size_t)b * 8 + h) * 1024, 0.f, C.lds, C.tid); } }
}
__device__ __forceinline__ void phase_attn_odd(const Ctx& C, const Args& a, int i) {
    const bf16_t *Qc = WSP(bf16_t, A_Q1), *Kc = WSP(bf16_t, A_K1), *Vc = WSP(bf16_t, A_K1 + 8 * MiB), *Qd = WSP(bf16_t, A_V1), *Kd = WSP(bf16_t, A_X1), *Vd = WSP(bf16_t, A_X2);
    bf16_t* ob = WSP(bf16_t, A_OB); float* Od = WSP(float, A_Q2);
    for (int P = C.bid; P < 512; P += C.G) { const int bh = P >> 3, pi = P & 7, b = bh >> 3, st = bh & 7;
#pragma unroll 1
        for (int s = 0; s < 2; ++s) { const int qb = s ? pi : 15 - pi;
            att::Tens T{Qd + 64 * st, Kd + 64 * st, Vd + 128 * (st >> 1), Od + 128 * st, 512, 512, 512, 1024};
            att::unit<64, 128, att::MODE_CAUSAL, true>(T, b, qb, nullptr, 0.f, C.lds, C.tid); } }
    for (int P = C.bid; P < 512; P += C.G) { const int bh = P >> 3, pi = P & 7, b = bh >> 3, h = bh & 7;
        const float sink = a.swa_sinks[i * 8 + h] * LOG2E;
#pragma unroll 1
        for (int s = 0; s < 2; ++s) { const int qb = s ? pi : 15 - pi;
            att::Tens T{Qc + 64 * h, Kc + 64 * (h >> 2), Vc + 64 * (h >> 2), ob + 64 * h, 512, 128, 128, 1024};
            att::unit<64, 64, att::MODE_SWA, false>(T, b, qb, nullptr, sink, C.lds, C.tid); } }
}
__device__ __forceinline__ void phase_diff_combine(const Ctx& C, const Args& a, int i, int l) {
    const float* Od = WSP(float, A_Q2); bf16_t* ob = WSP(bf16_t, A_OB);
    const float* lp = a.diff_lambda + i * 256;
    const float d01 = wave_sum(lp[C.lane] * lp[64 + C.lane]), d23 = wave_sum(lp[128 + C.lane] * lp[192 + C.lane]);
    const float lam_init = 0.8f - 0.6f * expf(-0.3f * (float)l);
    const float lam = expf(d01) - expf(d23) + lam_init;
    const float g0 = a.diff_g_subln[i * 128 + C.lane] * (1.0f - lam_init), g1 = a.diff_g_subln[i * 128 + 64 + C.lane] * (1.0f - lam_init);
    for (int tok = C.gw; tok < NTOK; tok += C.NGW) {
#pragma unroll
        for (int h = 0; h < 4; ++h) { const float* o1 = Od + (size_t)tok * 1024 + 256 * h; const float* o2 = o1 + 128;
            const float v0 = o1[C.lane] - lam * o2[C.lane], v1 = o1[64 + C.lane] - lam * o2[64 + C.lane];
            const float r = 1.0f / sqrtf(wave_sum(v0 * v0 + v1 * v1) * (1.0f / 128.0f) + 1e-5f);
            bf16_t* o = ob + (size_t)tok * 1024 + 512 + 128 * h; o[C.lane] = (bf16_t)f2bf(v0 * r * g0); o[64 + C.lane] = (bf16_t)f2bf(v1 * r * g1); }
    }
}
__device__ __forceinline__ void ln_row(f32x4 (&v)[4], const float* g, const float* bb, int lane) {
    float s = 0.f;
#pragma unroll
    for (int j = 0; j < 4; ++j) s += (v[j][0] + v[j][1]) + (v[j][2] + v[j][3]);
    const float mean = wave_sum(s) * (1.0f / DM); float s2 = 0.f;
#pragma unroll
    for (int j = 0; j < 4; ++j) { v[j] = v[j] - mean; s2 += (v[j][0] * v[j][0] + v[j][1] * v[j][1]) + (v[j][2] * v[j][2] + v[j][3] * v[j][3]); }
    const float rstd = 1.0f / sqrtf(wave_sum(s2) * (1.0f / DM) + 1e-5f);
#pragma unroll
    for (int j = 0; j < 4; ++j) { const f32x4 gg = *(const f32x4*)(g + 4 * lane + 256 * j), b4 = *(const f32x4*)(bb + 4 * lane + 256 * j); v[j] = v[j] * rstd * gg + b4; }
}
__device__ __forceinline__ void phase_ln1(const Ctx& C, const Args& a, int l) {
    float* xf = WSP(float, WS_XF); bf16_t* xs = WSP(bf16_t, A_XS);
    const float* g = a.ln_g + (size_t)(l * 2) * DM; const float* bb = a.ln_b + (size_t)(l * 2) * DM;
    for (int tok = C.gw; tok < NTOK; tok += C.NGW) {
        f32x4 v[4]; float* xr = xf + (size_t)tok * DM + 4 * C.lane;
#pragma unroll
        for (int j = 0; j < 4; ++j) v[j] = *(const f32x4*)(xr + 256 * j);
        ln_row(v, g, bb, C.lane);
        bf16_t* xo = xs + (size_t)tok * 2048 + 4 * C.lane;
#pragma unroll
        for (int j = 0; j < 4; ++j) { *(f32x4*)(xr + 256 * j) = v[j];
            const unsigned h0 = f2bf(v[j][0]), h1 = f2bf(v[j][1]), h2 = f2bf(v[j][2]), h3 = f2bf(v[j][3]);
            u32x2 hi2 = {h0 | (h1 << 16), h2 | (h3 << 16)}; *(u32x2*)(xo + 256 * j) = hi2;
            u32x2 lo2 = {pk2(v[j][0] - bf2f(h0), v[j][1] - bf2f(h1)), pk2(v[j][2] - bf2f(h2), v[j][3] - bf2f(h3))}; *(u32x2*)(xo + 1024 + 256 * j) = lo2; }
    }
}
__device__ __forceinline__ void phase_route(const Ctx& C, const Args& a, int l) {
    const float* lg = WSP(float, A_LOG);
    int* rowtok = WSP(int, WS_ROWTOK); float* tokw = WSP(float, WS_WSLOT); int* toke = WSP(int, WS_TOKE); int* tokp = WSP(int, WS_TOKP);
    unsigned* cnt = WSP(unsigned, WS_CTL) + CW_CNT + 64 * l;
    LAS int* cntw = (LAS int*)C.lds; LAS int* base = cntw + 64; LAS int* ent_e = base + 64; LAS int* ent_r = ent_e + 2048; LAS float* ent_w = (LAS float*)(ent_r + 2048);
    const int tpb = NTOK / C.G, tok0 = C.bid * tpb;
    if (C.tid < 64) cntw[C.tid] = 0;
    __syncthreads();
    const float bias = a.moe_bias[l * 64 + C.lane];
    const int g = C.lane >> 3;
    for (int tl = C.wave; tl < tpb; tl += NWAVES) {
        const int tok = tok0 + tl;
        const float z = lg[(size_t)tok * 256 + C.lane] + lg[(size_t)tok * 256 + 64 + C.lane];
        const float s = 1.0f / (1.0f + expf(-z));
        const float c = s + bias;
        float m1 = c; m1 = fmaxf(m1, __shfl_xor(m1, 1)); m1 = fmaxf(m1, __shfl_xor(m1, 2)); m1 = fmaxf(m1, __shfl_xor(m1, 4));
        const unsigned long long eq = __ballot(c == m1);
        const unsigned geq = (unsigned)(eq >> (8 * g)) & 0xffu;
        const bool is_first = (C.lane & 7) == (int)__builtin_ctz(geq);
        float m2 = is_first ? -INFINITY : c; m2 = fmaxf(m2, __shfl_xor(m2, 1)); m2 = fmaxf(m2, __shfl_xor(m2, 2)); m2 = fmaxf(m2, __shfl_xor(m2, 4));
        const float gs = m1 + m2;
        int grank = 0;
#pragma unroll
        for (int j = 0; j < 8; ++j) { const float gj = __builtin_bit_cast(float, __builtin_amdgcn_readlane(__builtin_bit_cast(int, gs), 8 * j)); grank += (gj > gs || (gj == gs && j < g)) ? 1 : 0; }
        const float v = grank < 4 ? c : -INFINITY;
        int rank = 0;
#pragma unroll
        for (int j = 0; j < 64; ++j) { const float vj = __builtin_bit_cast(float, __builtin_amdgcn_readlane(__builtin_bit_cast(int, v), j)); rank += (vj > v || (vj == v && j < C.lane)) ? 1 : 0; }
        const bool sel = rank < 8;
        const float ssum = wave_sum(sel ? s : 0.f);
        if (sel) { const int r = __hip_atomic_fetch_add(&cntw[C.lane], 1, __ATOMIC_RELAXED, __HIP_MEMORY_SCOPE_WORKGROUP);
            ent_e[tl * 8 + rank] = C.lane; ent_r[tl * 8 + rank] = r; ent_w[tl * 8 + rank] = s / ssum * 2.5f; }
    }
    __syncthreads();
    if (C.tid < 64) base[C.tid] = (int)atomicAdd(&cnt[C.tid], (unsigned)cntw[C.tid]);
    __syncthreads();
    for (int idx = C.tid; idx < tpb * 8; idx += NTHREADS) { const int e = ent_e[idx], pos = base[e] + ent_r[idx], tok = tok0 + (idx >> 3);
        if (pos < CAP) rowtok[(size_t)e * CAP + pos] = tok;
        toke[(size_t)tok0 * 8 + idx] = e; tokp[(size_t)tok0 * 8 + idx] = pos; tokw[(size_t)tok0 * 8 + idx] = ent_w[idx]; }
    __syncthreads();
}
__device__ __forceinline__ void moe_tables(const Ctx& C, int l) {
    const unsigned* cnt = WSP(unsigned, WS_CTL) + CW_CNT + 64 * l;
    LAS int* lcnt = (LAS int*)(C.lds + LX_CNT); LAS int* tst = (LAS int*)(C.lds + LX_TST); LAS unsigned char* texp = (LAS unsigned char*)(C.lds + LX_TEXP);
    __syncthreads();
    if (C.tid < 64) { int c = (int)__hip_atomic_load(cnt + C.tid, __ATOMIC_RELAXED, __HIP_MEMORY_SCOPE_AGENT); if (c > CAP) c = CAP; lcnt[C.tid] = c; }
    __syncthreads();
    if (C.tid == 0) { int acc = 0; for (int e = 0; e < 64; ++e) { tst[e] = acc; acc += (lcnt[e] + 255) >> 8; } tst[64] = acc; }
    __syncthreads();
    if (C.tid < 64) { const int t0 = tst[C.tid], t1 = tst[C.tid + 1]; for (int t = t0; t < t1; ++t) texp[t] = (unsigned char)C.tid; }
    __syncthreads();
}
template <bool GATHER_> struct MoeOrder {
    static constexpr bool GATHER = GATHER_;
    const LAS int* lcnt; const LAS int* tst; const LAS unsigned char* texp; const int* rowtok;
    int TR, nsh, NC, G, c; int sh_orow0;
    __device__ __forceinline__ bool next(int i, pg8::Unit& u) const {
        const long L = (long)i * G + c; if (L >= (long)(TR + nsh) * NC) return false;
        const int r = (int)(L / NC), cn = (int)(L % NC);
        if (r < TR) { const int e = __builtin_amdgcn_readfirstlane((int)texp[r]); u.e = e; u.lt = r - __builtin_amdgcn_readfirstlane(tst[e]); u.pm = r; u.orow = r * 256; }
        else { u.e = 64; u.lt = r - TR; u.pm = TR_MAX + (r - TR); u.orow = sh_orow0 + u.lt * 256; }
        u.pn = u.e * NC + cn; u.ocol = cn * (NC == 2 ? 128 : 256);
        return true;
    }
    __device__ __forceinline__ unsigned arow(const pg8::Unit& u, int r) const {
        if (!GATHER) return (unsigned)(u.pm * 256 + r);
        const int loc = u.lt * 256 + r;
        if (u.e == 64) return (unsigned)loc;
        return loc < __builtin_amdgcn_readfirstlane(lcnt[u.e]) ? (unsigned)rowtok[(size_t)u.e * CAP + loc] : 0u;
    }
};
__device__ __forceinline__ void phase_combine_ln2(const Ctx& C, const Args& a, int l) {
    float* xf = WSP(float, WS_XF); bf16_t* xb = WSP(bf16_t, WS_HS); const bf16_t* Ys = WSP(bf16_t, WS_YS);
    const int* toke = WSP(int, WS_TOKE); const int* tokp = WSP(int, WS_TOKP); const float* tokw = WSP(float, WS_WSLOT);
    const LAS int* tst = (const LAS int*)(C.lds + LX_TST);
    const float* g = a.ln_g + (size_t)(l * 2 + 1) * DM; const float* bb = a.ln_b + (size_t)(l * 2 + 1) * DM;
    for (int tok = C.gw; tok < NTOK; tok += C.NGW) {
        f32x4 v[4]; float* xr = xf + (size_t)tok * DM + 4 * C.lane;
#pragma unroll
        for (int j = 0; j < 4; ++j) v[j] = *(const f32x4*)(xr + 256 * j);
#pragma unroll
        for (int k = 0; k < 8; ++k) { const int e = toke[(size_t)tok * 8 + k], pos = tokp[(size_t)tok * 8 + k]; const float gw = tokw[(size_t)tok * 8 + k]; const size_t slot = (size_t)tst[e] * 256 + pos;
            const bf16_t* yr = Ys + slot * DM + 4 * C.lane;
#pragma unroll
            for (int j = 0; j < 4; ++j) { const u32x2 w = *(const u32x2*)(yr + 256 * j); v[j][0] += gw * bf2f(w.x & 0xffffu); v[j][1] += gw * bf2f(w.x >> 16); v[j][2] += gw * bf2f(w.y & 0xffffu); v[j][3] += gw * bf2f(w.y >> 16); } }
        ln_row(v, g, bb, C.lane);
        bf16_t* xo = xb + (size_t)tok * DM + 4 * C.lane;
#pragma unroll
        for (int j = 0; j < 4; ++j) { *(f32x4*)(xr + 256 * j) = v[j]; u32x2 w = {pk2(v[j][0], v[j][1]), pk2(v[j][2], v[j][3])}; *(u32x2*)(xo + 256 * j) = w;
            if (l == DEPTH - 1) *(f32x4*)(a.out + (size_t)tok * DM + 4 * C.lane + 256 * j) = v[j]; }
    }
}
constexpr int STEPS_PER_LAYER = 15, NSTEPS = 1 + STEPS_PER_LAYER * DEPTH;
#define CAS __attribute__((address_space(4)))
template <int STEP> __device__ __forceinline__ void step_fn(const CAS Args* ka, LAS unsigned char* lds_base, int l, int wv) {
#if defined(__HIP_DEVICE_COMPILE__)
    const Args a = *ka;
#else
    const Args a{};
#endif
    int lane_; asm volatile("v_mbcnt_lo_u32_b32 %0, -1, 0\n\tv_mbcnt_hi_u32_b32 %0, -1, %0" : "=v"(lane_)); asm volatile("" : "+s"(wv)); int tid_ = wv * 64 + lane_; asm volatile("" : "+v"(tid_));
    LAS unsigned char* lds_l = lds_base; asm volatile("" : "+s"(lds_l));
    Ctx C; C.lds = lds_l; C.ws = a.ws; C.tid = tid_; C.lane = C.tid & 63; C.wave = __builtin_amdgcn_readfirstlane(C.tid >> 6);
    int G_ = gridDim.x, bid_ = blockIdx.x; asm volatile("" : "+s"(G_), "+s"(bid_));
    C.G = G_; C.bid = bid_; C.gw = C.bid * NWAVES + C.wave; C.NGW = C.G * NWAVES;
    asm volatile("; STEP_BEGIN %0" :: "n"(STEP));
    const int i = l >> 1; const bool even = !(l & 1);
    const size_t swl = WS_SMALLW + (size_t)l * SW_LAYER;
    if constexpr (STEP == 99) phase_init(C, a);
    if constexpr (STEP == 0) phase_convert(C, a, l);
    if constexpr (STEP == 1) { pg8::Gemm g{WSP(bf16_t, WS_HS), WSP(bf16_t, swl), DM, DM}; pg8::StaticOrder S; S.init(NTOK, even ? 2048 : 2304, C.G, C.bid);
        pg8::EpiBf16 E{WSP(bf16_t, A_HB), HB_LD}; pg8::gemm_phase<pg8::EpiBf16, pg8::StaticOrder, true>(C.lds, g, S, E, C.tid); }
    if constexpr (STEP == 2) { if (even) phase_prep_even(C, a, i); else phase_prep_odd(C); }
    if constexpr (STEP == 3) { phase_kmean(C);
        { pg8::Gemm g{WSP(bf16_t, A_X1), WSP(bf16_t, swl + SW_WQB), 256, 256}; pg8::StaticOrder S; S.init(NTOK, 768, C.G, C.bid);
          pg8::EpiBf16 E{WSP(bf16_t, A_QF), 768}; pg8::gemm_phase<pg8::EpiBf16, pg8::StaticOrder, true>(C.lds, g, S, E, C.tid); }
        { pg8::Gemm g{WSP(bf16_t, A_X1 + 16 * MiB), WSP(bf16_t, swl + SW_WKVB), 256, 256}; pg8::StaticOrder S; S.init(NTOK, 1024, C.G, C.bid);
          pg8::EpiBf16 E{WSP(bf16_t, A_KVF), 1024}; pg8::gemm_phase<pg8::EpiBf16, pg8::StaticOrder, true>(C.lds, g, S, E, C.tid); } }
    if constexpr (STEP == 4) phase_prep_mla(C);
    if constexpr (STEP == 5) { if (even) phase_attn_even(C); else phase_attn_odd(C, a, i); }
    if constexpr (STEP == 6) phase_diff_combine(C, a, i, l);
    if constexpr (STEP == 7) { pg8::Gemm g{WSP(bf16_t, A_OB), WSP(bf16_t, swl + SW_WOUT), DM, DM}; pg8::StaticOrder S; S.init(NTOK, DM, C.G, C.bid);
        pg8::EpiResid E{l == 0 ? a.x : WSP(float, WS_XF), WSP(float, WS_XF), DN_ALPHA}; pg8::gemm_phase<pg8::EpiResid, pg8::StaticOrder, true>(C.lds, g, S, E, C.tid); }
    if constexpr (STEP == 8) phase_ln1(C, a, l);
    if constexpr (STEP == 9) { pg8::Gemm g{WSP(bf16_t, A_XS), WSP(bf16_t, WS_WR + (size_t)l * MiB), 2048, 2048}; pg8::StaticOrder S; S.init(NTOK, 256, C.G, C.bid);
        pg8::EpiF32 E{WSP(float, A_LOG), 256}; pg8::gemm_phase<pg8::EpiF32, pg8::StaticOrder, true>(C.lds, g, S, E, C.tid); }
    if constexpr (STEP == 10) phase_route(C, a, l);
    if constexpr (STEP == 11) { moe_tables(C, l);
        const LAS int* tst = (const LAS int*)(C.lds + LX_TST);
        MoeOrder<true> S{(const LAS int*)(C.lds + LX_CNT), tst, (const LAS unsigned char*)(C.lds + LX_TEXP), WSP(int, WS_ROWTOK), __builtin_amdgcn_readfirstlane(tst[64]), 128, 2, C.G, C.bid, SLOTS_R};
        pg8::Gemm g{WSP(bf16_t, A_XS), WSP(bf16_t, WS_WGU), 2048, DM}; pg8::EpiSwiGLU E{WSP(bf16_t, WS_HS)};
        pg8::gemm_phase<pg8::EpiSwiGLU, MoeOrder<true>, true>(C.lds, g, S, E, C.tid); }
    if constexpr (STEP == 12) { moe_tables(C, l);
        const LAS int* tst = (const LAS int*)(C.lds + LX_TST);
        MoeOrder<false> S{(const LAS int*)(C.lds + LX_CNT), tst, (const LAS unsigned char*)(C.lds + LX_TEXP), WSP(int, WS_ROWTOK), __builtin_amdgcn_readfirstlane(tst[64]), 0, 4, C.G, C.bid, 0};
        pg8::Gemm g{WSP(bf16_t, WS_HS), WSP(bf16_t, WS_WD), DE, DE}; pg8::EpiBf16 E{WSP(bf16_t, WS_YS), DM};
        pg8::gemm_phase<pg8::EpiBf16, MoeOrder<false>, true>(C.lds, g, S, E, C.tid); }
    if constexpr (STEP == 13) { moe_tables(C, l);
        const LAS int* tst = (const LAS int*)(C.lds + LX_TST);
        MoeOrder<false> S{(const LAS int*)(C.lds + LX_CNT), tst, (const LAS unsigned char*)(C.lds + LX_TEXP), WSP(int, WS_ROWTOK), 0, 128, 4, C.G, C.bid, 0};
        pg8::Gemm g{WSP(bf16_t, WS_HS), WSP(bf16_t, WS_WD), DE, DE}; pg8::EpiResid E{WSP(float, WS_XF), WSP(float, WS_XF), DN_ALPHA};
        pg8::gemm_phase<pg8::EpiResid, MoeOrder<false>, true>(C.lds, g, S, E, C.tid); }
    if constexpr (STEP == 14) { moe_tables(C, l); phase_combine_ln2(C, a, l); }
}
__global__ void __launch_bounds__(NTHREADS, 2) mega_fwd(Args a) {
    extern __shared__ __attribute__((aligned(16))) unsigned char lds_raw[];
    LAS unsigned char* lds = (LAS unsigned char*)lds_raw;
    const CAS Args* ka = (const CAS Args*)__builtin_amdgcn_kernarg_segment_ptr();
    const int wv = __builtin_amdgcn_readfirstlane(threadIdx.x >> 6);
    if (threadIdx.x < 4) ((LAS unsigned*)(lds + LX_BAR))[threadIdx.x] = 0u;
    __syncthreads();
    unsigned* barw = (unsigned*)(a.ws + WS_CTL) + CW_BAR;
    XcdBarrier bar; bar.bar = barw; bar.x = 0; bar.st = nullptr;
    if (a.use_bar) bar = xcd_barrier_post(barw, (volatile LAS unsigned*)(lds + LX_BAR));
    int step = 0;
#define RUN(K, cond) do { if (step >= a.st_lo && step < a.st_hi) { if (cond) { const CAS Args* kp = ka; asm volatile("" : "+s"(kp)); step_fn<K>(kp, lds, l, wv); } if (a.use_bar && step + 1 < a.st_hi) { XcdBarrier b2 = bar; asm volatile("" : "+s"(b2.bar)); int w2 = wv; asm volatile("" : "+s"(w2)); int l2_; asm volatile("v_mbcnt_lo_u32_b32 %0, -1, 0\n\tv_mbcnt_hi_u32_b32 %0, -1, %0" : "=v"(l2_)); xcd_barrier(b2, w2 == 0 && l2_ == 0); } } ++step; } while (0)
    { const int l = 0; RUN(99, true); }
#pragma unroll 1
    for (int l = 0; l < DEPTH; ++l) {
        const bool even = !(l & 1);
        RUN(0, true); RUN(1, true); RUN(2, true); RUN(3, even); RUN(4, even); RUN(5, true); RUN(6, !even); RUN(7, true);
        RUN(8, true); RUN(9, true); RUN(10, true); RUN(11, true); RUN(12, true); RUN(13, true); RUN(14, true);
    }
#undef RUN
}

extern "C" void kernel_launch(void* const* d_in, const int* in_sizes, int n_in, void* d_out, int out_size, void* d_ws, size_t ws_size, hipStream_t stream) {
    static int grid = 0;
    if (grid == 0) {
        if (n_in != 23 || out_size != NTOK * DM || ws_size < WS_END) { fprintf(stderr, "kernel_launch: unexpected problem shape (n_in %d out %d ws %zu)\n", n_in, out_size, ws_size); grid = -1; return; }
        int dev = 0, cus = 0;
        if (hipGetDevice(&dev) != hipSuccess || hipDeviceGetAttribute(&cus, hipDeviceAttributeMultiprocessorCount, dev) != hipSuccess) { grid = -1; return; }
        if (hipFuncSetAttribute((const void*)mega_fwd, hipFuncAttributeMaxDynamicSharedMemorySize, LDS_BYTES) != hipSuccess) { fprintf(stderr, "kernel_launch: hipFuncSetAttribute failed\n"); grid = -1; return; }
        int per_cu = 0;
        if (hipOccupancyMaxActiveBlocksPerMultiprocessor(&per_cu, (const void*)mega_fwd, NTHREADS, LDS_BYTES) != hipSuccess || per_cu < 1) { fprintf(stderr, "kernel_launch: occupancy query says %d\n", per_cu); }
        (void)hipGetLastError();
        grid = cus;
    }
    if (grid < 0) return;
    if (hipMemsetAsync((char*)d_ws + WS_CTL, 0, CTL_ZERO_BYTES, stream) != hipSuccess) return;
    Args a{};
    a.x = (const float*)d_in[0]; a.pos = (const int*)d_in[1];
    a.ev_w_in = (const float*)d_in[2]; a.ev_w_out = (const float*)d_in[3]; a.mla_g_qa = (const float*)d_in[4]; a.mla_w_qb = (const float*)d_in[5]; a.mla_g_kva = (const float*)d_in[6]; a.mla_w_kvb = (const float*)d_in[7];
    a.od_w_in = (const float*)d_in[8]; a.od_w_out = (const float*)d_in[9]; a.swa_sinks = (const float*)d_in[10]; a.diff_lambda = (const float*)d_in[11]; a.diff_g_subln = (const float*)d_in[12];
    a.ln_g = (const float*)d_in[13]; a.ln_b = (const float*)d_in[14]; a.moe_w_router = (const float*)d_in[15]; a.moe_bias = (const float*)d_in[16];
    a.moe_w_gate = (const float*)d_in[17]; a.moe_w_up = (const float*)d_in[18]; a.moe_w_down = (const float*)d_in[19]; a.sh_w_gate = (const float*)d_in[20]; a.sh_w_up = (const float*)d_in[21]; a.sh_w_down = (const float*)d_in[22];
    a.out = (float*)d_out; a.ws = (unsigned char*)d_ws;
#ifndef MK_ONE_LAUNCH
#define MK_ONE_LAUNCH 1
#endif
    if (MK_ONE_LAUNCH) {
        a.st_lo = 0; a.st_hi = NSTEPS; a.use_bar = 1;
        hipLaunchKernelGGL(mega_fwd, dim3(grid), dim3(NTHREADS), LDS_BYTES, stream, a);
    } else {
        for (int s = 0; s < NSTEPS; ++s) {
            if (s > 0) { const int ls = (s - 1) % STEPS_PER_LAYER, l = (s - 1) / STEPS_PER_LAYER; const bool even = !(l & 1);
                if (even && ls == 6) continue; if (!even && (ls == 3 || ls == 4)) continue; }
            a.st_lo = s; a.st_hi = s + 1; a.use_bar = 0;
            hipLaunchKernelGGL(mega_fwd, dim3(grid), dim3(NTHREADS), LDS_BYTES, stream, a);
        }
    }
}
```

```cpp
#include <hip/hip_runtime.h>
#include <cstdio>
#include <cstdint>

#define GAS __attribute__((address_space(1)))
#define LAS __attribute__((address_space(3)))
typedef unsigned short bf16_t;
typedef short bf16x8 __attribute__((ext_vector_type(8)));
typedef short s16x4 __attribute__((ext_vector_type(4)));
typedef float f32x2 __attribute__((ext_vector_type(2)));
typedef float f32x4 __attribute__((ext_vector_type(4)));
typedef float f32x16 __attribute__((ext_vector_type(16)));
typedef unsigned u32x2 __attribute__((ext_vector_type(2)));
typedef unsigned u32x4 __attribute__((ext_vector_type(4)));

constexpr int NTOK = 32768, DM = 1024, SEQ = 4096, NBATCH = 8, DEPTH = 4;
constexpr int EV_IN = 1952, OD_IN = 2304, HB_LD = 2304;
constexpr int NE = 64, DE = 256, TOPK = 8, CAP = 32768;
constexpr int TR_MAX = 1088;
constexpr int SLOTS_R = TR_MAX * 256;
constexpr int SLOTS = SLOTS_R + NTOK;
constexpr float DN_ALPHA = 1.681792830507429f;
constexpr float LOG2E = 1.4426950408889634f;

__device__ __forceinline__ unsigned f2bf(float f) { unsigned u = __builtin_bit_cast(unsigned, f); return (u + 0x7fffu + ((u >> 16) & 1u)) >> 16; }
__device__ __forceinline__ float bf2f(unsigned b) { return __builtin_bit_cast(float, b << 16); }
__device__ __forceinline__ unsigned pk2(float lo, float hi) { return f2bf(lo) | (f2bf(hi) << 16); }
__device__ __forceinline__ float wave_sum(float v) {
#pragma unroll
    for (int o = 1; o < 64; o <<= 1) v += __shfl_xor(v, o);
    return v;
}
namespace pg8 {
constexpr int BM = 256, BK = 64, HALF = 128, HTB = HALF * BK * 2  , STAGE_BYTES = 8 * HTB, NXCD = 8, WGM = 8;
__host__ __device__ __forceinline__ int lds_byte(int r, int c) { const int st = (r >> 4) * 2 + (c >> 5), rr = r & 15, cc = c & 31, ob = rr * 64 + cc * 2; return st * 1024 + (ob ^ (((ob >> 9) & 1) << 5)); }
__host__ __device__ __forceinline__ void stage_rc(int b, int& R, int& C) { const int st = b / 1024, sb = b % 1024, swz = sb ^ (((sb >> 9) & 1) << 5); R = (st >> 1) * 16 + swz / 64; C = (st & 1) * 32 + (swz % 64) / 2; }
__host__ __device__ __forceinline__ int perm32(int rho) { const int n = rho >> 4, i = rho & 15; return 8 * (i >> 2) + 4 * n + (i & 3); }

struct Unit { int pm, pn, orow, ocol, e, lt; };
struct Gemm { const bf16_t* A; const bf16_t* Bt; int lda, K; };

struct StaticOrder {
    static constexpr bool GATHER = false;
    int nM, nN, nwg, G, c;
    __device__ void init(int M, int N, int G_, int c_) { nM = M / BM; nN = N / BM; nwg = nM * nN; G = G_; c = c_; }
    __device__ __forceinline__ bool next(int i, Unit& u) const {
        const long L = (long)i * G + c; if (L >= nwg) return false;
        int wgid = (int)L; { const int q = nwg / NXCD, r = nwg % NXCD, xcd = wgid % NXCD, off = wgid / NXCD; wgid = (xcd < r ? xcd * (q + 1) : r * (q + 1) + (xcd - r) * q) + off; }
        const int nig = WGM * nN, gid = wgid / nig, fm = gid * WGM, gsz = (nM - fm) < WGM ? (nM - fm) : WGM;
        u.pm = fm + ((wgid % nig) % gsz); u.pn = (wgid % nig) / gsz; u.orow = u.pm * BM; u.ocol = u.pn * BM; u.e = 0; u.lt = u.pm; return true;
    }
    __device__ __forceinline__ unsigned arow(const Unit& u, int r) const { return (unsigned)(u.pm * BM + r); }
};

__device__ __forceinline__ unsigned cvt_pk_bf16(float lo, float hi) { unsigned r; asm volatile("v_cvt_pk_bf16_f32 %0, %1, %2" : "=v"(r) : "v"(lo), "v"(hi)); return r; }

struct EpiBf16 {
    static constexpr bool PERM = true;
    bf16_t* O; int ldc;
    __device__ __forceinline__ void operator()(const f32x4 (&acc)[2][2][4][2], const Unit& u, int wr, int wc, int fr, int fq) const {
        const int row0 = u.orow + wr * 64 + fr, col0 = u.ocol + wc * 32 + 8 * fq;
#pragma unroll
        for (int ai = 0; ai < 2; ++ai)
#pragma unroll
            for (int m = 0; m < 4; ++m) { bf16_t* rowp = O + (size_t)(row0 + ai * HALF + m * 16) * ldc + col0;
#pragma unroll
                for (int bj = 0; bj < 2; ++bj) { const f32x4 v0 = acc[ai][bj][m][0], v1 = acc[ai][bj][m][1];
                    u32x4 w; w.x = cvt_pk_bf16(v0[0], v0[1]); w.y = cvt_pk_bf16(v0[2], v0[3]); w.z = cvt_pk_bf16(v1[0], v1[1]); w.w = cvt_pk_bf16(v1[2], v1[3]);
                    *(u32x4*)(rowp + bj * HALF) = w; } }
    }
};
struct EpiF32 {
    static constexpr bool PERM = false;
    float* C; int ldc;
    __device__ __forceinline__ void operator()(const f32x4 (&acc)[2][2][4][2], const Unit& u, int wr, int wc, int fr, int fq) const {
        const int row0 = u.orow + wr * 64 + fr, col0 = u.ocol + wc * 32 + 4 * fq;
#pragma unroll
        for (int ai = 0; ai < 2; ++ai)
#pragma unroll
            for (int m = 0; m < 4; ++m) { float* rowp = C + (size_t)(row0 + ai * HALF + m * 16) * ldc + col0;
#pragma unroll
                for (int bj = 0; bj < 2; ++bj)
#pragma unroll
                    for (int n = 0; n < 2; ++n) *(f32x4*)(rowp + bj * HALF + n * 16) = acc[ai][bj][m][n]; }
    }
};
struct EpiResid {
    static constexpr bool PERM = false;
    const float* src; float* dst; float alpha;
    __device__ __forceinline__ void operator()(const f32x4 (&acc)[2][2][4][2], const Unit& u, int wr, int wc, int fr, int fq) const {
        const int row0 = u.orow + wr * 64 + fr, col0 = u.ocol + wc * 32 + 4 * fq;
#pragma unroll
        for (int ai = 0; ai < 2; ++ai)
#pragma unroll
            for (int m = 0; m < 4; ++m) { const size_t ro = (size_t)(row0 + ai * HALF + m * 16) * DM + col0;
#pragma unroll
                for (int bj = 0; bj < 2; ++bj)
#pragma unroll
                    for (int n = 0; n < 2; ++n) { const f32x4 s = *(const f32x4*)(src + ro + bj * HALF + n * 16); *(f32x4*)(dst + ro + bj * HALF + n * 16) = s * alpha + acc[ai][bj][m][n]; } }
    }
};
struct EpiSwiGLU {
    static constexpr bool PERM = true;
    bf16_t* H;
    __device__ __forceinline__ void operator()(const f32x4 (&acc)[2][2][4][2], const Unit& u, int wr, int wc, int fr, int fq) const {
        const int row0 = u.orow + wr * 64 + fr, col0 = u.ocol + wc * 32 + 8 * fq;
#pragma unroll
        for (int ai = 0; ai < 2; ++ai)
#pragma unroll
            for (int m = 0; m < 4; ++m) { bf16_t* rowp = H + (size_t)(row0 + ai * HALF + m * 16) * DE + col0;
                float h[8];
#pragma unroll
                for (int n = 0; n < 2; ++n)
#pragma unroll
                    for (int j = 0; j < 4; ++j) { const float g = acc[ai][0][m][n][j], up = acc[ai][1][m][n][j]; h[n * 4 + j] = g / (1.0f + __expf(-g)) * up; }
                u32x4 w; w.x = cvt_pk_bf16(h[0], h[1]); w.y = cvt_pk_bf16(h[2], h[3]); w.z = cvt_pk_bf16(h[4], h[5]); w.w = cvt_pk_bf16(h[6], h[7]);
                *(u32x4*)rowp = w; }
    }
};
struct EpiDown {
    static constexpr bool PERM = true;
    bf16_t* Y; const float* wslot; const LAS int* cnt;
    __device__ __forceinline__ void operator()(const f32x4 (&acc)[2][2][4][2], const Unit& u, int wr, int wc, int fr, int fq) const {
        const int rl0 = wr * 64 + fr, col0 = u.ocol + wc * 32 + 8 * fq; const int ce = cnt[u.e];
#pragma unroll
        for (int ai = 0; ai < 2; ++ai)
#pragma unroll
            for (int m = 0; m < 4; ++m) { const int rl = rl0 + ai * HALF + m * 16, loc = u.lt * BM + rl;
                const float gw = loc < ce ? wslot[(size_t)u.e * CAP + loc] : 0.f;
                bf16_t* rowp = Y + (size_t)(u.orow + rl) * DM + col0;
#pragma unroll
                for (int bj = 0; bj < 2; ++bj) { const f32x4 v0 = acc[ai][bj][m][0] * gw, v1 = acc[ai][bj][m][1] * gw;
                    u32x4 w; w.x = cvt_pk_bf16(v0[0], v0[1]); w.y = cvt_pk_bf16(v0[2], v0[3]); w.z = cvt_pk_bf16(v1[0], v1[1]); w.w = cvt_pk_bf16(v1[2], v1[3]);
                    *(u32x4*)(rowp + bj * HALF) = w; } }
    }
};

template <class Epi, class Sched, bool ALIGN_EPI>
__device__ __forceinline__ void gemm_phase(LAS unsigned char* lds, const Gemm g, const Sched& S, const Epi& E, const int tid) {
    const int wid = __builtin_amdgcn_readfirstlane(tid >> 6), lane = tid & 63, wr = wid >> 2, wc = wid & 3, fr = lane & 15, fq = lane >> 4;
    const int K = g.K, nt = K / BK;
    constexpr bool GATHER = Sched::GATHER;
    int Ra[2]; unsigned Ca[2], voffA[2], voffB[2];
    const unsigned ldab = (unsigned)g.lda * 2u;
#pragma unroll
    for (int i = 0; i < 2; ++i) { int R, C; stage_rc(tid * 16 + i * 8192, R, C); const int Rb = Epi::PERM ? ((R & ~31) + perm32(R & 31)) : R;
        Ra[i] = R; Ca[i] = (unsigned)C * 2u; voffA[i] = (unsigned)R * ldab + (unsigned)C * 2u; voffB[i] = (unsigned)(Rb * K + C) * 2u; }
    const size_t hstepA = (size_t)HALF * ldab;
    const size_t kstep = (size_t)(BK * 2);
    const size_t hstep = (size_t)HALF * K * 2;
    const size_t tstep = 2 * hstep;
    const unsigned ldsw = (unsigned)wid * 1024u;
    const int aoff = lds_byte(wr * 64 + fr, fq * 8), boff = lds_byte(wc * 32 + fr, fq * 8);
    const char* Ab = (const char*)g.A;
#define PG8_SA(b, h) (((b) * 2 + (h)) * HTB)
#define PG8_SB(b, h) ((4 + (b) * 2 + (h)) * HTB)
#define PG8_STAGE(bufoff, gbase, voff) do { _Pragma("unroll") for (int _i = 0; _i < 2; ++_i) \
        __builtin_amdgcn_global_load_lds((const unsigned*)((const char*)(gbase) + (voff)[_i]), (LAS unsigned*)(lds + (bufoff) + ldsw + _i * 8192), 16, 0, 0); } while (0)
#define PG8_STAGEA(bufoff, offs, ubase, h, kbyte) do { _Pragma("unroll") for (int _i = 0; _i < 2; ++_i) { \
        const char* _src = GATHER ? Ab + (size_t)(offs)[h][_i] + (size_t)(kbyte) : (ubase) + (size_t)(h) * hstepA + (size_t)(kbyte) + voffA[_i]; \
        __builtin_amdgcn_global_load_lds((const unsigned*)_src, (LAS unsigned*)(lds + (bufoff) + ldsw + _i * 8192), 16, 0, 0); } } while (0)
#define PG8_OFFS(dst, u) do { if constexpr (GATHER) { _Pragma("unroll") for (int _h = 0; _h < 2; ++_h) _Pragma("unroll") for (int _i = 0; _i < 2; ++_i) dst[_h][_i] = S.arow(u, _h * HALF + Ra[_i]) * ldab + Ca[_i]; } } while (0)
#define PG8_LDA(dst, b, h) do { _Pragma("unroll") for (int m = 0; m < 4; ++m) _Pragma("unroll") for (int k = 0; k < 2; ++k) dst[m][k] = *(const LAS bf16x8*)(lds + PG8_SA(b, h) + aoff + m * 2048 + k * 1024); } while (0)
#define PG8_LDB(dst, b, h) do { _Pragma("unroll") for (int n = 0; n < 2; ++n) _Pragma("unroll") for (int k = 0; k < 2; ++k) dst[n][k] = *(const LAS bf16x8*)(lds + PG8_SB(b, h) + boff + n * 2048 + k * 1024); } while (0)
#define PG8_MMA(ai, bj, At, Bt) do { __builtin_amdgcn_s_setprio(1); _Pragma("unroll") for (int m = 0; m < 4; ++m) _Pragma("unroll") for (int n = 0; n < 2; ++n) _Pragma("unroll") for (int k = 0; k < 2; ++k) \
        acc[ai][bj][m][n] = __builtin_amdgcn_mfma_f32_16x16x32_bf16(Bt[n][k], At[m][k], acc[ai][bj][m][n], 0, 0, 0); __builtin_amdgcn_s_setprio(0); } while (0)
#define PG8_WAIT_V(n) asm volatile("s_waitcnt vmcnt(" #n ")" ::: "memory")
#define PG8_WAIT_L(n) asm volatile("s_waitcnt lgkmcnt(" #n ")" ::: "memory")
#define PG8_BAR __builtin_amdgcn_s_barrier()
#define PG8_SCHED __builtin_amdgcn_sched_barrier(0)
    Unit cur, nxt; int ui = 0;
    if (!S.next(0, cur)) return;
    f32x4 acc[2][2][4][2];
#pragma unroll
    for (int a = 0; a < 2; ++a)
#pragma unroll
        for (int b = 0; b < 2; ++b)
#pragma unroll
            for (int m = 0; m < 4; ++m)
#pragma unroll
                for (int n = 0; n < 2; ++n) acc[a][b][m][n] = (f32x4){0.f, 0.f, 0.f, 0.f};
    bf16x8 At[4][2], B0[2][2], B1[2][2];
    unsigned oc[2][2] = {{0u, 0u}, {0u, 0u}}, on[2][2] = {{0u, 0u}, {0u, 0u}};
    PG8_OFFS(oc, cur);
    const char* cA = Ab + (size_t)S.arow(cur, 0) * ldab;
    const char* cB = (const char*)g.Bt + (size_t)cur.pn * tstep;
    PG8_STAGE(PG8_SB(0, 0), cB, voffB); PG8_STAGE(PG8_SB(0, 1), cB + hstep, voffB); PG8_STAGEA(PG8_SA(0, 0), oc, cA, 0, 0); PG8_STAGEA(PG8_SA(0, 1), oc, cA, 1, 0);
    if (wr == 1) PG8_BAR;
    PG8_WAIT_V(2); PG8_BAR;
    PG8_STAGE(PG8_SB(1, 0), cB + kstep, voffB); PG8_STAGEA(PG8_SA(1, 0), oc, cA, 0, kstep); PG8_STAGE(PG8_SB(1, 1), cB + hstep + kstep, voffB);
    PG8_WAIT_V(6); PG8_BAR;
    for (;;) {
        const bool has_next = S.next(ui + 1, nxt);
        if (has_next) { PG8_OFFS(on, nxt); } else {
#pragma unroll
            for (int h = 0; h < 2; ++h)
#pragma unroll
                for (int i = 0; i < 2; ++i) on[h][i] = oc[h][i]; }
        const char* nB = has_next ? (const char*)g.Bt + (size_t)nxt.pn * tstep : cB;
        const char* nA = has_next ? Ab + (size_t)S.arow(nxt, 0) * ldab : cA;
        for (int t = 0; t < nt; t += 2) {
            const bool last = (t == nt - 2);
            const size_t k1 = (size_t)(t + 1) * kstep;
            const size_t k2 = last ? 0 : (size_t)(t + 2) * kstep, k3 = k2 + kstep;
            const char* b2 = last ? nB : cB + (size_t)(t + 2) * kstep; const char* b3 = b2 + kstep;
            unsigned o2[2][2]; const char* a2 = last ? nA : cA;
#pragma unroll
            for (int h = 0; h < 2; ++h)
#pragma unroll
                for (int i = 0; i < 2; ++i) o2[h][i] = last ? on[h][i] : oc[h][i];
            PG8_LDB(B0, 0, 0); PG8_LDB(B1, 0, 1); PG8_SCHED; PG8_LDA(At, 0, 0); PG8_STAGEA(PG8_SA(1, 1), oc, cA, 1, k1);
            PG8_WAIT_V(8); PG8_WAIT_L(0); PG8_BAR; PG8_MMA(0, 0, At, B0); PG8_MMA(0, 1, At, B1); PG8_BAR; PG8_SCHED;
            PG8_LDA(At, 0, 1); PG8_STAGE(PG8_SB(0, 0), b2, voffB); PG8_STAGE(PG8_SB(0, 1), b2 + hstep, voffB); PG8_STAGEA(PG8_SA(0, 0), o2, a2, 0, k2);
            PG8_WAIT_V(8); PG8_WAIT_L(0); PG8_BAR; PG8_MMA(1, 0, At, B0); PG8_MMA(1, 1, At, B1); PG8_BAR; PG8_SCHED;
            PG8_LDB(B0, 1, 0); PG8_LDB(B1, 1, 1); PG8_SCHED; PG8_LDA(At, 1, 0); PG8_STAGEA(PG8_SA(0, 1), o2, a2, 1, k2);
            PG8_WAIT_V(8); PG8_WAIT_L(0); PG8_BAR; PG8_MMA(0, 0, At, B0); PG8_MMA(0, 1, At, B1); PG8_BAR; PG8_SCHED;
            PG8_LDA(At, 1, 1); PG8_STAGE(PG8_SB(1, 0), b3, voffB); PG8_STAGE(PG8_SB(1, 1), b3 + hstep, voffB); PG8_STAGEA(PG8_SA(1, 0), o2, a2, 0, k3);
            PG8_WAIT_V(8); PG8_WAIT_L(0); PG8_BAR; PG8_MMA(1, 0, At, B0); PG8_MMA(1, 1, At, B1); PG8_BAR; PG8_SCHED;
        }
        if constexpr (ALIGN_EPI) { if (wr == 0) PG8_BAR; }
        { int l2; asm volatile("v_mbcnt_lo_u32_b32 %0, -1, 0\n\tv_mbcnt_hi_u32_b32 %0, -1, %0" : "=v"(l2)); E(acc, cur, wr, wc, l2 & 15, l2 >> 4); }
        if (!has_next) break;
#pragma unroll
        for (int a = 0; a < 2; ++a)
#pragma unroll
            for (int b = 0; b < 2; ++b)
#pragma unroll
                for (int m = 0; m < 4; ++m)
#pragma unroll
                    for (int n = 0; n < 2; ++n) acc[a][b][m][n] = (f32x4){0.f, 0.f, 0.f, 0.f};
        cur = nxt; cB = nB; cA = nA; ++ui;
#pragma unroll
        for (int h = 0; h < 2; ++h)
#pragma unroll
            for (int i = 0; i < 2; ++i) oc[h][i] = on[h][i];
        if constexpr (ALIGN_EPI) { if (wr == 1) PG8_BAR; }
    }
    PG8_WAIT_V(0);
    if constexpr (!ALIGN_EPI) { if (wr == 0) PG8_BAR; }
    PG8_BAR;
#undef PG8_SA
#undef PG8_SB
#undef PG8_STAGE
#undef PG8_STAGEA
#undef PG8_OFFS
#undef PG8_LDA
#undef PG8_LDB
#undef PG8_MMA
#undef PG8_WAIT_V
#undef PG8_WAIT_L
#undef PG8_BAR
#undef PG8_SCHED
}
}
namespace att {
constexpr int MODE_CAUSAL = 0, MODE_MOBA = 1, MODE_SWA = 2;
constexpr int KPAD = 8;
__device__ __forceinline__ unsigned cvtpk(float lo, float hi) { unsigned r; asm volatile("v_cvt_pk_bf16_f32 %0, %1, %2" : "=v"(r) : "v"(lo), "v"(hi)); return r; }
template <int DK, int DV> struct Geo {
    static constexpr int KP = DK + KPAD, VP = DV + KPAD;
    static constexpr int KB = 64 * KP * 2, VB = 64 * VP * 2;
    static constexpr int KCH = 64 * DK / 8, VCH = 64 * DV / 8;
    static constexpr int KPT = (KCH + 511) / 512, VPT = (VCH + 511) / 512;
    static constexpr int LDS_BYTES = KB + VB;
};
struct Tens { const bf16_t* Q; const bf16_t* K; const bf16_t* V; void* O; int ldq, ldk, ldv, ldo; };

template <int DK, int DV, int MODE, bool OF32>
__device__ __forceinline__ void unit(const Tens& T, int b, int qb, const float* kmean, float sink, LAS unsigned char* lds, const int tid) {
    typedef Geo<DK, DV> G;
    asm volatile("; UNIT_BEGIN %0 %1 %2" :: "n"(DK), "n"(DV), "n"(MODE));
    const int lane = tid & 63, r32 = lane & 31, hi = lane >> 5; const int wid = __builtin_amdgcn_readfirstlane(tid >> 6);
    const size_t rowbase = (size_t)b * SEQ;
    const int q0 = qb * 256, qw0 = q0 + wid * 32, qabs = qw0 + r32;
    LAS unsigned char* Ks = lds; LAS unsigned char* Vs = lds + G::KB;
    bf16x8 qf[DK / 16];
    { const bf16_t* qp = T.Q + (rowbase + qabs) * T.ldq + 8 * hi;
#pragma unroll
      for (int d0 = 0; d0 < DK / 16; ++d0) qf[d0] = *(const bf16x8*)(qp + 16 * d0); }
    int sel0 = -1, sel1 = -1, sel2 = -1;
    if constexpr (MODE == MODE_MOBA) {
        float b0 = -INFINITY, b1 = -INFINITY, b2 = -INFINITY;
        float qv[32];
#pragma unroll
        for (int d0 = 0; d0 < 4; ++d0)
#pragma unroll
            for (int e = 0; e < 8; ++e) qv[8 * d0 + e] = bf2f((unsigned short)qf[d0][e]);
        const float* kmp = kmean + 8 * hi;
#pragma unroll 1
        for (int j = 0; j < qb; ++j, kmp += 128) {
            float a = 0.f;
#pragma unroll
            for (int d0 = 0; d0 < 4; ++d0) { const f32x4 k0 = *(const f32x4*)(kmp + 16 * d0) + *(const f32x4*)(kmp + 16 * d0 + 64), k1 = *(const f32x4*)(kmp + 16 * d0 + 4) + *(const f32x4*)(kmp + 16 * d0 + 68);
#pragma unroll
                for (int e = 0; e < 4; ++e) { a += qv[8 * d0 + e] * k0[e]; a += qv[8 * d0 + 4 + e] * k1[e]; } }
            a += __shfl_xor(a, 32);
            if (a > b0) { b2 = b1; sel2 = sel1; b1 = b0; sel1 = sel0; b0 = a; sel0 = j; }
            else if (a > b1) { b2 = b1; sel2 = sel1; b1 = a; sel1 = j; }
            else if (a > b2) { b2 = a; sel2 = j; }
        }
    }
    int t_lo, t_hi;
    if constexpr (MODE == MODE_SWA) { t_lo = qb == 0 ? 0 : qb * 4 - 2; t_hi = qb * 4 + 4; } else { t_lo = 0; t_hi = qb * 4 + 4; }
    u32x4 kreg[G::KPT], vreg[G::VPT];
    const bf16_t* Kg = T.K + rowbase * T.ldk; const bf16_t* Vg = T.V + rowbase * T.ldv;
    unsigned kgo[G::KPT], vgo[G::VPT], klo[G::KPT], vlo[G::VPT];
#pragma unroll
    for (int i_ = 0; i_ < G::KPT; ++i_) { const int c_ = tid + 512 * i_, row_ = c_ / (DK / 8), cc_ = c_ % (DK / 8); kgo[i_] = (unsigned)(row_ * T.ldk + cc_ * 8) * 2u; klo[i_] = (unsigned)(row_ * (G::KP * 2) + cc_ * 16); }
#pragma unroll
    for (int i_ = 0; i_ < G::VPT; ++i_) { const int c_ = tid + 512 * i_, row_ = c_ / (DV / 8), cc_ = c_ % (DV / 8); vgo[i_] = (unsigned)(row_ * T.ldv + cc_ * 8) * 2u; vlo[i_] = (unsigned)(row_ * (G::VP * 2) + cc_ * 16); }
#define ATT_LOAD(t) do { const char* kt_ = (const char*)(Kg + (size_t)(t) * 64 * T.ldk); const char* vt_ = (const char*)(Vg + (size_t)(t) * 64 * T.ldv); \
        _Pragma("unroll") for (int i_ = 0; i_ < G::KPT; ++i_) { if (tid + 512 * i_ < G::KCH) kreg[i_] = *(const u32x4*)(kt_ + kgo[i_]); } \
        _Pragma("unroll") for (int i_ = 0; i_ < G::VPT; ++i_) { if (tid + 512 * i_ < G::VCH) vreg[i_] = *(const u32x4*)(vt_ + vgo[i_]); } } while (0)
#define ATT_STORE() do { \
        _Pragma("unroll") for (int i_ = 0; i_ < G::KPT; ++i_) { if (tid + 512 * i_ < G::KCH) *(LAS u32x4*)(Ks + klo[i_]) = kreg[i_]; } \
        _Pragma("unroll") for (int i_ = 0; i_ < G::VPT; ++i_) { if (tid + 512 * i_ < G::VCH) *(LAS u32x4*)(Vs + vlo[i_]) = vreg[i_]; } } while (0)
    float mrun = -1e30f, lrun = 0.f;
    if constexpr (MODE == MODE_SWA) { mrun = sink; lrun = hi == 0 ? 1.f : 0.f; }
    f32x16 o[DV / 32];
#pragma unroll
    for (int d = 0; d < DV / 32; ++d) o[d] = f32x16{};
    const int krow = (r32 & 0x13) | ((r32 & 4) << 1) | ((r32 & 8) >> 1);
    const LAS unsigned char* kfb = Ks + krow * (G::KP * 2) + hi * 16;
    const int i16 = lane & 15;
    const LAS unsigned char* vfb = Vs + (8 * hi + (i16 >> 2)) * (G::VP * 2) + (16 * (r32 >> 4) + 4 * (i16 & 3)) * 2;
    ATT_LOAD(t_lo);
    for (int t = t_lo; t < t_hi; ++t) {
        __syncthreads();
        ATT_STORE();
        __syncthreads();
        if (t + 1 < t_hi) ATT_LOAD(t + 1);
        const int kv0 = t * 64;
        bool skip = kv0 > qw0 + 31;
        if constexpr (MODE == MODE_SWA) skip = skip || (kv0 + 63 < qw0 - 127);
        if (skip) continue;
        f32x16 p0 = f32x16{}, p1 = f32x16{};
#pragma unroll
        for (int d0 = 0; d0 < DK / 16; ++d0) {
            const bf16x8 k0 = *(const LAS bf16x8*)(kfb + d0 * 32);
            const bf16x8 k1 = *(const LAS bf16x8*)(kfb + 32 * (G::KP * 2) + d0 * 32);
            p0 = __builtin_amdgcn_mfma_f32_32x32x16_bf16(k0, qf[d0], p0, 0, 0, 0);
            p1 = __builtin_amdgcn_mfma_f32_32x32x16_bf16(k1, qf[d0], p1, 0, 0, 0);
        }
        bool need_mask = kv0 + 63 > qw0;
        if constexpr (MODE == MODE_SWA) need_mask = true;
        if constexpr (MODE == MODE_MOBA) { if (kv0 < q0) { const int jb = kv0 >> 8; if (!(jb == sel0 || jb == sel1 || jb == sel2)) {
#pragma unroll
            for (int i = 0; i < 16; ++i) { p0[i] = -INFINITY; p1[i] = -INFINITY; } } } }
        if (need_mask) {
#pragma unroll
            for (int i = 0; i < 16; ++i) { const int kv = kv0 + 16 * (i >> 3) + 8 * hi + (i & 7);
                bool m0 = kv > qabs, m1 = kv + 32 > qabs;
                if constexpr (MODE == MODE_SWA) { m0 = m0 || (kv < qabs - 127); m1 = m1 || (kv + 32 < qabs - 127); }
                if (m0) p0[i] = -INFINITY; if (m1) p1[i] = -INFINITY; }
        }
        float mx = p0[0];
#pragma unroll
        for (int i = 1; i < 16; ++i) mx = fmaxf(mx, p0[i]);
#pragma unroll
        for (int i = 0; i < 16; ++i) mx = fmaxf(mx, p1[i]);
        mx = fmaxf(mx, __shfl_xor(mx, 32));
        const float mnew = fmaxf(mrun, mx);
        const float alpha = __builtin_amdgcn_exp2f(mrun - mnew);
        mrun = mnew;
        float ls = 0.f;
#pragma unroll
        for (int i = 0; i < 16; ++i) { p0[i] = __builtin_amdgcn_exp2f(p0[i] - mnew); p1[i] = __builtin_amdgcn_exp2f(p1[i] - mnew); ls += p0[i] + p1[i]; }
        lrun = lrun * alpha + ls;
#pragma unroll
        for (int d = 0; d < DV / 32; ++d)
#pragma unroll
            for (int i = 0; i < 16; ++i) o[d][i] *= alpha;
        bf16x8 pf[4];
#pragma unroll
        for (int s2 = 0; s2 < 4; ++s2) { const f32x16& pp = (s2 >> 1) ? p1 : p0; const int b0 = 8 * (s2 & 1);
            u32x4 w; w.x = cvtpk(pp[b0 + 0], pp[b0 + 1]); w.y = cvtpk(pp[b0 + 2], pp[b0 + 3]); w.z = cvtpk(pp[b0 + 4], pp[b0 + 5]); w.w = cvtpk(pp[b0 + 6], pp[b0 + 7]);
            pf[s2] = __builtin_bit_cast(bf16x8, w); }
#pragma unroll
        for (int d = 0; d < DV / 32; ++d)
#pragma unroll
            for (int s2 = 0; s2 < 4; ++s2) {
                const LAS unsigned char* vp = vfb + (16 * s2) * (G::VP * 2) + d * 64;
                const s16x4 lo = __builtin_bit_cast(s16x4, __builtin_amdgcn_ds_read_tr16_b64_v4i16((LAS s16x4*)(vp)));
                const s16x4 hh = __builtin_bit_cast(s16x4, __builtin_amdgcn_ds_read_tr16_b64_v4i16((LAS s16x4*)(vp + 4 * (G::VP * 2))));
                const bf16x8 vf = (bf16x8){lo[0], lo[1], lo[2], lo[3], hh[0], hh[1], hh[2], hh[3]};
                o[d] = __builtin_amdgcn_mfma_f32_32x32x16_bf16(vf, pf[s2], o[d], 0, 0, 0);
            }
    }
#undef ATT_LOAD
#undef ATT_STORE
    const float ltot = lrun + __shfl_xor(lrun, 32);
    const float inv = 1.0f / ltot;
    if constexpr (OF32) {
        float* op = (float*)T.O + (rowbase + qabs) * T.ldo + 4 * hi;
#pragma unroll
        for (int d = 0; d < DV / 32; ++d)
#pragma unroll
            for (int g4 = 0; g4 < 4; ++g4) { f32x4 v = {o[d][4 * g4] * inv, o[d][4 * g4 + 1] * inv, o[d][4 * g4 + 2] * inv, o[d][4 * g4 + 3] * inv}; *(f32x4*)(op + 32 * d + 8 * g4) = v; }
    } else {
        bf16_t* op = (bf16_t*)T.O + (rowbase + qabs) * T.ldo + 4 * hi;
#pragma unroll
        for (int d = 0; d < DV / 32; ++d)
#pragma unroll
            for (int g4 = 0; g4 < 4; ++g4) { u32x2 w; w.x = cvtpk(o[d][4 * g4] * inv, o[d][4 * g4 + 1] * inv); w.y = cvtpk(o[d][4 * g4 + 2] * inv, o[d][4 * g4 + 3] * inv); *(u32x2*)(op + 32 * d + 8 * g4) = w; }
    }
}
}
constexpr int NWAVES = 8, NTHREADS = 512;
constexpr size_t MiB = 1u << 20;
constexpr size_t WS_CTL = 0, CTL_ZERO_BYTES = 1 * MiB;
constexpr size_t WS_SMALLW = 1 * MiB;
constexpr size_t SW_LAYER = 8 * MiB, SW_WOUT = 4608 * 1024, SW_WQB = SW_WOUT + 2 * MiB, SW_WKVB = SW_WQB + 384 * 1024;
static_assert(SW_WKVB + 512 * 1024 <= SW_LAYER, "small weights");
constexpr size_t WS_WR = WS_SMALLW + 4 * SW_LAYER;
constexpr size_t WS_ROPE = WS_WR + 4 * MiB;
constexpr size_t WS_KMEAN = WS_ROPE + 8 * MiB;
constexpr size_t WS_WGU = WS_KMEAN + 1 * MiB;
constexpr size_t WS_WD = WS_WGU + 65 * MiB;
constexpr size_t WS_ROWTOK = WS_WD + 33 * MiB;
constexpr size_t WS_WSLOT = WS_ROWTOK + 8 * MiB;
constexpr size_t WS_TOKE = WS_WSLOT + 8 * MiB;
constexpr size_t WS_TOKP = WS_TOKE + 1 * MiB;
constexpr size_t WS_XF = WS_TOKP + 1 * MiB;
constexpr size_t WS_HS = WS_XF + 128 * MiB;
constexpr size_t WS_YS = WS_HS + 152 * MiB;
constexpr size_t WS_END = WS_YS + 544 * MiB;
static_assert(WS_END <= 1024 * MiB, "workspace map exceeds 1 GiB");
constexpr size_t A_HB = WS_YS;
constexpr size_t A_QF = A_HB, A_KVF = A_HB + 48 * MiB;
constexpr size_t A_SSQ = A_HB;
constexpr size_t A_Q1 = A_HB + 144 * MiB;
constexpr size_t A_K1 = A_Q1 + 32 * MiB;
constexpr size_t A_V1 = A_K1 + 32 * MiB;
constexpr size_t A_X1 = A_V1 + 32 * MiB;
constexpr size_t A_X2 = A_X1 + 32 * MiB;
constexpr size_t A_Q2 = A_X2 + 32 * MiB;
constexpr size_t A_OB = A_Q2 + 128 * MiB;
static_assert(A_OB + 64 * MiB <= WS_END, "attention overlay");
constexpr size_t A_XS = WS_YS;
constexpr size_t A_LOG = WS_YS + 128 * MiB;
constexpr int CW_BAR = 4096;
constexpr int CW_CNT = 16384;
constexpr int RING_BYTES = 131072;
constexpr int LX_BAR = RING_BYTES;
constexpr int LX_CNT = RING_BYTES + 64;
constexpr int LX_TST = LX_CNT + 256;
constexpr int LX_TEXP = LX_TST + 320;
constexpr int LDS_BYTES = 147456;
static_assert(LX_TEXP + 1280 <= LDS_BYTES, "LDS map");

#define XB_TMO      128
#define XB_XCNT(j)  (256  + 64 * (j))
#define XB_XSUB(j)  (1280 + 64 * (j))
#define XB_XGEN(j)  (2304 + 64 * (j))
#define XB_TOP      3328
#define XB_TOPGEN   3392
#define XCD_BAR_WORDS 3456
#define XB_SPIN_CAP (1u << 20)
__device__ __forceinline__ unsigned xb_ld(unsigned* p)              { return __hip_atomic_load(p, __ATOMIC_RELAXED, __HIP_MEMORY_SCOPE_AGENT); }
__device__ __forceinline__ unsigned xb_add(unsigned* p, unsigned v) { return __hip_atomic_fetch_add(p, v, __ATOMIC_RELAXED, __HIP_MEMORY_SCOPE_AGENT); }
__device__ __forceinline__ unsigned xb_xcc_id() { return (unsigned)__builtin_amdgcn_s_getreg((3 << 11) | 20) & 0xFu; }
#define XB_SPIN(cond, bar) do { unsigned _sp = 0; while (cond) { __builtin_amdgcn_s_sleep(1); \
    if ((++_sp & 255u) == 0u) { if (xb_ld(&(bar)[XB_TMO])) break; if (_sp > XB_SPIN_CAP) { atomicAdd(&(bar)[XB_TMO], 1u); break; } } } } while (0)
struct XcdBarrier { unsigned* bar; unsigned x; volatile LAS unsigned* st; };
__device__ __forceinline__ XcdBarrier xcd_barrier_post(unsigned* bar, volatile LAS unsigned* st) {
    XcdBarrier b; b.bar = bar; b.x = xb_xcc_id(); b.st = st;
    if (threadIdx.x == 0) (void)xb_add(&bar[XB_XCNT(b.x)], 1u);
    return b;
}
__device__ __forceinline__ void xcd_barrier_complete(unsigned* bar, unsigned x, unsigned& nloc, unsigned& nx) {
    const unsigned G = gridDim.x * gridDim.y * gridDim.z;
    unsigned sum, cnt, mine, sp = 0u;
    for (;;) {
        sum = 0u; cnt = 0u; mine = 0u;
#pragma unroll
        for (unsigned j = 0; j < 16; ++j) { const unsigned c = xb_ld(&bar[XB_XCNT(j)]); sum += c; cnt += (c > 0u) ? 1u : 0u; mine = (j == x) ? c : mine; }
        if (sum == G) break;
        __builtin_amdgcn_s_sleep(1);
        if ((++sp & 255u) == 0u) { if (xb_ld(&bar[XB_TMO])) break; if (sp > XB_SPIN_CAP) { atomicAdd(&bar[XB_TMO], 1u); break; } }
    }
    nloc = mine > 0u ? mine : 1u; nx = cnt > 0u ? cnt : 1u;
}
__device__ __forceinline__ void xcd_barrier(const XcdBarrier& b, const bool leader) {
    asm volatile("s_waitcnt vmcnt(0)" ::: "memory");
    __syncthreads();
    if (leader) {
        unsigned* bar = b.bar; const unsigned bx = xb_xcc_id();
        __builtin_amdgcn_s_waitcnt(0);
        unsigned nloc = b.st[0], nx = b.st[1];
        if (nloc == 0u) { xcd_barrier_complete(bar, bx, nloc, nx); b.st[0] = nloc; b.st[1] = nx; }
        const unsigned old = xb_add(&bar[XB_XSUB(bx)], 1u);
        const unsigned gen = old / nloc;
        if (old + 1u == (gen + 1u) * nloc) {
            __builtin_amdgcn_fence(__ATOMIC_RELEASE, "agent");
            asm volatile("s_waitcnt vmcnt(0)" ::: "memory");
            const unsigned og = xb_add(&bar[XB_TOP], 1u);
            const unsigned tg = og / nx;
            if (og + 1u == (tg + 1u) * nx) xb_add(&bar[XB_TOPGEN], 1u);
            else XB_SPIN(xb_ld(&bar[XB_TOPGEN]) == tg, bar);
            __builtin_amdgcn_fence(__ATOMIC_ACQUIRE, "agent");
            xb_add(&bar[XB_XGEN(bx)], 1u);
            asm volatile("s_waitcnt vmcnt(0)" ::: "memory");
        } else {
            XB_SPIN(xb_ld(&bar[XB_XGEN(bx)]) == gen, bar);
            __builtin_amdgcn_fence(__ATOMIC_ACQUIRE, "agent");
            asm volatile("s_waitcnt vmcnt(0)" ::: "memory");
        }
    }
    __syncthreads();
}

struct Args {
    const float* x; const int* pos;
    const float *ev_w_in, *ev_w_out, *mla_g_qa, *mla_w_qb, *mla_g_kva, *mla_w_kvb, *od_w_in, *od_w_out, *swa_sinks, *diff_lambda, *diff_g_subln, *ln_g, *ln_b,
                *moe_w_router, *moe_bias, *moe_w_gate, *moe_w_up, *moe_w_down, *sh_w_gate, *sh_w_up, *sh_w_down;
    float* out; unsigned char* ws;
    int st_lo, st_hi, use_bar, pad;
};

__device__ __forceinline__ int wrow_map(int mode, int n);
__device__ __forceinline__ void transpose_item(const float* W, int N, int k0, int n0, bf16_t* WT, int ldk, int dst_row0, LAS float* scr, int lane, int mode = 0) {
#pragma unroll 8
    for (int i = 0; i < 32; ++i) { const int kk = 2 * i + (lane >> 5); scr[kk * 33 + (lane & 31)] = W[(size_t)(k0 + kk) * N + n0 + (lane & 31)]; }
    asm volatile("s_waitcnt lgkmcnt(0)" ::: "memory");
    const int c = lane & 7;
#pragma unroll
    for (int j = 0; j < 4; ++j) { const int n = (lane >> 3) + 8 * j; const LAS float* s = scr + (8 * c) * 33 + n;
        u32x4 o; o.x = pk2(s[0 * 33], s[1 * 33]); o.y = pk2(s[2 * 33], s[3 * 33]); o.z = pk2(s[4 * 33], s[5 * 33]); o.w = pk2(s[6 * 33], s[7 * 33]);
        const int drow = mode ? wrow_map(mode, n0 + n) : dst_row0 + n;
        *(u32x4*)(WT + (size_t)drow * ldk + k0 + 8 * c) = o; }
    asm volatile("s_waitcnt lgkmcnt(0)" ::: "memory");
}
__device__ __forceinline__ void sincos_acc(float angf, float& c, float& s) {
    const double x = (double)angf;
    const double n = __builtin_rint(x * 0.63661977236758134308);
    double r = x - n * 1.57079632679489655800; r -= n * 6.12323399573676603587e-17;
    const long q = (long)n;
    const double r2 = r * r;
    double sp = -2.5052108385441718775e-08; sp = sp * r2 + 2.7557319223985890653e-06; sp = sp * r2 - 1.9841269841269841270e-04; sp = sp * r2 + 8.3333333333333333333e-03; sp = sp * r2 - 1.6666666666666666667e-01;
    const double sn = r + r * r2 * sp;
    double cp = 2.0876756987868098979e-09; cp = cp * r2 - 2.7557319223985890653e-07; cp = cp * r2 + 2.4801587301587301587e-05; cp = cp * r2 - 1.3888888888888888889e-03; cp = cp * r2 + 4.1666666666666666667e-02; cp = cp * r2 - 0.5;
    const double cs = 1.0 + r2 * cp;
    double so, co;
    switch ((int)(q & 3)) { case 0: so = sn; co = cs; break; case 1: so = cs; co = -sn; break; case 2: so = -sn; co = -cs; break; default: so = -cs; co = sn; break; }
    s = (float)so; c = (float)co;
}
__host__ __device__ __forceinline__ int perm64(int f) { const int n = f >> 5, r = f & 31, G = r >> 4, fq = (r & 15) >> 2, i = r & 3; return 32 * G + 8 * fq + 4 * n + i; }
__host__ __device__ __forceinline__ int perm_pe(int f) { const int n = f >> 4, r = f & 15, fq = r >> 2, i = r & 3; return 8 * fq + 4 * n + i; }
__device__ __forceinline__ int wrow_map(int mode, int n) {
    if (mode == 1) { if (n < 1024) return (n & ~63) + perm64(n & 63); if (n >= 1920) return 1920 + perm_pe(n - 1920); return n; }
    if (mode == 2) { if (n < 640 || (n >= 768 && n < 1792)) return (n & ~63) + perm64(n & 63); return n; }
    if (mode == 3) { const int h = n / 96, w = n - 96 * h; return w < 64 ? n : 96 * h + 64 + perm_pe(w - 64); }
    return n;
}
constexpr float QS_64 = 0.125f * LOG2E;
constexpr float QS_96 = 0.10206207261596577f * LOG2E;

__device__ __forceinline__ u32x2 pack4(float a, float b, float c, float d) { u32x2 w; w.x = pg8::cvt_pk_bf16(a, b); w.y = pg8::cvt_pk_bf16(c, d); return w; }
__device__ __forceinline__ u32x4 pack8(const f32x4& v0, const f32x4& v1) { u32x4 w; w.x = pg8::cvt_pk_bf16(v0[0], v0[1]); w.y = pg8::cvt_pk_bf16(v0[2], v0[3]); w.z = pg8::cvt_pk_bf16(v1[0], v1[1]); w.w = pg8::cvt_pk_bf16(v1[2], v1[3]); return w; }

struct EpiWin {
    static constexpr bool PERM = true;
    unsigned char* ws; int even; const float* g_qa; const float* g_kva;
    __device__ __forceinline__ void rope_half(const f32x4 (&acc)[2][2][4][2], int bj, const pg8::Unit& u, int rowl, int wr, int wc, int fr, int fq, bf16_t* dst, int ld, int head0, float sc, bool km) const {
        const f32x2* rope = (const f32x2*)(ws + WS_ROPE);
        const int head = head0 + (wc >> 1), G = wc & 1, f0 = 16 * G + 4 * fq;
        float s1[4] = {0.f, 0.f, 0.f, 0.f}, s2[4] = {0.f, 0.f, 0.f, 0.f};
#pragma unroll
        for (int ai = 0; ai < 2; ++ai)
#pragma unroll
            for (int m = 0; m < 4; ++m) { const size_t r = (size_t)(u.orow + rowl + ai * 128 + m * 16);
                const f32x4 c01 = *(const f32x4*)(rope + r * 32 + f0), c23 = *(const f32x4*)(rope + r * 32 + f0 + 2);
                const f32x4 x1 = acc[ai][bj][m][0], x2 = acc[ai][bj][m][1];
                float o1[4], o2[4];
                o1[0] = x1[0] * c01[0] - x2[0] * c01[1]; o2[0] = x2[0] * c01[0] + x1[0] * c01[1];
                o1[1] = x1[1] * c01[2] - x2[1] * c01[3]; o2[1] = x2[1] * c01[2] + x1[1] * c01[3];
                o1[2] = x1[2] * c23[0] - x2[2] * c23[1]; o2[2] = x2[2] * c23[0] + x1[2] * c23[1];
                o1[3] = x1[3] * c23[2] - x2[3] * c23[3]; o2[3] = x2[3] * c23[2] + x1[3] * c23[3];
                bf16_t* dp = dst + r * ld + 64 * head + f0;
                *(u32x2*)dp = pack4(o1[0] * sc, o1[1] * sc, o1[2] * sc, o1[3] * sc); *(u32x2*)(dp + 32) = pack4(o2[0] * sc, o2[1] * sc, o2[2] * sc, o2[3] * sc);
                if (km) {
#pragma unroll
                    for (int i = 0; i < 4; ++i) { s1[i] += o1[i]; s2[i] += o2[i]; } } }
        if (km) {
#pragma unroll
            for (int i = 0; i < 4; ++i) {
#pragma unroll
                for (int o = 1; o < 16; o <<= 1) { s1[i] += __shfl_xor(s1[i], o); s2[i] += __shfl_xor(s2[i], o); } }
            if (fr == 0) { const int t = u.orow >> 8, b = t >> 4, j = t & 15; float* kp = (float*)(ws + WS_KMEAN) + ((((size_t)b * 8 + head) * 16 + j) * 2 + wr) * 64 + f0;
                *(f32x4*)kp = (f32x4){s1[0], s1[1], s1[2], s1[3]}; *(f32x4*)(kp + 32) = (f32x4){s2[0], s2[1], s2[2], s2[3]}; }
        }
    }
    __device__ __forceinline__ void plain_half(const f32x4 (&acc)[2][2][4][2], int bj, const pg8::Unit& u, int rowl, int wc, int fq, bf16_t* dst, int ld) const {
#pragma unroll
        for (int ai = 0; ai < 2; ++ai)
#pragma unroll
            for (int m = 0; m < 4; ++m) { const size_t r = (size_t)(u.orow + rowl + ai * 128 + m * 16); *(u32x4*)(dst + r * ld + 32 * wc + 8 * fq) = pack8(acc[ai][bj][m][0], acc[ai][bj][m][1]); }
    }
    __device__ __forceinline__ void lat_half(const f32x4 (&acc)[2][2][4][2], int bj, const pg8::Unit& u, int rowl, int wc, int fq, bf16_t* dst, int col0, const float* g, float* ssq, int nparts, int part) const {
        const int c = col0 + 32 * wc + 8 * fq; const f32x4 g0 = *(const f32x4*)(g + c), g1 = *(const f32x4*)(g + c + 4);
#pragma unroll
        for (int ai = 0; ai < 2; ++ai)
#pragma unroll
            for (int m = 0; m < 4; ++m) { const size_t r = (size_t)(u.orow + rowl + ai * 128 + m * 16); const f32x4 x0 = acc[ai][bj][m][0], x1 = acc[ai][bj][m][1];
                float ss = (x0[0] * x0[0] + x0[1] * x0[1]) + (x0[2] * x0[2] + x0[3] * x0[3]) + (x1[0] * x1[0] + x1[1] * x1[1]) + (x1[2] * x1[2] + x1[3] * x1[3]);
                ss += __shfl_xor(ss, 16); ss += __shfl_xor(ss, 32);
                *(u32x4*)(dst + r * 256 + c) = pack8(x0 * g0, x1 * g1);
                if (fq == 0) ssq[r * nparts + part] = ss; }
    }
    __device__ __forceinline__ void operator()(const f32x4 (&acc)[2][2][4][2], const pg8::Unit& u, int wr, int wc, int fr, int fq) const {
        const int rowl = wr * 64 + fr;
#pragma unroll
        for (int bj = 0; bj < 2; ++bj) {
            const int hk = (u.ocol >> 7) + bj;
            if (even) {
                if (hk < 4) rope_half(acc, bj, u, rowl, wr, wc, fr, fq, (bf16_t*)(ws + A_Q1), 512, 2 * hk, QS_64, false);
                else if (hk < 8) rope_half(acc, bj, u, rowl, wr, wc, fr, fq, (bf16_t*)(ws + A_K1), 512, 2 * (hk - 4), 1.0f, true);
                else if (hk < 12) plain_half(acc, bj, u, rowl, wc, fq, (bf16_t*)(ws + A_V1) + 128 * (hk - 8), 512);
                else if (hk < 14) lat_half(acc, bj, u, rowl, wc, fq, (bf16_t*)(ws + A_X1), 128 * (hk - 12), g_qa, (float*)(ws + A_SSQ), 8, 4 * (hk - 12) + wc);
                else if (hk == 14) lat_half(acc, bj, u, rowl, wc, fq, (bf16_t*)(ws + A_X1 + 16 * MiB), 0, g_kva, (float*)(ws + A_SSQ + 1 * MiB), 4, wc);
                else {
                    bf16_t* kvlat = (bf16_t*)(ws + A_X1 + 16 * MiB); bf16_t* Kb = (bf16_t*)(ws + A_Q2 + 48 * MiB); const f32x2* rope = (const f32x2*)(ws + WS_ROPE);
                    unsigned z0 = 0u; asm volatile("" : "+v"(z0));
#pragma unroll
                    for (int ai = 0; ai < 2; ++ai)
#pragma unroll
                        for (int m = 0; m < 4; ++m) { const size_t r = (size_t)(u.orow + rowl + ai * 128 + m * 16);
                            *(u32x4*)(kvlat + r * 256 + 128 + 32 * wc + 8 * fq) = (u32x4){z0, z0, z0, z0};
                            if (wc == 0) { const f32x4 x1 = acc[ai][bj][m][0], x2 = acc[ai][bj][m][1]; const f32x2* rt = rope + r * 32 + 8 * fq;
                                const f32x2 c0 = rt[0], c1 = rt[2], c2 = rt[4], c3 = rt[6];
                                const u32x2 w1 = pack4(x1[0] * c0.x - x2[0] * c0.y, x1[1] * c1.x - x2[1] * c1.y, x1[2] * c2.x - x2[2] * c2.y, x1[3] * c3.x - x2[3] * c3.y);
                                const u32x2 w2 = pack4(x2[0] * c0.x + x1[0] * c0.y, x2[1] * c1.x + x1[1] * c1.y, x2[2] * c2.x + x1[2] * c2.y, x2[3] * c3.x + x1[3] * c3.y);
#pragma unroll
                                for (int hh = 0; hh < 8; ++hh) { bf16_t* kp = Kb + r * 768 + 96 * hh + 64 + 4 * fq; *(u32x2*)kp = w1; *(u32x2*)(kp + 16) = w2; } } }
                }
            } else {
                if (hk < 4) rope_half(acc, bj, u, rowl, wr, wc, fr, fq, (bf16_t*)(ws + A_Q1), 512, 2 * hk, QS_64, false);
                else if (hk == 4) rope_half(acc, bj, u, rowl, wr, wc, fr, fq, (bf16_t*)(ws + A_K1), 128, 0, 1.0f, false);
                else if (hk == 5) plain_half(acc, bj, u, rowl, wc, fq, (bf16_t*)(ws + A_K1 + 8 * MiB), 128);
                else if (hk < 10) rope_half(acc, bj, u, rowl, wr, wc, fr, fq, (bf16_t*)(ws + A_V1), 512, 2 * (hk - 6), QS_64, false);
                else if (hk < 14) rope_half(acc, bj, u, rowl, wr, wc, fr, fq, (bf16_t*)(ws + A_X1), 512, 2 * (hk - 10), 1.0f, false);
                else plain_half(acc, bj, u, rowl, wc, fq, (bf16_t*)(ws + A_X2) + 128 * (hk - 14), 512);
            }
        }
    }
};
struct EpiMlaQ {
    static constexpr bool PERM = true;
    unsigned char* ws;
    __device__ __forceinline__ void operator()(const f32x4 (&acc)[2][2][4][2], const pg8::Unit& u, int wr, int wc, int fr, int fq) const {
        const int rowl = wr * 64 + fr; bf16_t* Qb = (bf16_t*)(ws + A_Q2); const float* ssq = (const float*)(ws + A_SSQ); const f32x2* rope = (const f32x2*)(ws + WS_ROPE);
#pragma unroll
        for (int ai = 0; ai < 2; ++ai)
#pragma unroll
            for (int m = 0; m < 4; ++m) { const size_t r = (size_t)(u.orow + rowl + ai * 128 + m * 16);
                const f32x4 q0 = *(const f32x4*)(ssq + r * 8), q1 = *(const f32x4*)(ssq + r * 8 + 4);
                const float rr = QS_96 / sqrtf(((q0[0] + q0[1]) + (q0[2] + q0[3]) + (q1[0] + q1[1]) + (q1[2] + q1[3])) * (1.0f / 256.0f) + 1e-6f);
#pragma unroll
                for (int bj = 0; bj < 2; ++bj) { const int gidx = (u.ocol >> 5) + 4 * bj + wc, head = gidx / 3, part = gidx - 3 * head;
                    const f32x4 x1 = acc[ai][bj][m][0] * rr, x2 = acc[ai][bj][m][1] * rr;
                    if (part < 2) *(u32x4*)(Qb + r * 768 + 96 * head + 32 * part + 8 * fq) = pack8(x1, x2);
                    else { const f32x2* rt = rope + r * 32 + 8 * fq; const f32x2 c0 = rt[0], c1 = rt[2], c2 = rt[4], c3 = rt[6]; bf16_t* qp = Qb + r * 768 + 96 * head + 64 + 4 * fq;
                        *(u32x2*)qp = pack4(x1[0] * c0.x - x2[0] * c0.y, x1[1] * c1.x - x2[1] * c1.y, x1[2] * c2.x - x2[2] * c2.y, x1[3] * c3.x - x2[3] * c3.y);
                        *(u32x2*)(qp + 16) = pack4(x2[0] * c0.x + x1[0] * c0.y, x2[1] * c1.x + x1[1] * c1.y, x2[2] * c2.x + x1[2] * c2.y, x2[3] * c3.x + x1[3] * c3.y); } } }
    }
};
struct EpiMlaKV {
    static constexpr bool PERM = true;
    unsigned char* ws;
    __device__ __forceinline__ void operator()(const f32x4 (&acc)[2][2][4][2], const pg8::Unit& u, int wr, int wc, int fr, int fq) const {
        const int rowl = wr * 64 + fr; bf16_t* Kb = (bf16_t*)(ws + A_Q2 + 48 * MiB); bf16_t* Vb = (bf16_t*)(ws + A_Q2 + 96 * MiB); const float* ssq = (const float*)(ws + A_SSQ + 1 * MiB);
#pragma unroll
        for (int ai = 0; ai < 2; ++ai)
#pragma unroll
            for (int m = 0; m < 4; ++m) { const size_t r = (size_t)(u.orow + rowl + ai * 128 + m * 16);
                const f32x4 q0 = *(const f32x4*)(ssq + r * 4);
                const float rr = 1.0f / sqrtf(((q0[0] + q0[1]) + (q0[2] + q0[3])) * (1.0f / 128.0f) + 1e-6f);
#pragma unroll
                for (int bj = 0; bj < 2; ++bj) { const int gidx = (u.ocol >> 5) + 4 * bj + wc, head = gidx >> 2, part = gidx & 3;
                    const u32x4 w = pack8(acc[ai][bj][m][0] * rr, acc[ai][bj][m][1] * rr);
                    if (part < 2) *(u32x4*)(Kb + r * 768 + 96 * head + 32 * part + 8 * fq) = w; else *(u32x4*)(Vb + r * 512 + 64 * head + 32 * (part - 2) + 8 * fq) = w; } }
    }
};

constexpr float YS_SCALE = 64.0f;
__device__ __forceinline__ unsigned pk_fp8x4(float a, float b, float c, float d) {
    a = fminf(fmaxf(a, -440.f), 440.f); b = fminf(fmaxf(b, -440.f), 440.f); c = fminf(fmaxf(c, -440.f), 440.f); d = fminf(fmaxf(d, -440.f), 440.f);
    int w = __builtin_amdgcn_cvt_pk_fp8_f32(a, b, 0, false); w = __builtin_amdgcn_cvt_pk_fp8_f32(c, d, w, true); return (unsigned)w; }
struct EpiDownAll {
    static constexpr bool PERM = true;
    unsigned char* ws;
    __device__ __forceinline__ void operator()(const f32x4 (&acc)[2][2][4][2], const pg8::Unit& u, int wr, int wc, int fr, int fq) const {
        const int rowl = wr * 64 + fr, c0 = u.ocol + 32 * wc + 8 * fq;
        if (u.e == 64) { float* xf = (float*)(ws + WS_XF);
#pragma unroll
            for (int ai = 0; ai < 2; ++ai)
#pragma unroll
                for (int m = 0; m < 4; ++m) { float* rp = xf + (size_t)(u.lt * 256 + rowl + ai * 128 + m * 16) * DM + c0;
#pragma unroll
                    for (int bj = 0; bj < 2; ++bj) { const f32x4 s0 = *(const f32x4*)(rp + bj * 128), s1 = *(const f32x4*)(rp + bj * 128 + 4);
                        *(f32x4*)(rp + bj * 128) = s0 * DN_ALPHA + acc[ai][bj][m][0]; *(f32x4*)(rp + bj * 128 + 4) = s1 * DN_ALPHA + acc[ai][bj][m][1]; } }
        } else { unsigned char* Y8 = ws + WS_YS;
#pragma unroll
            for (int ai = 0; ai < 2; ++ai)
#pragma unroll
                for (int m = 0; m < 4; ++m) { unsigned char* rp = Y8 + (size_t)(u.orow + rowl + ai * 128 + m * 16) * DM + c0;
#pragma unroll
                    for (int bj = 0; bj < 2; ++bj) { const f32x4 v0 = acc[ai][bj][m][0] * YS_SCALE, v1 = acc[ai][bj][m][1] * YS_SCALE;
                        u32x2 w; w.x = pk_fp8x4(v0[0], v0[1], v0[2], v0[3]); w.y = pk_fp8x4(v1[0], v1[1], v1[2], v1[3]); *(u32x2*)(rp + bj * 128) = w; } }
        }
    }
};
struct Ctx {
    LAS unsigned char* lds; unsigned char* ws; int tid, lane, wave, G, bid, gw, NGW;
};
#define WSP(T, off) ((T*)(C.ws + (off)))

__device__ __forceinline__ void phase_convert(const Ctx& C, const Args& a, int L) {
    LAS float* scr = (LAS float*)(C.lds + C.wave * 16384);
    {
        constexpr int IT_G = (1024 / 64) * (256 / 32);
        constexpr int IT_D = (256 / 64) * (1024 / 32);
        const int total = 65 * (2 * IT_G + IT_D);
        bf16_t* Wgu = WSP(bf16_t, WS_WGU); bf16_t* Wd = WSP(bf16_t, WS_WD);
        for (int it = C.gw; it < total; it += C.NGW) {
            const int e = it / (2 * IT_G + IT_D); int r = it % (2 * IT_G + IT_D);
            if (r < 2 * IT_G) {
                const int up = r >= IT_G; if (up) r -= IT_G;
                const float* W = e < 64 ? (up ? a.moe_w_up : a.moe_w_gate) + ((size_t)L * 64 + e) * 1024 * 256 : (up ? a.sh_w_up : a.sh_w_gate) + (size_t)L * 1024 * 256;
                const int kb = r / 8, nb = r % 8, n0 = nb * 32;
                transpose_item(W, 256, kb * 64, n0, Wgu + (size_t)e * 512 * 1024, 1024, (n0 >> 7) * 256 + up * 128 + (n0 & 127), scr, C.lane);
            } else {
                r -= 2 * IT_G;
                const float* W = e < 64 ? a.moe_w_down + ((size_t)L * 64 + e) * 256 * 1024 : a.sh_w_down + (size_t)L * 256 * 1024;
                const int kb = r / 32, nb = r % 32, n0 = nb * 32;
                transpose_item(W, 1024, kb * 64, n0, Wd + (size_t)e * 1024 * 256, 256, n0, scr, C.lane);
            }
        }
    }
}
__device__ __forceinline__ void phase_init(const Ctx& C, const Args& a) {
    LAS float* scr = (LAS float*)(C.lds + C.wave * 16384);
    for (int l = 0; l < DEPTH; ++l) {
        const int i = l >> 1; const bool even = !(l & 1);
        bf16_t* Win = WSP(bf16_t, WS_SMALLW + l * SW_LAYER); bf16_t* Wout = WSP(bf16_t, WS_SMALLW + l * SW_LAYER + SW_WOUT);
        const int nin = even ? EV_IN : OD_IN;
        const float* win = even ? a.ev_w_in + (size_t)i * 1024 * EV_IN : a.od_w_in + (size_t)i * 1024 * OD_IN;
        const float* wout = even ? a.ev_w_out + (size_t)i * 1024 * 1024 : a.od_w_out + (size_t)i * 1024 * 1024;
        const int it_in = 16 * (nin / 32), it_out = 16 * 32;
        for (int it = C.gw; it < it_in + it_out; it += C.NGW) {
            if (it < it_in) { const int kb = it / (nin / 32), nb = it % (nin / 32); transpose_item(win, nin, kb * 64, nb * 32, Win, 1024, nb * 32, scr, C.lane, even ? 1 : 2); }
            else { const int r = it - it_in, kb = r / 32, nb = r % 32; transpose_item(wout, 1024, kb * 64, nb * 32, Wout, 1024, nb * 32, scr, C.lane); }
        }
        if (even) {
            for (int idx = C.bid * NTHREADS + C.tid; idx < (2048 - EV_IN) * 1024 / 8; idx += C.G * NTHREADS) *(u32x4*)(Win + (size_t)EV_IN * 1024 + (size_t)idx * 8) = (u32x4){0u, 0u, 0u, 0u};
            bf16_t* Wqb = WSP(bf16_t, WS_SMALLW + l * SW_LAYER + SW_WQB); bf16_t* Wkvb = WSP(bf16_t, WS_SMALLW + l * SW_LAYER + SW_WKVB);
            const float* wqb = a.mla_w_qb + (size_t)i * 256 * 768; const float* wkvb = a.mla_w_kvb + (size_t)i * 128 * 1024;
            const int it_q = 4 * 24, it_kv = 2 * 32;
            for (int it = C.gw; it < it_q + it_kv; it += C.NGW) {
                if (it < it_q) { const int kb = it / 24, nb = it % 24; transpose_item(wqb, 768, kb * 64, nb * 32, Wqb, 256, nb * 32, scr, C.lane, 3); }
                else { const int r = it - it_q, kb = r / 32, nb = r % 32; transpose_item(wkvb, 1024, kb * 64, nb * 32, Wkvb, 256, nb * 32, scr, C.lane); }
            }
            for (int idx = C.bid * NTHREADS + C.tid; idx < 1024 * 16; idx += C.G * NTHREADS) { const int row = idx >> 4, ch = idx & 15; *(u32x4*)(Wkvb + (size_t)row * 256 + 128 + ch * 8) = (u32x4){0u, 0u, 0u, 0u}; }
        }
        bf16_t* Wr = WSP(bf16_t, WS_WR + (size_t)l * MiB); const float* wr = a.moe_w_router + (size_t)l * 1024 * 64;
        for (int idx = C.bid * NTHREADS + C.tid; idx < 256 * 2048; idx += C.G * NTHREADS) {
            const int n = idx >> 11, k = idx & 2047; unsigned v = 0;
            if (n < 128) { const int e = n & 63, kk = k & 1023; const float w = wr[(size_t)kk * 64 + e]; const unsigned wh = f2bf(w);
                if (n < 64) v = wh; else if (k < 1024) v = f2bf(w - bf2f(wh)); }
            Wr[idx] = (bf16_t)v;
        }
    }
    { f32x2* rope = WSP(f32x2, WS_ROPE);
      for (int idx = C.bid * NTHREADS + C.tid; idx < NTOK * 32; idx += C.G * NTHREADS) { const int tok = idx >> 5, j = idx & 31;
          const float inv = (float)exp2(-(double)j * (13.287712379549449 / 32.0));
          const float ang = (float)a.pos[tok] * inv; float cs, sn; sincos_acc(ang, cs, sn); rope[idx] = (f32x2){cs, sn}; } }
    { bf16_t* xb = WSP(bf16_t, WS_HS);
      for (size_t idx = (size_t)C.bid * NTHREADS + C.tid; idx < (size_t)NTOK * DM / 8; idx += (size_t)C.G * NTHREADS) { const f32x4 v0 = *(const f32x4*)(a.x + idx * 8), v1 = *(const f32x4*)(a.x + idx * 8 + 4);
          u32x4 o; o.x = pk2(v0[0], v0[1]); o.y = pk2(v0[2], v0[3]); o.z = pk2(v1[0], v1[1]); o.w = pk2(v1[2], v1[3]); *(u32x4*)(xb + idx * 8) = o; } }
}

template <int HW>
__device__ __forceinline__ void rope_heads(const bf16_t* src, bf16_t* dst, int nh, const f32x2* rope_tok, float scale, int lane) {
    const int npairs = nh * HW;
    for (int p = lane; p < npairs; p += 64) { const int hh = p / HW, i = p % HW;
        const float x1 = bf2f(src[hh * 2 * HW + i]), x2 = bf2f(src[hh * 2 * HW + i + HW]); const f32x2 cs = rope_tok[i * (32 / HW)];
        dst[hh * 2 * HW + i] = (bf16_t)f2bf((x1 * cs.x - x2 * cs.y) * scale); dst[hh * 2 * HW + i + HW] = (bf16_t)f2bf((x2 * cs.x + x1 * cs.y) * scale); }
}
__device__ __forceinline__ void copy_cols(const bf16_t* src, bf16_t* dst, int n, int lane) { for (int c = lane; c < n / 8; c += 64) *(u32x4*)(dst + c * 8) = *(const u32x4*)(src + c * 8); }

__device__ __forceinline__ void phase_prep_even(const Ctx& C, const Args& a, int i) {
    const bf16_t* hb = WSP(bf16_t, A_HB); const f32x2* rope = WSP(f32x2, WS_ROPE);
    bf16_t *Qa = WSP(bf16_t, A_Q1), *Ka = WSP(bf16_t, A_K1), *Va = WSP(bf16_t, A_V1), *qlat = WSP(bf16_t, A_X1), *kvlat = WSP(bf16_t, A_X1 + 16 * MiB), *kpe = WSP(bf16_t, A_X2);
    const float* gqa = a.mla_g_qa + i * 256; const float* gkva = a.mla_g_kva + i * 128;
    const float sc = 0.125f * LOG2E;
    for (int tok = C.gw; tok < NTOK; tok += C.NGW) {
        const bf16_t* h = hb + (size_t)tok * HB_LD; const f32x2* rt = rope + (size_t)tok * 32;
        rope_heads<32>(h, Qa + (size_t)tok * 512, 8, rt, sc, C.lane);
        rope_heads<32>(h + 512, Ka + (size_t)tok * 512, 8, rt, 1.0f, C.lane);
        copy_cols(h + 1024, Va + (size_t)tok * 512, 512, C.lane);
        { float v[4]; float ss = 0.f;
#pragma unroll
          for (int j = 0; j < 4; ++j) { v[j] = bf2f(h[1536 + C.lane + 64 * j]); ss += v[j] * v[j]; }
          const float r = 1.0f / sqrtf(wave_sum(ss) * (1.0f / 256.0f) + 1e-6f);
#pragma unroll
          for (int j = 0; j < 4; ++j) qlat[(size_t)tok * 256 + C.lane + 64 * j] = (bf16_t)f2bf(v[j] * r * gqa[C.lane + 64 * j]); }
        { float v[2]; float ss = 0.f;
#pragma unroll
          for (int j = 0; j < 2; ++j) { v[j] = bf2f(h[1792 + C.lane + 64 * j]); ss += v[j] * v[j]; }
          const float r = 1.0f / sqrtf(wave_sum(ss) * (1.0f / 128.0f) + 1e-6f);
#pragma unroll
          for (int j = 0; j < 2; ++j) { kvlat[(size_t)tok * 256 + C.lane + 64 * j] = (bf16_t)f2bf(v[j] * r * gkva[C.lane + 64 * j]); kvlat[(size_t)tok * 256 + 128 + C.lane + 64 * j] = 0; } }
        rope_heads<16>(h + 1920, kpe + (size_t)tok * 32, 1, rt, 1.0f, C.lane);
    }
}
__device__ __forceinline__ void phase_kmean(const Ctx& C) {
    const bf16_t* Ka = WSP(bf16_t, A_K1); float* km = WSP(float, WS_KMEAN);
    for (int idx = C.bid * NTHREADS + C.tid; idx < NBATCH * 16 * 512; idx += C.G * NTHREADS) {
        const int c = idx & 511, bj = idx >> 9, b = bj >> 4, j = bj & 15; const bf16_t* p = Ka + ((size_t)b * SEQ + j * 256) * 512 + c;
        float s = 0.f;
        for (int r = 0; r < 256; ++r) s += bf2f(p[(size_t)r * 512]);
        km[(((size_t)b * 8 + (c >> 6)) * 16 + j) * 64 + (c & 63)] = s * (1.0f / 256.0f);
    }
}
__device__ __forceinline__ void phase_prep_mla(const Ctx& C) {
    const bf16_t *qf = WSP(bf16_t, A_QF), *kvf = WSP(bf16_t, A_KVF), *kpe = WSP(bf16_t, A_X2); const f32x2* rope = WSP(f32x2, WS_ROPE);
    bf16_t *Qb = WSP(bf16_t, A_Q2), *Kb = WSP(bf16_t, A_Q2 + 48 * MiB), *Vb = WSP(bf16_t, A_Q2 + 96 * MiB);
    const float sc = 0.10206207261596577f * LOG2E;
    for (int tok = C.gw; tok < NTOK; tok += C.NGW) {
        const bf16_t* q = qf + (size_t)tok * 768; const bf16_t* kv = kvf + (size_t)tok * 1024; const f32x2* rt = rope + (size_t)tok * 32;
        bf16_t* qo = Qb + (size_t)tok * 768; bf16_t* ko = Kb + (size_t)tok * 768; bf16_t* vo = Vb + (size_t)tok * 512;
        for (int p = C.lane; p < 512; p += 64) { const int hh = p >> 6, d = p & 63; qo[hh * 96 + d] = (bf16_t)f2bf(bf2f(q[hh * 96 + d]) * sc); ko[hh * 96 + d] = kv[hh * 128 + d]; vo[hh * 64 + d] = kv[hh * 128 + 64 + d]; }
        for (int p = C.lane; p < 128; p += 64) { const int hh = p >> 4, i2 = p & 15;
            const float x1 = bf2f(q[hh * 96 + 64 + i2]), x2 = bf2f(q[hh * 96 + 80 + i2]); const f32x2 cs = rt[2 * i2];
            qo[hh * 96 + 64 + i2] = (bf16_t)f2bf((x1 * cs.x - x2 * cs.y) * sc); qo[hh * 96 + 80 + i2] = (bf16_t)f2bf((x2 * cs.x + x1 * cs.y) * sc); }
        for (int p = C.lane; p < 256; p += 64) { const int hh = p >> 5, d = p & 31; ko[hh * 96 + 64 + d] = kpe[(size_t)tok * 32 + d]; }
    }
}
__device__ __forceinline__ void phase_prep_odd(const Ctx& C) {
    const bf16_t* hb = WSP(bf16_t, A_HB); const f32x2* rope = WSP(f32x2, WS_ROPE);
    bf16_t *Qc = WSP(bf16_t, A_Q1), *Kc = WSP(bf16_t, A_K1), *Vc = WSP(bf16_t, A_K1 + 8 * MiB), *Qd = WSP(bf16_t, A_V1), *Kd = WSP(bf16_t, A_X1), *Vd = WSP(bf16_t, A_X2);
    const float sc = 0.125f * LOG2E;
    for (int tok = C.gw; tok < NTOK; tok += C.NGW) {
        const bf16_t* h = hb + (size_t)tok * HB_LD; const f32x2* rt = rope + (size_t)tok * 32;
        rope_heads<32>(h, Qc + (size_t)tok * 512, 8, rt, sc, C.lane);
        rope_heads<32>(h + 512, Kc + (size_t)tok * 128, 2, rt, 1.0f, C.lane);
        copy_cols(h + 640, Vc + (size_t)tok * 128, 128, C.lane);
        rope_heads<32>(h + 768, Qd + (size_t)tok * 512, 8, rt, sc, C.lane);
        rope_heads<32>(h + 1280, Kd + (size_t)tok * 512, 8, rt, 1.0f, C.lane);
        copy_cols(h + 1792, Vd + (size_t)tok * 512, 512, C.lane);
    }
}
__device__ __forceinline__ void phase_attn_even(const Ctx& C) {
    const bf16_t *Qa = WSP(bf16_t, A_Q1), *Ka = WSP(bf16_t, A_K1), *Va = WSP(bf16_t, A_V1), *Qb = WSP(bf16_t, A_Q2), *Kb = WSP(bf16_t, A_Q2 + 48 * MiB), *Vb = WSP(bf16_t, A_Q2 + 96 * MiB);
    bf16_t* ob = WSP(bf16_t, A_OB); const float* km = WSP(float, WS_KMEAN);
    for (int P = C.bid; P < 512; P += C.G) { const int bh = P >> 3, pi = P & 7, b = bh >> 3, h = bh & 7;
#pragma unroll 1
        for (int s = 0; s < 2; ++s) { const int qb = s ? pi : 15 - pi;
            att::Tens T{Qb + 96 * h, Kb + 96 * h, Vb + 64 * h, ob + 512 + 64 * h, 768, 768, 512, 1024};
            att::unit<96, 64, att::MODE_CAUSAL, false>(T, b, qb, nullptr, 0.f, C.lds, C.tid); } }
    int tid2 = C.tid; asm volatile("" : "+v"(tid2));
    for (int P = C.bid; P < 512; P += C.G) { const int bh = P >> 3, pi = P & 7, b = bh >> 3, h = bh & 7;
#pragma unroll 1
        for (int s = 0; s < 2; ++s) { const int qb = s ? pi : 15 - pi;
            att::Tens T{Qa + 64 * h, Ka + 64 * h, Va + 64 * h, ob + 64 * h, 512, 512, 512, 1024};
            att::unit<64, 64, att::MODE_MOBA, false>(T, b, qb, km + ((size_t)b * 8 + h) * 2048, 0.f, C.lds, tid2); } }
}
__device__ __forceinline__ void phase_attn_odd(const Ctx& C, const Args& a, int i) {
    const bf16_t *Qc = WSP(bf16_t, A_Q1), *Kc = WSP(bf16_t, A_K1), *Vc = WSP(bf16_t, A_K1 + 8 * MiB), *Qd = WSP(bf16_t, A_V1), *Kd = WSP(bf16_t, A_X1), *Vd = WSP(bf16_t, A_X2);
    bf16_t* ob = WSP(bf16_t, A_OB); float* Od = WSP(float, A_Q2);
    for (int P = C.bid; P < 512; P += C.G) { const int bh = P >> 3, pi = P & 7, b = bh >> 3, st = bh & 7;
#pragma unroll 1
        for (int s = 0; s < 2; ++s) { const int qb = s ? pi : 15 - pi;
            att::Tens T{Qd + 64 * st, Kd + 64 * st, Vd + 128 * (st >> 1), Od + 128 * st, 512, 512, 512, 1024};
            att::unit<64, 128, att::MODE_CAUSAL, true>(T, b, qb, nullptr, 0.f, C.lds, C.tid); } }
    int tid2 = C.tid; asm volatile("" : "+v"(tid2));
    for (int P = C.bid; P < 512; P += C.G) { const int bh = P >> 3, pi = P & 7, b = bh >> 3, h = bh & 7;
        const float sink = a.swa_sinks[i * 8 + h] * LOG2E;
#pragma unroll 1
        for (int s = 0; s < 2; ++s) { const int qb = s ? pi : 15 - pi;
            att::Tens T{Qc + 64 * h, Kc + 64 * (h >> 2), Vc + 64 * (h >> 2), ob + 64 * h, 512, 128, 128, 1024};
            att::unit<64, 64, att::MODE_SWA, false>(T, b, qb, nullptr, sink, C.lds, tid2); } }
}
__device__ __forceinline__ void phase_diff_combine(const Ctx& C, const Args& a, int i, int l) {
    const float* Od = WSP(float, A_Q2); bf16_t* ob = WSP(bf16_t, A_OB);
    const float* lp = a.diff_lambda + i * 256;
    const float d01 = wave_sum(lp[C.lane] * lp[64 + C.lane]), d23 = wave_sum(lp[128 + C.lane] * lp[192 + C.lane]);
    const float lam_init = 0.8f - 0.6f * expf(-0.3f * (float)l);
    const float lam = expf(d01) - expf(d23) + lam_init;
    const float g0 = a.diff_g_subln[i * 128 + C.lane] * (1.0f - lam_init), g1 = a.diff_g_subln[i * 128 + 64 + C.lane] * (1.0f - lam_init);
    for (int tok = C.gw; tok < NTOK; tok += C.NGW) {
#pragma unroll
        for (int h = 0; h < 4; ++h) { const float* o1 = Od + (size_t)tok * 1024 + 256 * h; const float* o2 = o1 + 128;
            const float v0 = o1[C.lane] - lam * o2[C.lane], v1 = o1[64 + C.lane] - lam * o2[64 + C.lane];
            const float r = 1.0f / sqrtf(wave_sum(v0 * v0 + v1 * v1) * (1.0f / 128.0f) + 1e-5f);
            bf16_t* o = ob + (size_t)tok * 1024 + 512 + 128 * h; o[C.lane] = (bf16_t)f2bf(v0 * r * g0); o[64 + C.lane] = (bf16_t)f2bf(v1 * r * g1); }
    }
}
__device__ __forceinline__ void ln_row(f32x4 (&v)[4], const float* g, const float* bb, int lane) {
    float s = 0.f;
#pragma unroll
    for (int j = 0; j < 4; ++j) s += (v[j][0] + v[j][1]) + (v[j][2] + v[j][3]);
    const float mean = wave_sum(s) * (1.0f / DM); float s2 = 0.f;
#pragma unroll
    for (int j = 0; j < 4; ++j) { v[j] = v[j] - mean; s2 += (v[j][0] * v[j][0] + v[j][1] * v[j][1]) + (v[j][2] * v[j][2] + v[j][3] * v[j][3]); }
    const float rstd = 1.0f / sqrtf(wave_sum(s2) * (1.0f / DM) + 1e-5f);
#pragma unroll
    for (int j = 0; j < 4; ++j) { const f32x4 gg = *(const f32x4*)(g + 4 * lane + 256 * j), b4 = *(const f32x4*)(bb + 4 * lane + 256 * j); v[j] = v[j] * rstd * gg + b4; }
}
__device__ __forceinline__ void phase_ln1(const Ctx& C, const Args& a, int l) {
    float* xf = WSP(float, WS_XF); bf16_t* xs = WSP(bf16_t, A_XS);
    const float* g = a.ln_g + (size_t)(l * 2) * DM; const float* bb = a.ln_b + (size_t)(l * 2) * DM;
    for (int tok = C.gw; tok < NTOK; tok += C.NGW) {
        f32x4 v[4]; float* xr = xf + (size_t)tok * DM + 4 * C.lane;
#pragma unroll
        for (int j = 0; j < 4; ++j) v[j] = *(const f32x4*)(xr + 256 * j);
        ln_row(v, g, bb, C.lane);
        bf16_t* xo = xs + (size_t)tok * 2048 + 4 * C.lane;
#pragma unroll
        for (int j = 0; j < 4; ++j) { *(f32x4*)(xr + 256 * j) = v[j];
            const unsigned h0 = f2bf(v[j][0]), h1 = f2bf(v[j][1]), h2 = f2bf(v[j][2]), h3 = f2bf(v[j][3]);
            u32x2 hi2 = {h0 | (h1 << 16), h2 | (h3 << 16)}; *(u32x2*)(xo + 256 * j) = hi2;
            u32x2 lo2 = {pk2(v[j][0] - bf2f(h0), v[j][1] - bf2f(h1)), pk2(v[j][2] - bf2f(h2), v[j][3] - bf2f(h3))}; *(u32x2*)(xo + 1024 + 256 * j) = lo2; }
    }
}
__device__ __forceinline__ void phase_route(const Ctx& C, const Args& a, int l) {
    const float* lg = WSP(float, A_LOG);
    int* rowtok = WSP(int, WS_ROWTOK); float* tokw = WSP(float, WS_WSLOT); int* toke = WSP(int, WS_TOKE); int* tokp = WSP(int, WS_TOKP);
    unsigned* cnt = WSP(unsigned, WS_CTL) + CW_CNT + 64 * l;
    LAS int* cntw = (LAS int*)C.lds; LAS int* base = cntw + 64; LAS int* ent_e = base + 64; LAS int* ent_r = ent_e + 2048; LAS float* ent_w = (LAS float*)(ent_r + 2048);
    const int tpb = NTOK / C.G, tok0 = C.bid * tpb;
    if (C.tid < 64) cntw[C.tid] = 0;
    __syncthreads();
    const float bias = a.moe_bias[l * 64 + C.lane];
    const int g = C.lane >> 3;
    for (int tl = C.wave; tl < tpb; tl += NWAVES) {
        const int tok = tok0 + tl;
        const float z = lg[(size_t)tok * 256 + C.lane] + lg[(size_t)tok * 256 + 64 + C.lane];
        const float s = 1.0f / (1.0f + expf(-z));
        const float c = s + bias;
        float m1 = c; m1 = fmaxf(m1, __shfl_xor(m1, 1)); m1 = fmaxf(m1, __shfl_xor(m1, 2)); m1 = fmaxf(m1, __shfl_xor(m1, 4));
        const unsigned long long eq = __ballot(c == m1);
        const unsigned geq = (unsigned)(eq >> (8 * g)) & 0xffu;
        const bool is_first = (C.lane & 7) == (int)__builtin_ctz(geq);
        float m2 = is_first ? -INFINITY : c; m2 = fmaxf(m2, __shfl_xor(m2, 1)); m2 = fmaxf(m2, __shfl_xor(m2, 2)); m2 = fmaxf(m2, __shfl_xor(m2, 4));
        const float gs = m1 + m2;
        int grank = 0;
#pragma unroll
        for (int j = 0; j < 8; ++j) { const float gj = __builtin_bit_cast(float, __builtin_amdgcn_readlane(__builtin_bit_cast(int, gs), 8 * j)); grank += (gj > gs || (gj == gs && j < g)) ? 1 : 0; }
        const float v = grank < 4 ? c : -INFINITY;
        int rank = 0;
#pragma unroll
        for (int j = 0; j < 64; ++j) { const float vj = __builtin_bit_cast(float, __builtin_amdgcn_readlane(__builtin_bit_cast(int, v), j)); rank += (vj > v || (vj == v && j < C.lane)) ? 1 : 0; }
        const bool sel = rank < 8;
        const float ssum = wave_sum(sel ? s : 0.f);
        if (sel) { const int r = __hip_atomic_fetch_add(&cntw[C.lane], 1, __ATOMIC_RELAXED, __HIP_MEMORY_SCOPE_WORKGROUP);
            ent_e[tl * 8 + rank] = C.lane; ent_r[tl * 8 + rank] = r; ent_w[tl * 8 + rank] = s / ssum * 2.5f; }
    }
    __syncthreads();
    if (C.tid < 64) base[C.tid] = (int)atomicAdd(&cnt[C.tid], (unsigned)cntw[C.tid]);
    __syncthreads();
    for (int idx = C.tid; idx < tpb * 8; idx += NTHREADS) { const int e = ent_e[idx], pos = base[e] + ent_r[idx], tok = tok0 + (idx >> 3);
        if (pos < CAP) rowtok[(size_t)e * CAP + pos] = tok;
        toke[(size_t)tok0 * 8 + idx] = e; tokp[(size_t)tok0 * 8 + idx] = pos; tokw[(size_t)tok0 * 8 + idx] = ent_w[idx]; }
    __syncthreads();
}
__device__ __forceinline__ void moe_tables(const Ctx& C, int l) {
    const unsigned* cnt = WSP(unsigned, WS_CTL) + CW_CNT + 64 * l;
    LAS int* lcnt = (LAS int*)(C.lds + LX_CNT); LAS int* tst = (LAS int*)(C.lds + LX_TST); LAS unsigned char* texp = (LAS unsigned char*)(C.lds + LX_TEXP);
    __syncthreads();
    if (C.tid < 64) { int c = (int)__hip_atomic_load(cnt + C.tid, __ATOMIC_RELAXED, __HIP_MEMORY_SCOPE_AGENT); if (c > CAP) c = CAP; lcnt[C.tid] = c; }
    __syncthreads();
    if (C.tid == 0) { int acc = 0; for (int e = 0; e < 64; ++e) { tst[e] = acc; acc += (lcnt[e] + 255) >> 8; } tst[64] = acc; }
    __syncthreads();
    if (C.tid < 64) { const int t0 = tst[C.tid], t1 = tst[C.tid + 1]; for (int t = t0; t < t1; ++t) texp[t] = (unsigned char)C.tid; }
    __syncthreads();
}
template <bool GATHER_> struct MoeOrder {
    static constexpr bool GATHER = GATHER_;
    const LAS int* lcnt; const LAS int* tst; const LAS unsigned char* texp; const int* rowtok;
    int TR, nsh, NC, G, c; int sh_orow0;
    __device__ __forceinline__ bool next(int i, pg8::Unit& u) const {
        const long L = (long)i * G + c; if (L >= (long)(TR + nsh) * NC) return false;
        const int r = (int)(L / NC), cn = (int)(L % NC);
        if (r < TR) { const int e = __builtin_amdgcn_readfirstlane((int)texp[r]); u.e = e; u.lt = r - __builtin_amdgcn_readfirstlane(tst[e]); u.pm = r; u.orow = r * 256; }
        else { u.e = 64; u.lt = r - TR; u.pm = TR_MAX + (r - TR); u.orow = sh_orow0 + u.lt * 256; }
        u.pn = u.e * NC + cn; u.ocol = cn * (NC == 2 ? 128 : 256);
        return true;
    }
    __device__ __forceinline__ unsigned arow(const pg8::Unit& u, int r) const {
        if (!GATHER) return (unsigned)(u.pm * 256 + r);
        const int loc = u.lt * 256 + r;
        if (u.e == 64) return (unsigned)loc;
        return loc < __builtin_amdgcn_readfirstlane(lcnt[u.e]) ? (unsigned)rowtok[(size_t)u.e * CAP + loc] : 0u;
    }
};
__device__ __forceinline__ void phase_combine_ln2(const Ctx& C, const Args& a, int l) {
    float* xf = WSP(float, WS_XF); bf16_t* xb = WSP(bf16_t, WS_HS); const unsigned char* Ys = WSP(unsigned char, WS_YS);
    const int* toke = WSP(int, WS_TOKE); const int* tokp = WSP(int, WS_TOKP); const float* tokw = WSP(float, WS_WSLOT);
    const LAS int* tst = (const LAS int*)(C.lds + LX_TST);
    const float* g = a.ln_g + (size_t)(l * 2 + 1) * DM; const float* bb = a.ln_b + (size_t)(l * 2 + 1) * DM;
    for (int tok = C.gw; tok < NTOK; tok += C.NGW) {
        f32x4 v[4]; float* xr = xf + (size_t)tok * DM + 4 * C.lane;
#pragma unroll
        for (int j = 0; j < 4; ++j) v[j] = *(const f32x4*)(xr + 256 * j);
#pragma unroll
        for (int k = 0; k < 8; ++k) { const int e = toke[(size_t)tok * 8 + k], pos = tokp[(size_t)tok * 8 + k]; const float gw = tokw[(size_t)tok * 8 + k] * (1.0f / YS_SCALE); const size_t slot = (size_t)tst[e] * 256 + pos;
            const unsigned char* yr = Ys + slot * DM + 4 * C.lane;
#pragma unroll
            for (int j = 0; j < 4; ++j) { const int w = *(const int*)(yr + 256 * j);
                v[j][0] += gw * __builtin_amdgcn_cvt_f32_fp8(w, 0); v[j][1] += gw * __builtin_amdgcn_cvt_f32_fp8(w, 1); v[j][2] += gw * __builtin_amdgcn_cvt_f32_fp8(w, 2); v[j][3] += gw * __builtin_amdgcn_cvt_f32_fp8(w, 3); } }
        ln_row(v, g, bb, C.lane);
        bf16_t* xo = xb + (size_t)tok * DM + 4 * C.lane;
#pragma unroll
        for (int j = 0; j < 4; ++j) { *(f32x4*)(xr + 256 * j) = v[j]; u32x2 w = {pk2(v[j][0], v[j][1]), pk2(v[j][2], v[j][3])}; *(u32x2*)(xo + 256 * j) = w;
            if (l == DEPTH - 1) *(f32x4*)(a.out + (size_t)tok * DM + 4 * C.lane + 256 * j) = v[j]; }
    }
}
constexpr int STEPS_PER_LAYER = 15, NSTEPS = 1 + STEPS_PER_LAYER * DEPTH;
#define CAS __attribute__((address_space(4)))
template <int STEP> __device__ __forceinline__ void step_fn(const CAS Args* ka, LAS unsigned char* lds_base, int l, int wv) {
#if defined(__HIP_DEVICE_COMPILE__)
    const Args a = *ka;
#else
    const Args a{};
#endif
    int lane_; asm volatile("v_mbcnt_lo_u32_b32 %0, -1, 0\n\tv_mbcnt_hi_u32_b32 %0, -1, %0" : "=v"(lane_)); asm volatile("" : "+s"(wv)); int tid_ = wv * 64 + lane_; asm volatile("" : "+v"(tid_));
    LAS unsigned char* lds_l = lds_base; asm volatile("" : "+s"(lds_l));
    Ctx C; C.lds = lds_l; C.ws = a.ws; C.tid = tid_; C.lane = C.tid & 63; C.wave = __builtin_amdgcn_readfirstlane(C.tid >> 6);
    int G_ = gridDim.x, bid_ = blockIdx.x; asm volatile("" : "+s"(G_), "+s"(bid_));
    C.G = G_; C.bid = bid_; C.gw = C.bid * NWAVES + C.wave; C.NGW = C.G * NWAVES;
    asm volatile("; STEP_BEGIN %0" :: "n"(STEP));
    const int i = l >> 1; const bool even = !(l & 1);
    const size_t swl = WS_SMALLW + (size_t)l * SW_LAYER;
    if constexpr (STEP == 99) phase_init(C, a);
    if constexpr (STEP == 0) phase_convert(C, a, l);
    if constexpr (STEP == 1) { pg8::Gemm g{WSP(bf16_t, WS_HS), WSP(bf16_t, swl), DM, DM}; pg8::StaticOrder S; S.init(NTOK, even ? 2048 : 2304, C.G, C.bid);
        EpiWin E{C.ws, even ? 1 : 0, a.mla_g_qa + i * 256, a.mla_g_kva + i * 128}; pg8::gemm_phase<EpiWin, pg8::StaticOrder, true>(C.lds, g, S, E, C.tid); }
    if constexpr (STEP == 3) {
        { pg8::Gemm g{WSP(bf16_t, A_X1), WSP(bf16_t, swl + SW_WQB), 256, 256}; pg8::StaticOrder S; S.init(NTOK, 768, C.G, C.bid);
          EpiMlaQ E{C.ws}; pg8::gemm_phase<EpiMlaQ, pg8::StaticOrder, true>(C.lds, g, S, E, C.tid); }
        { int tid3 = C.tid; asm volatile("" : "+v"(tid3)); unsigned char* ws3 = C.ws; asm volatile("" : "+s"(ws3));
          pg8::Gemm g{(bf16_t*)(ws3 + A_X1 + 16 * MiB), (bf16_t*)(ws3 + swl + SW_WKVB), 256, 256}; pg8::StaticOrder S; S.init(NTOK, 1024, C.G, C.bid);
          EpiMlaKV E{ws3}; pg8::gemm_phase<EpiMlaKV, pg8::StaticOrder, true>(C.lds, g, S, E, tid3); } }
    if constexpr (STEP == 5) { if (even) phase_attn_even(C); else phase_attn_odd(C, a, i); }
    if constexpr (STEP == 6) phase_diff_combine(C, a, i, l);
    if constexpr (STEP == 7) { pg8::Gemm g{WSP(bf16_t, A_OB), WSP(bf16_t, swl + SW_WOUT), DM, DM}; pg8::StaticOrder S; S.init(NTOK, DM, C.G, C.bid);
        pg8::EpiResid E{l == 0 ? a.x : WSP(float, WS_XF), WSP(float, WS_XF), DN_ALPHA}; pg8::gemm_phase<pg8::EpiResid, pg8::StaticOrder, true>(C.lds, g, S, E, C.tid); }
    if constexpr (STEP == 8) phase_ln1(C, a, l);
    if constexpr (STEP == 9) { pg8::Gemm g{WSP(bf16_t, A_XS), WSP(bf16_t, WS_WR + (size_t)l * MiB), 2048, 2048}; pg8::StaticOrder S; S.init(NTOK, 256, C.G, C.bid);
        pg8::EpiF32 E{WSP(float, A_LOG), 256}; pg8::gemm_phase<pg8::EpiF32, pg8::StaticOrder, true>(C.lds, g, S, E, C.tid); }
    if constexpr (STEP == 10) phase_route(C, a, l);
    if constexpr (STEP == 11) { moe_tables(C, l);
        const LAS int* tst = (const LAS int*)(C.lds + LX_TST);
        MoeOrder<true> S{(const LAS int*)(C.lds + LX_CNT), tst, (const LAS unsigned char*)(C.lds + LX_TEXP), WSP(int, WS_ROWTOK), __builtin_amdgcn_readfirstlane(tst[64]), 128, 2, C.G, C.bid, SLOTS_R};
        pg8::Gemm g{WSP(bf16_t, A_XS), WSP(bf16_t, WS_WGU), 2048, DM}; pg8::EpiSwiGLU E{WSP(bf16_t, WS_HS)};
        pg8::gemm_phase<pg8::EpiSwiGLU, MoeOrder<true>, true>(C.lds, g, S, E, C.tid); }
    if constexpr (STEP == 12) { moe_tables(C, l);
        const LAS int* tst = (const LAS int*)(C.lds + LX_TST);
        MoeOrder<false> S{(const LAS int*)(C.lds + LX_CNT), tst, (const LAS unsigned char*)(C.lds + LX_TEXP), WSP(int, WS_ROWTOK), __builtin_amdgcn_readfirstlane(tst[64]), 128, 4, C.G, C.bid, 0};
        pg8::Gemm g{WSP(bf16_t, WS_HS), WSP(bf16_t, WS_WD), DE, DE}; EpiDownAll E{C.ws};
        pg8::gemm_phase<EpiDownAll, MoeOrder<false>, true>(C.lds, g, S, E, C.tid); }
    if constexpr (STEP == 14) { moe_tables(C, l); phase_combine_ln2(C, a, l); }
}
__global__ void __launch_bounds__(NTHREADS, 2) mega_fwd(Args a) {
    extern __shared__ __attribute__((aligned(16))) unsigned char lds_raw[];
    LAS unsigned char* lds = (LAS unsigned char*)lds_raw;
    const CAS Args* ka = (const CAS Args*)__builtin_amdgcn_kernarg_segment_ptr();
    const int wv = __builtin_amdgcn_readfirstlane(threadIdx.x >> 6);
    if (threadIdx.x < 4) ((LAS unsigned*)(lds + LX_BAR))[threadIdx.x] = 0u;
    __syncthreads();
    unsigned* barw = (unsigned*)(a.ws + WS_CTL) + CW_BAR;
    XcdBarrier bar; bar.bar = barw; bar.x = 0; bar.st = nullptr;
    if (a.use_bar) bar = xcd_barrier_post(barw, (volatile LAS unsigned*)(lds + LX_BAR));
    int step = 0;
#ifndef DUP_MASK
#define DUP_MASK 0u
#endif
#define BARRIER_NOW() do { XcdBarrier b2 = bar; asm volatile("" : "+s"(b2.bar)); int w2 = wv; asm volatile("" : "+s"(w2)); int l2_; asm volatile("v_mbcnt_lo_u32_b32 %0, -1, 0\n\tv_mbcnt_hi_u32_b32 %0, -1, %0" : "=v"(l2_)); xcd_barrier(b2, w2 == 0 && l2_ == 0); } while (0)
#define RUN(K, cond) do { if (step >= a.st_lo && step < a.st_hi) { if (cond) { const CAS Args* kp = ka; asm volatile("" : "+s"(kp)); step_fn<K>(kp, lds, l, wv); \
        if constexpr (K < 32 && ((DUP_MASK >> (K & 31)) & 1u)) { BARRIER_NOW(); const CAS Args* kp2 = ka; asm volatile("" : "+s"(kp2)); step_fn<K>(kp2, lds, l, wv); } if (a.use_bar && step + 1 < a.st_hi) BARRIER_NOW(); } } ++step; } while (0)
    { const int l = 0; RUN(99, true); }
#pragma unroll 1
    for (int l = 0; l < DEPTH; ++l) {
        const bool even = !(l & 1);
        RUN(0, true); RUN(1, true); RUN(2, false); RUN(3, even); RUN(4, false); RUN(5, true); RUN(6, !even); RUN(7, true);
        RUN(8, true); RUN(9, true); RUN(10, true); RUN(11, true); RUN(12, true); RUN(13, false); RUN(14, true);
    }
#undef RUN
}

extern "C" void kernel_launch(void* const* d_in, const int* in_sizes, int n_in, void* d_out, int out_size, void* d_ws, size_t ws_size, hipStream_t stream) {
    static int grid = 0;
    if (grid == 0) {
        if (n_in != 23 || out_size != NTOK * DM || ws_size < WS_END) { fprintf(stderr, "kernel_launch: unexpected problem shape (n_in %d out %d ws %zu)\n", n_in, out_size, ws_size); grid = -1; return; }
        int dev = 0, cus = 0;
        if (hipGetDevice(&dev) != hipSuccess || hipDeviceGetAttribute(&cus, hipDeviceAttributeMultiprocessorCount, dev) != hipSuccess) { grid = -1; return; }
        if (hipFuncSetAttribute((const void*)mega_fwd, hipFuncAttributeMaxDynamicSharedMemorySize, LDS_BYTES) != hipSuccess) { fprintf(stderr, "kernel_launch: hipFuncSetAttribute failed\n"); grid = -1; return; }
        int per_cu = 0;
        if (hipOccupancyMaxActiveBlocksPerMultiprocessor(&per_cu, (const void*)mega_fwd, NTHREADS, LDS_BYTES) != hipSuccess || per_cu < 1) { fprintf(stderr, "kernel_launch: occupancy query says %d\n", per_cu); }
        (void)hipGetLastError();
        grid = cus;
    }
    if (grid < 0) return;
    if (hipMemsetAsync((char*)d_ws + WS_CTL, 0, CTL_ZERO_BYTES, stream) != hipSuccess) return;
    Args a{};
    a.x = (const float*)d_in[0]; a.pos = (const int*)d_in[1];
    a.ev_w_in = (const float*)d_in[2]; a.ev_w_out = (const float*)d_in[3]; a.mla_g_qa = (const float*)d_in[4]; a.mla_w_qb = (const float*)d_in[5]; a.mla_g_kva = (const float*)d_in[6]; a.mla_w_kvb = (const float*)d_in[7];
    a.od_w_in = (const float*)d_in[8]; a.od_w_out = (const float*)d_in[9]; a.swa_sinks = (const float*)d_in[10]; a.diff_lambda = (const float*)d_in[11]; a.diff_g_subln = (const float*)d_in[12];
    a.ln_g = (const float*)d_in[13]; a.ln_b = (const float*)d_in[14]; a.moe_w_router = (const float*)d_in[15]; a.moe_bias = (const float*)d_in[16];
    a.moe_w_gate = (const float*)d_in[17]; a.moe_w_up = (const float*)d_in[18]; a.moe_w_down = (const float*)d_in[19]; a.sh_w_gate = (const float*)d_in[20]; a.sh_w_up = (const float*)d_in[21]; a.sh_w_down = (const float*)d_in[22];
    a.out = (float*)d_out; a.ws = (unsigned char*)d_ws;
#ifndef MK_ONE_LAUNCH
#define MK_ONE_LAUNCH 1
#endif
    if (MK_ONE_LAUNCH) {
        a.st_lo = 0; a.st_hi = NSTEPS; a.use_bar = 1;
        hipLaunchKernelGGL(mega_fwd, dim3(grid), dim3(NTHREADS), LDS_BYTES, stream, a);
    } else {
        for (int s = 0; s < NSTEPS; ++s) {
            if (s > 0) { const int ls = (s - 1) % STEPS_PER_LAYER, l = (s - 1) / STEPS_PER_LAYER; const bool even = !(l & 1);
                if (ls == 2 || ls == 4 || ls == 13) continue; if (even && ls == 6) continue; if (!even && ls == 3) continue; }
            a.st_lo = s; a.st_hi = s + 1; a.use_bar = 0;
            hipLaunchKernelGGL(mega_fwd, dim3(grid), dim3(NTHREADS), LDS_BYTES, stream, a);
        }
    }
}
```

```cpp
#include <hip/hip_runtime.h>
#include <cstdio>
#include <cstdint>

#define GAS __attribute__((address_space(1)))
#define LAS __attribute__((address_space(3)))
typedef unsigned short bf16_t;
typedef short bf16x8 __attribute__((ext_vector_type(8)));
typedef short s16x4 __attribute__((ext_vector_type(4)));
typedef float f32x2 __attribute__((ext_vector_type(2)));
typedef float f32x4 __attribute__((ext_vector_type(4)));
typedef float f32x16 __attribute__((ext_vector_type(16)));
typedef unsigned u32x2 __attribute__((ext_vector_type(2)));
typedef unsigned u32x4 __attribute__((ext_vector_type(4)));

constexpr int NTOK = 32768, DM = 1024, SEQ = 4096, NBATCH = 8, DEPTH = 4;
constexpr int EV_IN = 1952, OD_IN = 2304, HB_LD = 2304;
constexpr int NE = 64, DE = 256, TOPK = 8, CAP = 32768;
constexpr int TR_MAX = 1088;
constexpr int SLOTS_R = TR_MAX * 256;
constexpr int SLOTS = SLOTS_R + NTOK;
constexpr float DN_ALPHA = 1.681792830507429f;
constexpr float LOG2E = 1.4426950408889634f;

__device__ __forceinline__ unsigned f2bf(float f) { unsigned u = __builtin_bit_cast(unsigned, f); return (u + 0x7fffu + ((u >> 16) & 1u)) >> 16; }
__device__ __forceinline__ float bf2f(unsigned b) { return __builtin_bit_cast(float, b << 16); }
__device__ __forceinline__ unsigned pk2(float lo, float hi) { return f2bf(lo) | (f2bf(hi) << 16); }
__device__ __forceinline__ float wave_sum(float v) {
#pragma unroll
    for (int o = 1; o < 64; o <<= 1) v += __shfl_xor(v, o);
    return v;
}
namespace pg8 {
constexpr int BM = 256, BK = 64, HALF = 128, HTB = HALF * BK * 2  , STAGE_BYTES = 8 * HTB, NXCD = 8, WGM = 8;
__host__ __device__ __forceinline__ int lds_byte(int r, int c) { const int st = (r >> 4) * 2 + (c >> 5), rr = r & 15, cc = c & 31, ob = rr * 64 + cc * 2; return st * 1024 + (ob ^ (((ob >> 9) & 1) << 5)); }
__host__ __device__ __forceinline__ void stage_rc(int b, int& R, int& C) { const int st = b / 1024, sb = b % 1024, swz = sb ^ (((sb >> 9) & 1) << 5); R = (st >> 1) * 16 + swz / 64; C = (st & 1) * 32 + (swz % 64) / 2; }
__host__ __device__ __forceinline__ int perm32(int rho) { const int n = rho >> 4, i = rho & 15; return 8 * (i >> 2) + 4 * n + (i & 3); }

struct Unit { int pm, pn, orow, ocol, e, lt; };
struct Gemm { const bf16_t* A; const bf16_t* Bt; int lda, K; };

struct StaticOrder {
    static constexpr bool GATHER = false;
    int nM, nN, nwg, G, c;
    __device__ void init(int M, int N, int G_, int c_) { nM = M / BM; nN = N / BM; nwg = nM * nN; G = G_; c = c_; }
    __device__ __forceinline__ bool next(int i, Unit& u) const {
        const long L = (long)i * G + c; if (L >= nwg) return false;
        int wgid = (int)L; { const int q = nwg / NXCD, r = nwg % NXCD, xcd = wgid % NXCD, off = wgid / NXCD; wgid = (xcd < r ? xcd * (q + 1) : r * (q + 1) + (xcd - r) * q) + off; }
        const int nig = WGM * nN, gid = wgid / nig, fm = gid * WGM, gsz = (nM - fm) < WGM ? (nM - fm) : WGM;
        u.pm = fm + ((wgid % nig) % gsz); u.pn = (wgid % nig) / gsz; u.orow = u.pm * BM; u.ocol = u.pn * BM; u.e = 0; u.lt = u.pm; return true;
    }
    __device__ __forceinline__ unsigned arow(const Unit& u, int r) const { return (unsigned)(u.pm * BM + r); }
};

__device__ __forceinline__ unsigned cvt_pk_bf16(float lo, float hi) { unsigned r; asm volatile("v_cvt_pk_bf16_f32 %0, %1, %2" : "=v"(r) : "v"(lo), "v"(hi)); return r; }

struct EpiBf16 {
    static constexpr bool PERM = true;
    bf16_t* O; int ldc;
    __device__ __forceinline__ void operator()(const f32x4 (&acc)[2][2][4][2], const Unit& u, int wr, int wc, int fr, int fq) const {
        const int row0 = u.orow + wr * 64 + fr, col0 = u.ocol + wc * 32 + 8 * fq;
#pragma unroll
        for (int ai = 0; ai < 2; ++ai)
#pragma unroll
            for (int m = 0; m < 4; ++m) { bf16_t* rowp = O + (size_t)(row0 + ai * HALF + m * 16) * ldc + col0;
#pragma unroll
                for (int bj = 0; bj < 2; ++bj) { const f32x4 v0 = acc[ai][bj][m][0], v1 = acc[ai][bj][m][1];
                    u32x4 w; w.x = cvt_pk_bf16(v0[0], v0[1]); w.y = cvt_pk_bf16(v0[2], v0[3]); w.z = cvt_pk_bf16(v1[0], v1[1]); w.w = cvt_pk_bf16(v1[2], v1[3]);
                    *(u32x4*)(rowp + bj * HALF) = w; } }
    }
};
struct EpiF32 {
    static constexpr bool PERM = false;
    float* C; int ldc;
    __device__ __forceinline__ void operator()(const f32x4 (&acc)[2][2][4][2], const Unit& u, int wr, int wc, int fr, int fq) const {
        const int row0 = u.orow + wr * 64 + fr, col0 = u.ocol + wc * 32 + 4 * fq;
#pragma unroll
        for (int ai = 0; ai < 2; ++ai)
#pragma unroll
            for (int m = 0; m < 4; ++m) { float* rowp = C + (size_t)(row0 + ai * HALF + m * 16) * ldc + col0;
#pragma unroll
                for (int bj = 0; bj < 2; ++bj)
#pragma unroll
                    for (int n = 0; n < 2; ++n) *(f32x4*)(rowp + bj * HALF + n * 16) = acc[ai][bj][m][n]; }
    }
};
struct EpiResid {
    static constexpr bool PERM = false;
    const float* src; float* dst; float alpha;
    __device__ __forceinline__ void operator()(const f32x4 (&acc)[2][2][4][2], const Unit& u, int wr, int wc, int fr, int fq) const {
        const int row0 = u.orow + wr * 64 + fr, col0 = u.ocol + wc * 32 + 4 * fq;
#pragma unroll
        for (int ai = 0; ai < 2; ++ai)
#pragma unroll
            for (int m = 0; m < 4; ++m) { const size_t ro = (size_t)(row0 + ai * HALF + m * 16) * DM + col0;
#pragma unroll
                for (int bj = 0; bj < 2; ++bj)
#pragma unroll
                    for (int n = 0; n < 2; ++n) { const f32x4 s = *(const f32x4*)(src + ro + bj * HALF + n * 16); *(f32x4*)(dst + ro + bj * HALF + n * 16) = s * alpha + acc[ai][bj][m][n]; } }
    }
};
struct EpiSwiGLU {
    static constexpr bool PERM = true;
    bf16_t* H;
    __device__ __forceinline__ void operator()(const f32x4 (&acc)[2][2][4][2], const Unit& u, int wr, int wc, int fr, int fq) const {
        const int row0 = u.orow + wr * 64 + fr, col0 = u.ocol + wc * 32 + 8 * fq;
#pragma unroll
        for (int ai = 0; ai < 2; ++ai)
#pragma unroll
            for (int m = 0; m < 4; ++m) { bf16_t* rowp = H + (size_t)(row0 + ai * HALF + m * 16) * DE + col0;
                float h[8];
#pragma unroll
                for (int n = 0; n < 2; ++n)
#pragma unroll
                    for (int j = 0; j < 4; ++j) { const float g = acc[ai][0][m][n][j], up = acc[ai][1][m][n][j]; h[n * 4 + j] = g / (1.0f + __expf(-g)) * up; }
                u32x4 w; w.x = cvt_pk_bf16(h[0], h[1]); w.y = cvt_pk_bf16(h[2], h[3]); w.z = cvt_pk_bf16(h[4], h[5]); w.w = cvt_pk_bf16(h[6], h[7]);
                *(u32x4*)rowp = w; }
    }
};
struct EpiDown {
    static constexpr bool PERM = true;
    bf16_t* Y; const float* wslot; const LAS int* cnt;
    __device__ __forceinline__ void operator()(const f32x4 (&acc)[2][2][4][2], const Unit& u, int wr, int wc, int fr, int fq) const {
        const int rl0 = wr * 64 + fr, col0 = u.ocol + wc * 32 + 8 * fq; const int ce = cnt[u.e];
#pragma unroll
        for (int ai = 0; ai < 2; ++ai)
#pragma unroll
            for (int m = 0; m < 4; ++m) { const int rl = rl0 + ai * HALF + m * 16, loc = u.lt * BM + rl;
                const float gw = loc < ce ? wslot[(size_t)u.e * CAP + loc] : 0.f;
                bf16_t* rowp = Y + (size_t)(u.orow + rl) * DM + col0;
#pragma unroll
                for (int bj = 0; bj < 2; ++bj) { const f32x4 v0 = acc[ai][bj][m][0] * gw, v1 = acc[ai][bj][m][1] * gw;
                    u32x4 w; w.x = cvt_pk_bf16(v0[0], v0[1]); w.y = cvt_pk_bf16(v0[2], v0[3]); w.z = cvt_pk_bf16(v1[0], v1[1]); w.w = cvt_pk_bf16(v1[2], v1[3]);
                    *(u32x4*)(rowp + bj * HALF) = w; } }
    }
};

template <class Epi, class Sched, bool ALIGN_EPI>
__device__ __forceinline__ void gemm_phase(LAS unsigned char* lds, const Gemm g, const Sched& S, const Epi& E, const int tid) {
    const int wid = __builtin_amdgcn_readfirstlane(tid >> 6), lane = tid & 63, wr = wid >> 2, wc = wid & 3, fr = lane & 15, fq = lane >> 4;
    const int K = g.K, nt = K / BK;
    constexpr bool GATHER = Sched::GATHER;
    int Ra[2]; unsigned Ca[2], voffA[2], voffB[2];
    const unsigned ldab = (unsigned)g.lda * 2u;
#pragma unroll
    for (int i = 0; i < 2; ++i) { int R, C; stage_rc(tid * 16 + i * 8192, R, C); const int Rb = Epi::PERM ? ((R & ~31) + perm32(R & 31)) : R;
        Ra[i] = R; Ca[i] = (unsigned)C * 2u; voffA[i] = (unsigned)R * ldab + (unsigned)C * 2u; voffB[i] = (unsigned)(Rb * K + C) * 2u; }
    const size_t hstepA = (size_t)HALF * ldab;
    const size_t kstep = (size_t)(BK * 2);
    const size_t hstep = (size_t)HALF * K * 2;
    const size_t tstep = 2 * hstep;
    const unsigned ldsw = (unsigned)wid * 1024u;
    const int aoff = lds_byte(wr * 64 + fr, fq * 8), boff = lds_byte(wc * 32 + fr, fq * 8);
    const char* Ab = (const char*)g.A;
#define PG8_SA(b, h) (((b) * 2 + (h)) * HTB)
#define PG8_SB(b, h) ((4 + (b) * 2 + (h)) * HTB)
#define PG8_STAGE(bufoff, gbase, voff) do { _Pragma("unroll") for (int _i = 0; _i < 2; ++_i) \
        __builtin_amdgcn_global_load_lds((const unsigned*)((const char*)(gbase) + (voff)[_i]), (LAS unsigned*)(lds + (bufoff) + ldsw + _i * 8192), 16, 0, 0); } while (0)
#define PG8_STAGEA(bufoff, offs, ubase, h, kbyte) do { _Pragma("unroll") for (int _i = 0; _i < 2; ++_i) { \
        const char* _src = GATHER ? Ab + (size_t)(offs)[h][_i] + (size_t)(kbyte) : (ubase) + (size_t)(h) * hstepA + (size_t)(kbyte) + voffA[_i]; \
        __builtin_amdgcn_global_load_lds((const unsigned*)_src, (LAS unsigned*)(lds + (bufoff) + ldsw + _i * 8192), 16, 0, 0); } } while (0)
#define PG8_OFFS(dst, u) do { if constexpr (GATHER) { _Pragma("unroll") for (int _h = 0; _h < 2; ++_h) _Pragma("unroll") for (int _i = 0; _i < 2; ++_i) dst[_h][_i] = S.arow(u, _h * HALF + Ra[_i]) * ldab + Ca[_i]; } } while (0)
#define PG8_LDA(dst, b, h) do { _Pragma("unroll") for (int m = 0; m < 4; ++m) _Pragma("unroll") for (int k = 0; k < 2; ++k) dst[m][k] = *(const LAS bf16x8*)(lds + PG8_SA(b, h) + aoff + m * 2048 + k * 1024); } while (0)
#define PG8_LDB(dst, b, h) do { _Pragma("unroll") for (int n = 0; n < 2; ++n) _Pragma("unroll") for (int k = 0; k < 2; ++k) dst[n][k] = *(const LAS bf16x8*)(lds + PG8_SB(b, h) + boff + n * 2048 + k * 1024); } while (0)
#define PG8_MMA(ai, bj, At, Bt) do { __builtin_amdgcn_s_setprio(1); _Pragma("unroll") for (int m = 0; m < 4; ++m) _Pragma("unroll") for (int n = 0; n < 2; ++n) _Pragma("unroll") for (int k = 0; k < 2; ++k) \
        acc[ai][bj][m][n] = __builtin_amdgcn_mfma_f32_16x16x32_bf16(Bt[n][k], At[m][k], acc[ai][bj][m][n], 0, 0, 0); __builtin_amdgcn_s_setprio(0); } while (0)
#define PG8_WAIT_V(n) asm volatile("s_waitcnt vmcnt(" #n ")" ::: "memory")
#define PG8_WAIT_L(n) asm volatile("s_waitcnt lgkmcnt(" #n ")" ::: "memory")
#define PG8_BAR __builtin_amdgcn_s_barrier()
#define PG8_SCHED __builtin_amdgcn_sched_barrier(0)
    Unit cur, nxt; int ui = 0;
    if (!S.next(0, cur)) return;
    f32x4 acc[2][2][4][2];
#pragma unroll
    for (int a = 0; a < 2; ++a)
#pragma unroll
        for (int b = 0; b < 2; ++b)
#pragma unroll
            for (int m = 0; m < 4; ++m)
#pragma unroll
                for (int n = 0; n < 2; ++n) acc[a][b][m][n] = (f32x4){0.f, 0.f, 0.f, 0.f};
    bf16x8 At[4][2], B0[2][2], B1[2][2];
    unsigned oc[2][2] = {{0u, 0u}, {0u, 0u}}, on[2][2] = {{0u, 0u}, {0u, 0u}};
    PG8_OFFS(oc, cur);
    const char* cA = Ab + (size_t)S.arow(cur, 0) * ldab;
    const char* cB = (const char*)g.Bt + (size_t)cur.pn * tstep;
    PG8_STAGE(PG8_SB(0, 0), cB, voffB); PG8_STAGE(PG8_SB(0, 1), cB + hstep, voffB); PG8_STAGEA(PG8_SA(0, 0), oc, cA, 0, 0); PG8_STAGEA(PG8_SA(0, 1), oc, cA, 1, 0);
    if (wr == 1) PG8_BAR;
    PG8_WAIT_V(2); PG8_BAR;
    PG8_STAGE(PG8_SB(1, 0), cB + kstep, voffB); PG8_STAGEA(PG8_SA(1, 0), oc, cA, 0, kstep); PG8_STAGE(PG8_SB(1, 1), cB + hstep + kstep, voffB);
    PG8_WAIT_V(6); PG8_BAR;
    for (;;) {
        const bool has_next = S.next(ui + 1, nxt);
        if (has_next) { PG8_OFFS(on, nxt); } else {
#pragma unroll
            for (int h = 0; h < 2; ++h)
#pragma unroll
                for (int i = 0; i < 2; ++i) on[h][i] = oc[h][i]; }
        const char* nB = has_next ? (const char*)g.Bt + (size_t)nxt.pn * tstep : cB;
        const char* nA = has_next ? Ab + (size_t)S.arow(nxt, 0) * ldab : cA;
        for (int t = 0; t < nt; t += 2) {
            const bool last = (t == nt - 2);
            const size_t k1 = (size_t)(t + 1) * kstep;
            const size_t k2 = last ? 0 : (size_t)(t + 2) * kstep, k3 = k2 + kstep;
            const char* b2 = last ? nB : cB + (size_t)(t + 2) * kstep; const char* b3 = b2 + kstep;
            unsigned o2[2][2]; const char* a2 = last ? nA : cA;
#pragma unroll
            for (int h = 0; h < 2; ++h)
#pragma unroll
                for (int i = 0; i < 2; ++i) o2[h][i] = last ? on[h][i] : oc[h][i];
            PG8_LDB(B0, 0, 0); PG8_LDB(B1, 0, 1); PG8_SCHED; PG8_LDA(At, 0, 0); PG8_STAGEA(PG8_SA(1, 1), oc, cA, 1, k1);
            PG8_WAIT_V(8); PG8_WAIT_L(0); PG8_BAR; PG8_MMA(0, 0, At, B0); PG8_MMA(0, 1, At, B1); PG8_BAR; PG8_SCHED;
            PG8_LDA(At, 0, 1); PG8_STAGE(PG8_SB(0, 0), b2, voffB); PG8_STAGE(PG8_SB(0, 1), b2 + hstep, voffB); PG8_STAGEA(PG8_SA(0, 0), o2, a2, 0, k2);
            PG8_WAIT_V(8); PG8_WAIT_L(0); PG8_BAR; PG8_MMA(1, 0, At, B0); PG8_MMA(1, 1, At, B1); PG8_BAR; PG8_SCHED;
            PG8_LDB(B0, 1, 0); PG8_LDB(B1, 1, 1); PG8_SCHED; PG8_LDA(At, 1, 0); PG8_STAGEA(PG8_SA(0, 1), o2, a2, 1, k2);
            PG8_WAIT_V(8); PG8_WAIT_L(0); PG8_BAR; PG8_MMA(0, 0, At, B0); PG8_MMA(0, 1, At, B1); PG8_BAR; PG8_SCHED;
            PG8_LDA(At, 1, 1); PG8_STAGE(PG8_SB(1, 0), b3, voffB); PG8_STAGE(PG8_SB(1, 1), b3 + hstep, voffB); PG8_STAGEA(PG8_SA(1, 0), o2, a2, 0, k3);
            PG8_WAIT_V(8); PG8_WAIT_L(0); PG8_BAR; PG8_MMA(1, 0, At, B0); PG8_MMA(1, 1, At, B1); PG8_BAR; PG8_SCHED;
        }
        if constexpr (ALIGN_EPI) { if (wr == 0) PG8_BAR; }
        { int l2; asm volatile("v_mbcnt_lo_u32_b32 %0, -1, 0\n\tv_mbcnt_hi_u32_b32 %0, -1, %0" : "=v"(l2)); E(acc, cur, wr, wc, l2 & 15, l2 >> 4); }
        if (!has_next) break;
#pragma unroll
        for (int a = 0; a < 2; ++a)
#pragma unroll
            for (int b = 0; b < 2; ++b)
#pragma unroll
                for (int m = 0; m < 4; ++m)
#pragma unroll
                    for (int n = 0; n < 2; ++n) acc[a][b][m][n] = (f32x4){0.f, 0.f, 0.f, 0.f};
        cur = nxt; cB = nB; cA = nA; ++ui;
#pragma unroll
        for (int h = 0; h < 2; ++h)
#pragma unroll
            for (int i = 0; i < 2; ++i) oc[h][i] = on[h][i];
        if constexpr (ALIGN_EPI) { if (wr == 1) PG8_BAR; }
    }
    PG8_WAIT_V(0);
    if constexpr (!ALIGN_EPI) { if (wr == 0) PG8_BAR; }
    PG8_BAR;
#undef PG8_SA
#undef PG8_SB
#undef PG8_STAGE
#undef PG8_STAGEA
#undef PG8_OFFS
#undef PG8_LDA
#undef PG8_LDB
#undef PG8_MMA
#undef PG8_WAIT_V
#undef PG8_WAIT_L
#undef PG8_BAR
#undef PG8_SCHED
}
}
namespace att {
constexpr int M_CAUSAL = 0, M_MOBA = 1, M_SWA = 2, M_DIFF = 3;
constexpr float RESCALE_THR = 8.0f;
__device__ __forceinline__ unsigned cvtpk(float lo, float hi) { unsigned r; asm volatile("v_cvt_pk_bf16_f32 %0, %1, %2" : "=v"(r) : "v"(lo), "v"(hi)); return r; }
__device__ __forceinline__ float max3f(float a, float b, float c) { float r; asm("v_max3_f32 %0, %1, %2, %3" : "=v"(r) : "v"(a), "v"(b), "v"(c)); return r; }
__device__ __forceinline__ float xhalf_max(float m) { const auto rr = __builtin_amdgcn_permlane32_swap(__float_as_uint(m), __float_as_uint(m), false, false); return fmaxf(__uint_as_float(rr[0]), __uint_as_float(rr[1])); }
__device__ __forceinline__ float xhalf_sum(float m) { const auto rr = __builtin_amdgcn_permlane32_swap(__float_as_uint(m), __float_as_uint(m), false, false); return __uint_as_float(rr[0]) + __uint_as_float(rr[1]); }
__device__ __forceinline__ void glds16(const void* gsrc, unsigned lds_dst) { unsigned keep;
    asm volatile("s_mov_b32 %0, m0\n\ts_mov_b32 m0, %2\n\ts_nop 0\n\tglobal_load_lds_dwordx4 %1, off\n\ts_mov_b32 m0, %0" : "=&s"(keep) : "v"(gsrc), "s"(lds_dst) : "memory"); }
template <int DK, int DV, int MODE> struct Cfg {
    static constexpr int KCOLS = (MODE == M_DIFF) ? 2 * DK : DK;
    static constexpr int NKP = KCOLS / 16 * 2, NVP = 4 * (DV / 32), NP = NKP + NVP;
    static constexpr int KBYTES = NKP * 1024, VBYTES = NVP * 1024, BUF = KBYTES + VBYTES;
    static constexpr int QROWS = (MODE == M_DIFF) ? 128 : 256;
    static constexpr int LDS_BYTES = 2 * BUF;
};
struct Tens { const bf16_t* Q; const bf16_t* K; const bf16_t* V; bf16_t* O; int ldq, ldk, ldv, ldo; };

template <int DK, int DV, int MODE>
__device__ __forceinline__ void unit(const Tens& T, int b, int qb, const float* kmean, float sink, float lam, const float* gsub, float gscale, LAS unsigned char* lds, const int tid) {
    typedef Cfg<DK, DV, MODE> G;
    asm volatile("; UNIT_BEGIN %0 %1 %2" :: "n"(DK), "n"(DV), "n"(MODE));
    const int lane = tid & 63, r32 = lane & 31, hi = lane >> 5; const int wid = __builtin_amdgcn_readfirstlane(tid >> 6);
    const int strm = (MODE == M_DIFF) ? (wid >> 2) : 0, wq = (MODE == M_DIFF) ? (wid & 3) : wid;
    const size_t rowbase = (size_t)b * SEQ;
    const int q0 = qb * G::QROWS, qw0 = q0 + wq * 32, qabs = qw0 + r32;
    bf16x8 qf[DK / 16];
    { const bf16_t* qp = T.Q + (rowbase + qabs) * T.ldq + strm * DK + 8 * hi;
#pragma unroll
      for (int d0 = 0; d0 < DK / 16; ++d0) qf[d0] = *(const bf16x8*)(qp + 16 * d0); }
    int sel0 = -1, sel1 = -1, sel2 = -1;
    if constexpr (MODE == M_MOBA) {
        float b0 = -INFINITY, b1 = -INFINITY, b2 = -INFINITY;
        float qv[32];
#pragma unroll
        for (int d0 = 0; d0 < 4; ++d0)
#pragma unroll
            for (int e = 0; e < 8; ++e) qv[8 * d0 + e] = bf2f((unsigned short)qf[d0][e]);
        const float* kmp = kmean + 8 * hi;
#pragma unroll 1
        for (int j = 0; j < qb; ++j, kmp += 128) {
            float a = 0.f;
#pragma unroll
            for (int d0 = 0; d0 < 4; ++d0) { const f32x4 k0 = *(const f32x4*)(kmp + 16 * d0) + *(const f32x4*)(kmp + 16 * d0 + 64), k1 = *(const f32x4*)(kmp + 16 * d0 + 4) + *(const f32x4*)(kmp + 16 * d0 + 68);
#pragma unroll
                for (int e = 0; e < 4; ++e) { a += qv[8 * d0 + e] * k0[e]; a += qv[8 * d0 + 4 + e] * k1[e]; } }
            a += __shfl_xor(a, 32);
            if (a > b0) { b2 = b1; sel2 = sel1; b1 = b0; sel1 = sel0; b0 = a; sel0 = j; }
            else if (a > b1) { b2 = b1; sel2 = sel1; b1 = a; sel1 = j; }
            else if (a > b2) { b2 = a; sel2 = j; }
        }
    }
    int t_lo = 0; const int t_hi = (q0 + G::QROWS) >> 6;
    if constexpr (MODE == M_SWA) t_lo = qb == 0 ? 0 : qb * 4 - 2;
    const int krow = (r32 & 0x13) | ((r32 & 4) << 1) | ((r32 & 8) >> 1);
    const unsigned koff = (unsigned)(krow * T.ldk + 8 * hi) * 2u, voff = (unsigned)((lane >> 2) * T.ldv + 8 * (lane & 3)) * 2u;
    const char* Kg = (const char*)(T.K + rowbase * T.ldk); const char* Vg = (const char*)(T.V + rowbase * T.ldv);
    const unsigned lds0 = (unsigned)(uintptr_t)lds;
#define ATT_DMA(t, bsel) do { _Pragma("unroll") for (int p_ = 0; p_ < (G::NP + 7) / 8; ++p_) { const int pc_ = wid + 8 * p_; if (pc_ < G::NP) { \
        if (pc_ < G::NKP) { const char* s_ = Kg + ((size_t)((t) * 64 + 32 * (pc_ & 1)) * T.ldk + 16 * (pc_ >> 1)) * 2 + koff; \
            glds16(s_, (unsigned)__builtin_amdgcn_readfirstlane((int)(lds0 + (bsel) * G::BUF + pc_ * 1024))); } \
        else { const int pv_ = pc_ - G::NKP; const char* s_ = Vg + ((size_t)((t) * 64 + 16 * (pv_ & 3)) * T.ldv + 32 * (pv_ >> 2)) * 2 + voff; \
            glds16(s_, (unsigned)__builtin_amdgcn_readfirstlane((int)(lds0 + (bsel) * G::BUF + G::KBYTES + pv_ * 1024))); } } } } while (0)
    float mref = 0.f, lsum = 0.f; bool fresh = true;
    if constexpr (MODE == M_SWA) lsum = hi == 0 ? __builtin_amdgcn_exp2f(sink) : 0.f;
    f32x16 o[DV / 32];
#pragma unroll
    for (int d = 0; d < DV / 32; ++d) o[d] = f32x16{};
    const int kfo = (strm * (DK / 16) * 2) * 1024 + hi * 512 + r32 * 16;
    const int i16 = lane & 15;
    const int vfo = G::KBYTES + (8 * hi + (i16 >> 2)) * 64 + (16 * (r32 >> 4) + 4 * (i16 & 3)) * 2;
    __builtin_amdgcn_s_barrier();
    ATT_DMA(t_lo, 0);
    for (int t = t_lo; t < t_hi; ++t) {
        const int bsel = (t - t_lo) & 1;
        __builtin_amdgcn_s_waitcnt(0x0F70);
        __builtin_amdgcn_s_barrier();
        if (t + 1 < t_hi) ATT_DMA(t + 1, bsel ^ 1);
        const int kv0 = t * 64;
        bool skip = kv0 > qw0 + 31;
        if constexpr (MODE == M_SWA) skip = skip || (kv0 + 63 < qw0 - 127);
        if constexpr (MODE == M_MOBA) { if (kv0 < q0) { const int jb = kv0 >> 8; skip = skip || !__any(jb == sel0 || jb == sel1 || jb == sel2); } }
        if (skip) continue;
        const LAS unsigned char* bb = lds + bsel * G::BUF;
        bf16x8 kf[DK / 16][2];
#pragma unroll
        for (int d0 = 0; d0 < DK / 16; ++d0) { kf[d0][0] = *(const LAS bf16x8*)(bb + kfo + (2 * d0) * 1024); kf[d0][1] = *(const LAS bf16x8*)(bb + kfo + (2 * d0 + 1) * 1024); }
        f32x16 p0, p1;
#pragma unroll
        for (int i = 0; i < 16; ++i) { p0[i] = -mref; p1[i] = -mref; }
        __builtin_amdgcn_sched_barrier(0);
#pragma unroll
        for (int d0 = 0; d0 < DK / 16; ++d0) {
            p0 = __builtin_amdgcn_mfma_f32_32x32x16_bf16(kf[d0][0], qf[d0], p0, 0, 0, 0);
            p1 = __builtin_amdgcn_mfma_f32_32x32x16_bf16(kf[d0][1], qf[d0], p1, 0, 0, 0);
        }
        __builtin_amdgcn_sched_barrier(0);
        bf16x8 vf[2][4];
#define ATT_VLOAD(dbase) do { _Pragma("unroll") for (int d_ = 0; d_ < 2; ++d_) _Pragma("unroll") for (int s2 = 0; s2 < 4; ++s2) { const LAS unsigned char* vp = bb + vfo + (4 * ((dbase) + d_) + s2) * 1024; \
            const s16x4 lo = __builtin_bit_cast(s16x4, __builtin_amdgcn_ds_read_tr16_b64_v4i16((LAS s16x4*)(vp))); const s16x4 hh = __builtin_bit_cast(s16x4, __builtin_amdgcn_ds_read_tr16_b64_v4i16((LAS s16x4*)(vp + 256))); \
            vf[d_][s2] = (bf16x8){lo[0], lo[1], lo[2], lo[3], hh[0], hh[1], hh[2], hh[3]}; } } while (0)
        ATT_VLOAD(0);
        __builtin_amdgcn_sched_barrier(0);
        if constexpr (MODE == M_MOBA) { if (kv0 < q0) { const int jb = kv0 >> 8; if (!(jb == sel0 || jb == sel1 || jb == sel2)) {
#pragma unroll
            for (int i = 0; i < 16; ++i) { p0[i] = -INFINITY; p1[i] = -INFINITY; } } } }
        bool need_mask = kv0 + 63 > qw0;
        if constexpr (MODE == M_SWA) need_mask = need_mask || (kv0 < qw0 + 31 - 127);
        if (need_mask) {
#pragma unroll
            for (int i = 0; i < 16; ++i) { const int kv = kv0 + 16 * (i >> 3) + 8 * hi + (i & 7);
                bool m0 = kv > qabs, m1 = kv + 32 > qabs;
                if constexpr (MODE == M_SWA) { m0 = m0 || (kv < qabs - 127); m1 = m1 || (kv + 32 < qabs - 127); }
                if (m0) p0[i] = -INFINITY; if (m1) p1[i] = -INFINITY; }
        }
        float mx = max3f(p0[0], p1[0], p0[1]), mxb = max3f(p1[1], p0[2], p1[2]);
#pragma unroll
        for (int i = 3; i < 15; i += 2) { mx = max3f(mx, p0[i], p1[i]); mxb = max3f(mxb, p0[i + 1], p1[i + 1]); }
        mx = max3f(mx, p0[15], p1[15]); mx = fmaxf(mx, mxb);
        mx = xhalf_max(mx);
        if (fresh || !__all(mx <= RESCALE_THR)) {
            const float dm = fresh ? (mx > -1e30f ? mx : 0.f) : fmaxf(mx, 0.f), alpha = __builtin_amdgcn_exp2f(-dm); fresh = false;
            mref += dm; lsum *= alpha;
#pragma unroll
            for (int d = 0; d < DV / 32; ++d)
#pragma unroll
                for (int i = 0; i < 16; ++i) o[d][i] *= alpha;
#pragma unroll
            for (int i = 0; i < 16; ++i) { p0[i] -= dm; p1[i] -= dm; }
        }
        float ls0 = 0.f, ls1 = 0.f;
#pragma unroll
        for (int i = 0; i < 16; ++i) { p0[i] = __builtin_amdgcn_exp2f(p0[i]); p1[i] = __builtin_amdgcn_exp2f(p1[i]); ls0 += p0[i]; ls1 += p1[i]; }
        lsum += ls0 + ls1;
        bf16x8 pf[4];
#pragma unroll
        for (int s2 = 0; s2 < 4; ++s2) { const f32x16& pp = (s2 >> 1) ? p1 : p0; const int b0 = 8 * (s2 & 1);
            u32x4 w; w.x = cvtpk(pp[b0 + 0], pp[b0 + 1]); w.y = cvtpk(pp[b0 + 2], pp[b0 + 3]); w.z = cvtpk(pp[b0 + 4], pp[b0 + 5]); w.w = cvtpk(pp[b0 + 6], pp[b0 + 7]);
            pf[s2] = __builtin_bit_cast(bf16x8, w); }
        __builtin_amdgcn_sched_barrier(0);
        if constexpr (DV == 64) {
#pragma unroll
            for (int d = 0; d < 2; ++d)
#pragma unroll
                for (int s2 = 0; s2 < 4; ++s2) o[d] = __builtin_amdgcn_mfma_f32_32x32x16_bf16(vf[d][s2], pf[s2], o[d], 0, 0, 0);
        } else {
            bf16x8 vg[2][4];
#pragma unroll
            for (int d_ = 0; d_ < 2; ++d_)
#pragma unroll
                for (int s2 = 0; s2 < 4; ++s2) { const LAS unsigned char* vp = bb + vfo + (4 * (2 + d_) + s2) * 1024;
                    const s16x4 lo = __builtin_bit_cast(s16x4, __builtin_amdgcn_ds_read_tr16_b64_v4i16((LAS s16x4*)(vp))); const s16x4 hh = __builtin_bit_cast(s16x4, __builtin_amdgcn_ds_read_tr16_b64_v4i16((LAS s16x4*)(vp + 256)));
                    vg[d_][s2] = (bf16x8){lo[0], lo[1], lo[2], lo[3], hh[0], hh[1], hh[2], hh[3]}; }
            __builtin_amdgcn_sched_barrier(0);
#pragma unroll
            for (int d = 0; d < 2; ++d)
#pragma unroll
                for (int s2 = 0; s2 < 4; ++s2) o[d] = __builtin_amdgcn_mfma_f32_32x32x16_bf16(vf[d][s2], pf[s2], o[d], 0, 0, 0);
            __builtin_amdgcn_sched_barrier(0);
#pragma unroll
            for (int d = 0; d < 2; ++d)
#pragma unroll
                for (int s2 = 0; s2 < 4; ++s2) o[2 + d] = __builtin_amdgcn_mfma_f32_32x32x16_bf16(vg[d][s2], pf[s2], o[2 + d], 0, 0, 0);
        }
    }
#undef ATT_DMA
#undef ATT_VLOAD
    const float inv = 1.0f / xhalf_sum(lsum);
    if constexpr (MODE == M_DIFF) {
        LAS float* xch = (LAS float*)lds;
        __builtin_amdgcn_s_barrier();
        if (strm == 1) {
#pragma unroll
            for (int d = 0; d < DV / 32; ++d)
#pragma unroll
                for (int i = 0; i < 16; ++i) xch[((wq * (DV / 32) + d) * 16 + i) * 64 + lane] = o[d][i] * inv;
        }
        asm volatile("s_waitcnt lgkmcnt(0)" ::: "memory");
        __builtin_amdgcn_s_barrier();
        if (strm == 0) {
            float ss = 0.f;
#pragma unroll
            for (int d = 0; d < DV / 32; ++d)
#pragma unroll
                for (int i = 0; i < 16; ++i) { const float v = o[d][i] * inv - lam * xch[((wq * (DV / 32) + d) * 16 + i) * 64 + lane]; o[d][i] = v; ss += v * v; }
            ss = xhalf_sum(ss);
            const float rr = gscale / sqrtf(ss * (1.0f / DV) + 1e-5f);
            bf16_t* op = T.O + (rowbase + qabs) * T.ldo + 4 * hi;
#pragma unroll
            for (int d = 0; d < DV / 32; ++d)
#pragma unroll
                for (int g4 = 0; g4 < 4; ++g4) { const f32x4 gg = *(const f32x4*)(gsub + 32 * d + 8 * g4 + 4 * hi);
                    u32x2 w; w.x = cvtpk(o[d][4 * g4] * rr * gg[0], o[d][4 * g4 + 1] * rr * gg[1]); w.y = cvtpk(o[d][4 * g4 + 2] * rr * gg[2], o[d][4 * g4 + 3] * rr * gg[3]); *(u32x2*)(op + 32 * d + 8 * g4) = w; }
        }
    } else {
        bf16_t* op = T.O + (rowbase + qabs) * T.ldo + 4 * hi;
#pragma unroll
        for (int d = 0; d < DV / 32; ++d)
#pragma unroll
            for (int g4 = 0; g4 < 4; ++g4) { u32x2 w; w.x = cvtpk(o[d][4 * g4] * inv, o[d][4 * g4 + 1] * inv); w.y = cvtpk(o[d][4 * g4 + 2] * inv, o[d][4 * g4 + 3] * inv); *(u32x2*)(op + 32 * d + 8 * g4) = w; }
    }
}
}
constexpr int NWAVES = 8, NTHREADS = 512;
constexpr size_t MiB = 1u << 20;
constexpr size_t WS_CTL = 0, CTL_ZERO_BYTES = 1 * MiB;
constexpr size_t WS_SMALLW = 1 * MiB;
constexpr size_t SW_LAYER = 8 * MiB, SW_WOUT = 4608 * 1024, SW_WQB = SW_WOUT + 2 * MiB, SW_WKVB = SW_WQB + 384 * 1024;
static_assert(SW_WKVB + 512 * 1024 <= SW_LAYER, "small weights");
constexpr size_t WS_WR = WS_SMALLW + 4 * SW_LAYER;
constexpr size_t WS_ROPE = WS_WR + 4 * MiB;
constexpr size_t WS_KMEAN = WS_ROPE + 8 * MiB;
constexpr size_t WS_WGU = WS_KMEAN + 1 * MiB;
constexpr size_t WS_WD = WS_WGU + 65 * MiB;
constexpr size_t WS_ROWTOK = WS_WD + 33 * MiB;
constexpr size_t WS_WSLOT = WS_ROWTOK + 8 * MiB;
constexpr size_t WS_TOKE = WS_WSLOT + 8 * MiB;
constexpr size_t WS_TOKP = WS_TOKE + 1 * MiB;
constexpr size_t WS_XF = WS_TOKP + 1 * MiB;
constexpr size_t WS_HS = WS_XF + 128 * MiB;
constexpr size_t WS_YS = WS_HS + 152 * MiB;
constexpr size_t WS_END = WS_YS + 544 * MiB;
static_assert(WS_END <= 1024 * MiB, "workspace map exceeds 1 GiB");
constexpr size_t A_HB = WS_YS;
constexpr size_t A_QF = A_HB, A_KVF = A_HB + 48 * MiB;
constexpr size_t A_SSQ = A_HB;
constexpr size_t A_Q1 = A_HB + 144 * MiB;
constexpr size_t A_K1 = A_Q1 + 32 * MiB;
constexpr size_t A_V1 = A_K1 + 32 * MiB;
constexpr size_t A_X1 = A_V1 + 32 * MiB;
constexpr size_t A_X2 = A_X1 + 32 * MiB;
constexpr size_t A_Q2 = A_X2 + 32 * MiB;
constexpr size_t A_OB = A_Q2 + 128 * MiB;
static_assert(A_OB + 64 * MiB <= WS_END, "attention overlay");
constexpr size_t A_XS = WS_YS;
constexpr size_t A_LOG = WS_YS + 128 * MiB;
constexpr int CW_BAR = 4096;
constexpr int CW_CNT = 16384;
constexpr int RING_BYTES = 131072;
constexpr int LX_BAR = RING_BYTES;
constexpr int LX_CNT = RING_BYTES + 64;
constexpr int LX_TST = LX_CNT + 256;
constexpr int LX_TEXP = LX_TST + 320;
constexpr int LDS_BYTES = 147456;
static_assert(LX_TEXP + 1280 <= LDS_BYTES, "LDS map");

#define XB_TMO      128
#define XB_XCNT(j)  (256  + 64 * (j))
#define XB_XSUB(j)  (1280 + 64 * (j))
#define XB_XGEN(j)  (2304 + 64 * (j))
#define XB_TOP      3328
#define XB_TOPGEN   3392
#define XCD_BAR_WORDS 3456
#define XB_SPIN_CAP (1u << 20)
__device__ __forceinline__ unsigned xb_ld(unsigned* p)              { return __hip_atomic_load(p, __ATOMIC_RELAXED, __HIP_MEMORY_SCOPE_AGENT); }
__device__ __forceinline__ unsigned xb_add(unsigned* p, unsigned v) { return __hip_atomic_fetch_add(p, v, __ATOMIC_RELAXED, __HIP_MEMORY_SCOPE_AGENT); }
__device__ __forceinline__ unsigned xb_xcc_id() { return (unsigned)__builtin_amdgcn_s_getreg((3 << 11) | 20) & 0xFu; }
#define XB_SPIN(cond, bar) do { unsigned _sp = 0; while (cond) { __builtin_amdgcn_s_sleep(1); \
    if ((++_sp & 255u) == 0u) { if (xb_ld(&(bar)[XB_TMO])) break; if (_sp > XB_SPIN_CAP) { atomicAdd(&(bar)[XB_TMO], 1u); break; } } } } while (0)
struct XcdBarrier { unsigned* bar; unsigned x; volatile LAS unsigned* st; };
__device__ __forceinline__ XcdBarrier xcd_barrier_post(unsigned* bar, volatile LAS unsigned* st) {
    XcdBarrier b; b.bar = bar; b.x = xb_xcc_id(); b.st = st;
    if (threadIdx.x == 0) (void)xb_add(&bar[XB_XCNT(b.x)], 1u);
    return b;
}
__device__ __forceinline__ void xcd_barrier_complete(unsigned* bar, unsigned x, unsigned& nloc, unsigned& nx) {
    const unsigned G = gridDim.x * gridDim.y * gridDim.z;
    unsigned sum, cnt, mine, sp = 0u;
    for (;;) {
        sum = 0u; cnt = 0u; mine = 0u;
#pragma unroll
        for (unsigned j = 0; j < 16; ++j) { const unsigned c = xb_ld(&bar[XB_XCNT(j)]); sum += c; cnt += (c > 0u) ? 1u : 0u; mine = (j == x) ? c : mine; }
        if (sum == G) break;
        __builtin_amdgcn_s_sleep(1);
        if ((++sp & 255u) == 0u) { if (xb_ld(&bar[XB_TMO])) break; if (sp > XB_SPIN_CAP) { atomicAdd(&bar[XB_TMO], 1u); break; } }
    }
    nloc = mine > 0u ? mine : 1u; nx = cnt > 0u ? cnt : 1u;
}
__device__ __forceinline__ void xcd_barrier(const XcdBarrier& b, const bool leader) {
    asm volatile("s_waitcnt vmcnt(0)" ::: "memory");
    __syncthreads();
    if (leader) {
        unsigned* bar = b.bar; const unsigned bx = xb_xcc_id();
        __builtin_amdgcn_s_waitcnt(0);
        unsigned nloc = b.st[0], nx = b.st[1];
        if (nloc == 0u) { xcd_barrier_complete(bar, bx, nloc, nx); b.st[0] = nloc; b.st[1] = nx; }
        const unsigned old = xb_add(&bar[XB_XSUB(bx)], 1u);
        const unsigned gen = old / nloc;
        if (old + 1u == (gen + 1u) * nloc) {
            __builtin_amdgcn_fence(__ATOMIC_RELEASE, "agent");
            asm volatile("s_waitcnt vmcnt(0)" ::: "memory");
            const unsigned og = xb_add(&bar[XB_TOP], 1u);
            const unsigned tg = og / nx;
            if (og + 1u == (tg + 1u) * nx) xb_add(&bar[XB_TOPGEN], 1u);
            else XB_SPIN(xb_ld(&bar[XB_TOPGEN]) == tg, bar);
            __builtin_amdgcn_fence(__ATOMIC_ACQUIRE, "agent");
            xb_add(&bar[XB_XGEN(bx)], 1u);
            asm volatile("s_waitcnt vmcnt(0)" ::: "memory");
        } else {
            XB_SPIN(xb_ld(&bar[XB_XGEN(bx)]) == gen, bar);
            __builtin_amdgcn_fence(__ATOMIC_ACQUIRE, "agent");
            asm volatile("s_waitcnt vmcnt(0)" ::: "memory");
        }
    }
    __syncthreads();
}

struct Args {
    const float* x; const int* pos;
    const float *ev_w_in, *ev_w_out, *mla_g_qa, *mla_w_qb, *mla_g_kva, *mla_w_kvb, *od_w_in, *od_w_out, *swa_sinks, *diff_lambda, *diff_g_subln, *ln_g, *ln_b,
                *moe_w_router, *moe_bias, *moe_w_gate, *moe_w_up, *moe_w_down, *sh_w_gate, *sh_w_up, *sh_w_down;
    float* out; unsigned char* ws;
    int st_lo, st_hi, use_bar, pad;
};

__device__ __forceinline__ int wrow_map(int mode, int n);
__device__ __forceinline__ void transpose_item(const float* W, int N, int k0, int n0, bf16_t* WT, int ldk, int dst_row0, LAS float* scr, int lane, int mode = 0) {
#pragma unroll 8
    for (int i = 0; i < 32; ++i) { const int kk = 2 * i + (lane >> 5); scr[kk * 33 + (lane & 31)] = W[(size_t)(k0 + kk) * N + n0 + (lane & 31)]; }
    asm volatile("s_waitcnt lgkmcnt(0)" ::: "memory");
    const int c = lane & 7;
#pragma unroll
    for (int j = 0; j < 4; ++j) { const int n = (lane >> 3) + 8 * j; const LAS float* s = scr + (8 * c) * 33 + n;
        u32x4 o; o.x = pk2(s[0 * 33], s[1 * 33]); o.y = pk2(s[2 * 33], s[3 * 33]); o.z = pk2(s[4 * 33], s[5 * 33]); o.w = pk2(s[6 * 33], s[7 * 33]);
        const int drow = mode ? wrow_map(mode, n0 + n) : dst_row0 + n;
        *(u32x4*)(WT + (size_t)drow * ldk + k0 + 8 * c) = o; }
    asm volatile("s_waitcnt lgkmcnt(0)" ::: "memory");
}
__device__ __forceinline__ void sincos_acc(float angf, float& c, float& s) {
    const double x = (double)angf;
    const double n = __builtin_rint(x * 0.63661977236758134308);
    double r = x - n * 1.57079632679489655800; r -= n * 6.12323399573676603587e-17;
    const long q = (long)n;
    const double r2 = r * r;
    double sp = -2.5052108385441718775e-08; sp = sp * r2 + 2.7557319223985890653e-06; sp = sp * r2 - 1.9841269841269841270e-04; sp = sp * r2 + 8.3333333333333333333e-03; sp = sp * r2 - 1.6666666666666666667e-01;
    const double sn = r + r * r2 * sp;
    double cp = 2.0876756987868098979e-09; cp = cp * r2 - 2.7557319223985890653e-07; cp = cp * r2 + 2.4801587301587301587e-05; cp = cp * r2 - 1.3888888888888888889e-03; cp = cp * r2 + 4.1666666666666666667e-02; cp = cp * r2 - 0.5;
    const double cs = 1.0 + r2 * cp;
    double so, co;
    switch ((int)(q & 3)) { case 0: so = sn; co = cs; break; case 1: so = cs; co = -sn; break; case 2: so = -sn; co = -cs; break; default: so = -cs; co = sn; break; }
    s = (float)so; c = (float)co;
}
__host__ __device__ __forceinline__ int perm64(int f) { const int n = f >> 5, r = f & 31, G = r >> 4, fq = (r & 15) >> 2, i = r & 3; return 32 * G + 8 * fq + 4 * n + i; }
__host__ __device__ __forceinline__ int perm_pe(int f) { const int n = f >> 4, r = f & 15, fq = r >> 2, i = r & 3; return 8 * fq + 4 * n + i; }
__device__ __forceinline__ int wrow_map(int mode, int n) {
    if (mode == 1) { if (n < 1024) return (n & ~63) + perm64(n & 63); if (n >= 1920) return 1920 + perm_pe(n - 1920); return n; }
    if (mode == 2) { if (n < 640 || (n >= 768 && n < 1792)) return (n & ~63) + perm64(n & 63); return n; }
    if (mode == 3) { const int h = n / 96, w = n - 96 * h; return w < 64 ? n : 96 * h + 64 + perm_pe(w - 64); }
    return n;
}
constexpr float QS_64 = 0.125f * LOG2E;
constexpr float QS_96 = 0.10206207261596577f * LOG2E;

__device__ __forceinline__ u32x2 pack4(float a, float b, float c, float d) { u32x2 w; w.x = pg8::cvt_pk_bf16(a, b); w.y = pg8::cvt_pk_bf16(c, d); return w; }
__device__ __forceinline__ u32x4 pack8(const f32x4& v0, const f32x4& v1) { u32x4 w; w.x = pg8::cvt_pk_bf16(v0[0], v0[1]); w.y = pg8::cvt_pk_bf16(v0[2], v0[3]); w.z = pg8::cvt_pk_bf16(v1[0], v1[1]); w.w = pg8::cvt_pk_bf16(v1[2], v1[3]); return w; }

struct EpiWin {
    static constexpr bool PERM = true;
    unsigned char* ws; int even; const float* g_qa; const float* g_kva;
    __device__ __forceinline__ void rope_half(const f32x4 (&acc)[2][2][4][2], int bj, const pg8::Unit& u, int rowl, int wr, int wc, int fr, int fq, bf16_t* dst, int ld, int head0, float sc, bool km) const {
        const f32x2* rope = (const f32x2*)(ws + WS_ROPE);
        const int head = head0 + (wc >> 1), G = wc & 1, f0 = 16 * G + 4 * fq;
        float s1[4] = {0.f, 0.f, 0.f, 0.f}, s2[4] = {0.f, 0.f, 0.f, 0.f};
#pragma unroll
        for (int ai = 0; ai < 2; ++ai)
#pragma unroll
            for (int m = 0; m < 4; ++m) { const size_t r = (size_t)(u.orow + rowl + ai * 128 + m * 16);
                const f32x4 c01 = *(const f32x4*)(rope + r * 32 + f0), c23 = *(const f32x4*)(rope + r * 32 + f0 + 2);
                const f32x4 x1 = acc[ai][bj][m][0], x2 = acc[ai][bj][m][1];
                float o1[4], o2[4];
                o1[0] = x1[0] * c01[0] - x2[0] * c01[1]; o2[0] = x2[0] * c01[0] + x1[0] * c01[1];
                o1[1] = x1[1] * c01[2] - x2[1] * c01[3]; o2[1] = x2[1] * c01[2] + x1[1] * c01[3];
                o1[2] = x1[2] * c23[0] - x2[2] * c23[1]; o2[2] = x2[2] * c23[0] + x1[2] * c23[1];
                o1[3] = x1[3] * c23[2] - x2[3] * c23[3]; o2[3] = x2[3] * c23[2] + x1[3] * c23[3];
                bf16_t* dp = dst + r * ld + 64 * head + f0;
                *(u32x2*)dp = pack4(o1[0] * sc, o1[1] * sc, o1[2] * sc, o1[3] * sc); *(u32x2*)(dp + 32) = pack4(o2[0] * sc, o2[1] * sc, o2[2] * sc, o2[3] * sc);
                if (km) {
#pragma unroll
                    for (int i = 0; i < 4; ++i) { s1[i] += o1[i]; s2[i] += o2[i]; } } }
        if (km) {
#pragma unroll
            for (int i = 0; i < 4; ++i) {
#pragma unroll
                for (int o = 1; o < 16; o <<= 1) { s1[i] += __shfl_xor(s1[i], o); s2[i] += __shfl_xor(s2[i], o); } }
            if (fr == 0) { const int t = u.orow >> 8, b = t >> 4, j = t & 15; float* kp = (float*)(ws + WS_KMEAN) + ((((size_t)b * 8 + head) * 16 + j) * 2 + wr) * 64 + f0;
                *(f32x4*)kp = (f32x4){s1[0], s1[1], s1[2], s1[3]}; *(f32x4*)(kp + 32) = (f32x4){s2[0], s2[1], s2[2], s2[3]}; }
        }
    }
    __device__ __forceinline__ void plain_half(const f32x4 (&acc)[2][2][4][2], int bj, const pg8::Unit& u, int rowl, int wc, int fq, bf16_t* dst, int ld) const {
#pragma unroll
        for (int ai = 0; ai < 2; ++ai)
#pragma unroll
            for (int m = 0; m < 4; ++m) { const size_t r = (size_t)(u.orow + rowl + ai * 128 + m * 16); *(u32x4*)(dst + r * ld + 32 * wc + 8 * fq) = pack8(acc[ai][bj][m][0], acc[ai][bj][m][1]); }
    }
    __device__ __forceinline__ void lat_half(const f32x4 (&acc)[2][2][4][2], int bj, const pg8::Unit& u, int rowl, int wc, int fq, bf16_t* dst, int col0, const float* g, float* ssq, int nparts, int part) const {
        const int c = col0 + 32 * wc + 8 * fq; const f32x4 g0 = *(const f32x4*)(g + c), g1 = *(const f32x4*)(g + c + 4);
#pragma unroll
        for (int ai = 0; ai < 2; ++ai)
#pragma unroll
            for (int m = 0; m < 4; ++m) { const size_t r = (size_t)(u.orow + rowl + ai * 128 + m * 16); const f32x4 x0 = acc[ai][bj][m][0], x1 = acc[ai][bj][m][1];
                float ss = (x0[0] * x0[0] + x0[1] * x0[1]) + (x0[2] * x0[2] + x0[3] * x0[3]) + (x1[0] * x1[0] + x1[1] * x1[1]) + (x1[2] * x1[2] + x1[3] * x1[3]);
                ss += __shfl_xor(ss, 16); ss += __shfl_xor(ss, 32);
                *(u32x4*)(dst + r * 256 + c) = pack8(x0 * g0, x1 * g1);
                if (fq == 0) ssq[r * nparts + part] = ss; }
    }
    __device__ __forceinline__ void operator()(const f32x4 (&acc)[2][2][4][2], const pg8::Unit& u, int wr, int wc, int fr, int fq) const {
        const int rowl = wr * 64 + fr;
#pragma unroll
        for (int bj = 0; bj < 2; ++bj) {
            const int hk = (u.ocol >> 7) + bj;
            if (even) {
                if (hk < 4) rope_half(acc, bj, u, rowl, wr, wc, fr, fq, (bf16_t*)(ws + A_Q1), 512, 2 * hk, QS_64, false);
                else if (hk < 8) rope_half(acc, bj, u, rowl, wr, wc, fr, fq, (bf16_t*)(ws + A_K1), 512, 2 * (hk - 4), 1.0f, true);
                else if (hk < 12) plain_half(acc, bj, u, rowl, wc, fq, (bf16_t*)(ws + A_V1) + 128 * (hk - 8), 512);
                else if (hk < 14) lat_half(acc, bj, u, rowl, wc, fq, (bf16_t*)(ws + A_X1), 128 * (hk - 12), g_qa, (float*)(ws + A_SSQ), 8, 4 * (hk - 12) + wc);
                else if (hk == 14) lat_half(acc, bj, u, rowl, wc, fq, (bf16_t*)(ws + A_X1 + 16 * MiB), 0, g_kva, (float*)(ws + A_SSQ + 1 * MiB), 4, wc);
                else {
                    bf16_t* kvlat = (bf16_t*)(ws + A_X1 + 16 * MiB); bf16_t* Kb = (bf16_t*)(ws + A_Q2 + 48 * MiB); const f32x2* rope = (const f32x2*)(ws + WS_ROPE);
                    unsigned z0 = 0u; asm volatile("" : "+v"(z0));
#pragma unroll
                    for (int ai = 0; ai < 2; ++ai)
#pragma unroll
                        for (int m = 0; m < 4; ++m) { const size_t r = (size_t)(u.orow + rowl + ai * 128 + m * 16);
                            *(u32x4*)(kvlat + r * 256 + 128 + 32 * wc + 8 * fq) = (u32x4){z0, z0, z0, z0};
                            if (wc == 0) { const f32x4 x1 = acc[ai][bj][m][0], x2 = acc[ai][bj][m][1]; const f32x2* rt = rope + r * 32 + 8 * fq;
                                const f32x2 c0 = rt[0], c1 = rt[2], c2 = rt[4], c3 = rt[6];
                                const u32x2 w1 = pack4(x1[0] * c0.x - x2[0] * c0.y, x1[1] * c1.x - x2[1] * c1.y, x1[2] * c2.x - x2[2] * c2.y, x1[3] * c3.x - x2[3] * c3.y);
                                const u32x2 w2 = pack4(x2[0] * c0.x + x1[0] * c0.y, x2[1] * c1.x + x1[1] * c1.y, x2[2] * c2.x + x1[2] * c2.y, x2[3] * c3.x + x1[3] * c3.y);
#pragma unroll
                                for (int hh = 0; hh < 8; ++hh) { bf16_t* kp = Kb + r * 768 + 96 * hh + 64 + 4 * fq; *(u32x2*)kp = w1; *(u32x2*)(kp + 16) = w2; } } }
                }
            } else {
                if (hk < 4) rope_half(acc, bj, u, rowl, wr, wc, fr, fq, (bf16_t*)(ws + A_Q1), 512, 2 * hk, QS_64, false);
                else if (hk == 4) rope_half(acc, bj, u, rowl, wr, wc, fr, fq, (bf16_t*)(ws + A_K1), 128, 0, 1.0f, false);
                else if (hk == 5) plain_half(acc, bj, u, rowl, wc, fq, (bf16_t*)(ws + A_K1 + 8 * MiB), 128);
                else if (hk < 10) rope_half(acc, bj, u, rowl, wr, wc, fr, fq, (bf16_t*)(ws + A_V1), 512, 2 * (hk - 6), QS_64, false);
                else if (hk < 14) rope_half(acc, bj, u, rowl, wr, wc, fr, fq, (bf16_t*)(ws + A_X1), 512, 2 * (hk - 10), 1.0f, false);
                else plain_half(acc, bj, u, rowl, wc, fq, (bf16_t*)(ws + A_X2) + 128 * (hk - 14), 512);
            }
        }
    }
};
struct EpiMlaQ {
    static constexpr bool PERM = true;
    unsigned char* ws;
    __device__ __forceinline__ void operator()(const f32x4 (&acc)[2][2][4][2], const pg8::Unit& u, int wr, int wc, int fr, int fq) const {
        const int rowl = wr * 64 + fr; bf16_t* Qb = (bf16_t*)(ws + A_Q2); const float* ssq = (const float*)(ws + A_SSQ); const f32x2* rope = (const f32x2*)(ws + WS_ROPE);
#pragma unroll
        for (int ai = 0; ai < 2; ++ai)
#pragma unroll
            for (int m = 0; m < 4; ++m) { const size_t r = (size_t)(u.orow + rowl + ai * 128 + m * 16);
                const f32x4 q0 = *(const f32x4*)(ssq + r * 8), q1 = *(const f32x4*)(ssq + r * 8 + 4);
                const float rr = QS_96 / sqrtf(((q0[0] + q0[1]) + (q0[2] + q0[3]) + (q1[0] + q1[1]) + (q1[2] + q1[3])) * (1.0f / 256.0f) + 1e-6f);
#pragma unroll
                for (int bj = 0; bj < 2; ++bj) { const int gidx = (u.ocol >> 5) + 4 * bj + wc, head = gidx / 3, part = gidx - 3 * head;
                    const f32x4 x1 = acc[ai][bj][m][0] * rr, x2 = acc[ai][bj][m][1] * rr;
                    if (part < 2) *(u32x4*)(Qb + r * 768 + 96 * head + 32 * part + 8 * fq) = pack8(x1, x2);
                    else { const f32x2* rt = rope + r * 32 + 8 * fq; const f32x2 c0 = rt[0], c1 = rt[2], c2 = rt[4], c3 = rt[6]; bf16_t* qp = Qb + r * 768 + 96 * head + 64 + 4 * fq;
                        *(u32x2*)qp = pack4(x1[0] * c0.x - x2[0] * c0.y, x1[1] * c1.x - x2[1] * c1.y, x1[2] * c2.x - x2[2] * c2.y, x1[3] * c3.x - x2[3] * c3.y);
                        *(u32x2*)(qp + 16) = pack4(x2[0] * c0.x + x1[0] * c0.y, x2[1] * c1.x + x1[1] * c1.y, x2[2] * c2.x + x1[2] * c2.y, x2[3] * c3.x + x1[3] * c3.y); } } }
    }
};
struct EpiMlaKV {
    static constexpr bool PERM = true;
    unsigned char* ws;
    __device__ __forceinline__ void operator()(const f32x4 (&acc)[2][2][4][2], const pg8::Unit& u, int wr, int wc, int fr, int fq) const {
        const int rowl = wr * 64 + fr; bf16_t* Kb = (bf16_t*)(ws + A_Q2 + 48 * MiB); bf16_t* Vb = (bf16_t*)(ws + A_Q2 + 96 * MiB); const float* ssq = (const float*)(ws + A_SSQ + 1 * MiB);
#pragma unroll
        for (int ai = 0; ai < 2; ++ai)
#pragma unroll
            for (int m = 0; m < 4; ++m) { const size_t r = (size_t)(u.orow + rowl + ai * 128 + m * 16);
                const f32x4 q0 = *(const f32x4*)(ssq + r * 4);
                const float rr = 1.0f / sqrtf(((q0[0] + q0[1]) + (q0[2] + q0[3])) * (1.0f / 128.0f) + 1e-6f);
#pragma unroll
                for (int bj = 0; bj < 2; ++bj) { const int gidx = (u.ocol >> 5) + 4 * bj + wc, head = gidx >> 2, part = gidx & 3;
                    const u32x4 w = pack8(acc[ai][bj][m][0] * rr, acc[ai][bj][m][1] * rr);
                    if (part < 2) *(u32x4*)(Kb + r * 768 + 96 * head + 32 * part + 8 * fq) = w; else *(u32x4*)(Vb + r * 512 + 64 * head + 32 * (part - 2) + 8 * fq) = w; } }
    }
};

constexpr float YS_SCALE = 64.0f;
__device__ __forceinline__ unsigned pk_fp8x4(float a, float b, float c, float d) {
    a = fminf(fmaxf(a, -440.f), 440.f); b = fminf(fmaxf(b, -440.f), 440.f); c = fminf(fmaxf(c, -440.f), 440.f); d = fminf(fmaxf(d, -440.f), 440.f);
    int w = __builtin_amdgcn_cvt_pk_fp8_f32(a, b, 0, false); w = __builtin_amdgcn_cvt_pk_fp8_f32(c, d, w, true); return (unsigned)w; }
struct EpiDownAll {
    static constexpr bool PERM = true;
    unsigned char* ws;
    __device__ __forceinline__ void operator()(const f32x4 (&acc)[2][2][4][2], const pg8::Unit& u, int wr, int wc, int fr, int fq) const {
        const int rowl = wr * 64 + fr, c0 = u.ocol + 32 * wc + 8 * fq;
        if (u.e == 64) { float* xf = (float*)(ws + WS_XF);
#pragma unroll
            for (int ai = 0; ai < 2; ++ai)
#pragma unroll
                for (int m = 0; m < 4; ++m) { float* rp = xf + (size_t)(u.lt * 256 + rowl + ai * 128 + m * 16) * DM + c0;
#pragma unroll
                    for (int bj = 0; bj < 2; ++bj) { const f32x4 s0 = *(const f32x4*)(rp + bj * 128), s1 = *(const f32x4*)(rp + bj * 128 + 4);
                        *(f32x4*)(rp + bj * 128) = s0 * DN_ALPHA + acc[ai][bj][m][0]; *(f32x4*)(rp + bj * 128 + 4) = s1 * DN_ALPHA + acc[ai][bj][m][1]; } }
        } else { unsigned char* Y8 = ws + WS_YS;
#pragma unroll
            for (int ai = 0; ai < 2; ++ai)
#pragma unroll
                for (int m = 0; m < 4; ++m) { unsigned char* rp = Y8 + (size_t)(u.orow + rowl + ai * 128 + m * 16) * DM + c0;
#pragma unroll
                    for (int bj = 0; bj < 2; ++bj) { const f32x4 v0 = acc[ai][bj][m][0] * YS_SCALE, v1 = acc[ai][bj][m][1] * YS_SCALE;
                        u32x2 w; w.x = pk_fp8x4(v0[0], v0[1], v0[2], v0[3]); w.y = pk_fp8x4(v1[0], v1[1], v1[2], v1[3]); *(u32x2*)(rp + bj * 128) = w; } }
        }
    }
};
struct Ctx {
    LAS unsigned char* lds; unsigned char* ws; int tid, lane, wave, G, bid, gw, NGW;
};
#define WSP(T, off) ((T*)(C.ws + (off)))

__device__ __forceinline__ void phase_convert(const Ctx& C, const Args& a, int L) {
    LAS float* scr = (LAS float*)(C.lds + C.wave * 16384);
    {
        constexpr int IT_G = (1024 / 64) * (256 / 32);
        constexpr int IT_D = (256 / 64) * (1024 / 32);
        const int total = 65 * (2 * IT_G + IT_D);
        bf16_t* Wgu = WSP(bf16_t, WS_WGU); bf16_t* Wd = WSP(bf16_t, WS_WD);
        for (int it = C.gw; it < total; it += C.NGW) {
            const int e = it / (2 * IT_G + IT_D); int r = it % (2 * IT_G + IT_D);
            if (r < 2 * IT_G) {
                const int up = r >= IT_G; if (up) r -= IT_G;
                const float* W = e < 64 ? (up ? a.moe_w_up : a.moe_w_gate) + ((size_t)L * 64 + e) * 1024 * 256 : (up ? a.sh_w_up : a.sh_w_gate) + (size_t)L * 1024 * 256;
                const int kb = r / 8, nb = r % 8, n0 = nb * 32;
                transpose_item(W, 256, kb * 64, n0, Wgu + (size_t)e * 512 * 1024, 1024, (n0 >> 7) * 256 + up * 128 + (n0 & 127), scr, C.lane);
            } else {
                r -= 2 * IT_G;
                const float* W = e < 64 ? a.moe_w_down + ((size_t)L * 64 + e) * 256 * 1024 : a.sh_w_down + (size_t)L * 256 * 1024;
                const int kb = r / 32, nb = r % 32, n0 = nb * 32;
                transpose_item(W, 1024, kb * 64, n0, Wd + (size_t)e * 1024 * 256, 256, n0, scr, C.lane);
            }
        }
    }
}
__device__ __forceinline__ void phase_init(const Ctx& C, const Args& a) {
    LAS float* scr = (LAS float*)(C.lds + C.wave * 16384);
    for (int l = 0; l < DEPTH; ++l) {
        const int i = l >> 1; const bool even = !(l & 1);
        bf16_t* Win = WSP(bf16_t, WS_SMALLW + l * SW_LAYER); bf16_t* Wout = WSP(bf16_t, WS_SMALLW + l * SW_LAYER + SW_WOUT);
        const int nin = even ? EV_IN : OD_IN;
        const float* win = even ? a.ev_w_in + (size_t)i * 1024 * EV_IN : a.od_w_in + (size_t)i * 1024 * OD_IN;
        const float* wout = even ? a.ev_w_out + (size_t)i * 1024 * 1024 : a.od_w_out + (size_t)i * 1024 * 1024;
        const int it_in = 16 * (nin / 32), it_out = 16 * 32;
        for (int it = C.gw; it < it_in + it_out; it += C.NGW) {
            if (it < it_in) { const int kb = it / (nin / 32), nb = it % (nin / 32); transpose_item(win, nin, kb * 64, nb * 32, Win, 1024, nb * 32, scr, C.lane, even ? 1 : 2); }
            else { const int r = it - it_in, kb = r / 32, nb = r % 32; transpose_item(wout, 1024, kb * 64, nb * 32, Wout, 1024, nb * 32, scr, C.lane); }
        }
        if (even) {
            for (int idx = C.bid * NTHREADS + C.tid; idx < (2048 - EV_IN) * 1024 / 8; idx += C.G * NTHREADS) *(u32x4*)(Win + (size_t)EV_IN * 1024 + (size_t)idx * 8) = (u32x4){0u, 0u, 0u, 0u};
            bf16_t* Wqb = WSP(bf16_t, WS_SMALLW + l * SW_LAYER + SW_WQB); bf16_t* Wkvb = WSP(bf16_t, WS_SMALLW + l * SW_LAYER + SW_WKVB);
            const float* wqb = a.mla_w_qb + (size_t)i * 256 * 768; const float* wkvb = a.mla_w_kvb + (size_t)i * 128 * 1024;
            const int it_q = 4 * 24, it_kv = 2 * 32;
            for (int it = C.gw; it < it_q + it_kv; it += C.NGW) {
                if (it < it_q) { const int kb = it / 24, nb = it % 24; transpose_item(wqb, 768, kb * 64, nb * 32, Wqb, 256, nb * 32, scr, C.lane, 3); }
                else { const int r = it - it_q, kb = r / 32, nb = r % 32; transpose_item(wkvb, 1024, kb * 64, nb * 32, Wkvb, 256, nb * 32, scr, C.lane); }
            }
            for (int idx = C.bid * NTHREADS + C.tid; idx < 1024 * 16; idx += C.G * NTHREADS) { const int row = idx >> 4, ch = idx & 15; *(u32x4*)(Wkvb + (size_t)row * 256 + 128 + ch * 8) = (u32x4){0u, 0u, 0u, 0u}; }
        }
        bf16_t* Wr = WSP(bf16_t, WS_WR + (size_t)l * MiB); const float* wr = a.moe_w_router + (size_t)l * 1024 * 64;
        for (int idx = C.bid * NTHREADS + C.tid; idx < 256 * 2048; idx += C.G * NTHREADS) {
            const int n = idx >> 11, k = idx & 2047; unsigned v = 0;
            if (n < 128) { const int e = n & 63, kk = k & 1023; const float w = wr[(size_t)kk * 64 + e]; const unsigned wh = f2bf(w);
                if (n < 64) v = wh; else if (k < 1024) v = f2bf(w - bf2f(wh)); }
            Wr[idx] = (bf16_t)v;
        }
    }
    { f32x2* rope = WSP(f32x2, WS_ROPE);
      for (int idx = C.bid * NTHREADS + C.tid; idx < NTOK * 32; idx += C.G * NTHREADS) { const int tok = idx >> 5, j = idx & 31;
          const float inv = (float)exp2(-(double)j * (13.287712379549449 / 32.0));
          const float ang = (float)a.pos[tok] * inv; float cs, sn; sincos_acc(ang, cs, sn); rope[idx] = (f32x2){cs, sn}; } }
    { bf16_t* xb = WSP(bf16_t, WS_HS);
      for (size_t idx = (size_t)C.bid * NTHREADS + C.tid; idx < (size_t)NTOK * DM / 8; idx += (size_t)C.G * NTHREADS) { const f32x4 v0 = *(const f32x4*)(a.x + idx * 8), v1 = *(const f32x4*)(a.x + idx * 8 + 4);
          u32x4 o; o.x = pk2(v0[0], v0[1]); o.y = pk2(v0[2], v0[3]); o.z = pk2(v1[0], v1[1]); o.w = pk2(v1[2], v1[3]); *(u32x4*)(xb + idx * 8) = o; } }
}

template <int HW>
__device__ __forceinline__ void rope_heads(const bf16_t* src, bf16_t* dst, int nh, const f32x2* rope_tok, float scale, int lane) {
    const int npairs = nh * HW;
    for (int p = lane; p < npairs; p += 64) { const int hh = p / HW, i = p % HW;
        const float x1 = bf2f(src[hh * 2 * HW + i]), x2 = bf2f(src[hh * 2 * HW + i + HW]); const f32x2 cs = rope_tok[i * (32 / HW)];
        dst[hh * 2 * HW + i] = (bf16_t)f2bf((x1 * cs.x - x2 * cs.y) * scale); dst[hh * 2 * HW + i + HW] = (bf16_t)f2bf((x2 * cs.x + x1 * cs.y) * scale); }
}
__device__ __forceinline__ void copy_cols(const bf16_t* src, bf16_t* dst, int n, int lane) { for (int c = lane; c < n / 8; c += 64) *(u32x4*)(dst + c * 8) = *(const u32x4*)(src + c * 8); }

__device__ __forceinline__ void phase_prep_even(const Ctx& C, const Args& a, int i) {
    const bf16_t* hb = WSP(bf16_t, A_HB); const f32x2* rope = WSP(f32x2, WS_ROPE);
    bf16_t *Qa = WSP(bf16_t, A_Q1), *Ka = WSP(bf16_t, A_K1), *Va = WSP(bf16_t, A_V1), *qlat = WSP(bf16_t, A_X1), *kvlat = WSP(bf16_t, A_X1 + 16 * MiB), *kpe = WSP(bf16_t, A_X2);
    const float* gqa = a.mla_g_qa + i * 256; const float* gkva = a.mla_g_kva + i * 128;
    const float sc = 0.125f * LOG2E;
    for (int tok = C.gw; tok < NTOK; tok += C.NGW) {
        const bf16_t* h = hb + (size_t)tok * HB_LD; const f32x2* rt = rope + (size_t)tok * 32;
        rope_heads<32>(h, Qa + (size_t)tok * 512, 8, rt, sc, C.lane);
        rope_heads<32>(h + 512, Ka + (size_t)tok * 512, 8, rt, 1.0f, C.lane);
        copy_cols(h + 1024, Va + (size_t)tok * 512, 512, C.lane);
        { float v[4]; float ss = 0.f;
#pragma unroll
          for (int j = 0; j < 4; ++j) { v[j] = bf2f(h[1536 + C.lane + 64 * j]); ss += v[j] * v[j]; }
          const float r = 1.0f / sqrtf(wave_sum(ss) * (1.0f / 256.0f) + 1e-6f);
#pragma unroll
          for (int j = 0; j < 4; ++j) qlat[(size_t)tok * 256 + C.lane + 64 * j] = (bf16_t)f2bf(v[j] * r * gqa[C.lane + 64 * j]); }
        { float v[2]; float ss = 0.f;
#pragma unroll
          for (int j = 0; j < 2; ++j) { v[j] = bf2f(h[1792 + C.lane + 64 * j]); ss += v[j] * v[j]; }
          const float r = 1.0f / sqrtf(wave_sum(ss) * (1.0f / 128.0f) + 1e-6f);
#pragma unroll
          for (int j = 0; j < 2; ++j) { kvlat[(size_t)tok * 256 + C.lane + 64 * j] = (bf16_t)f2bf(v[j] * r * gkva[C.lane + 64 * j]); kvlat[(size_t)tok * 256 + 128 + C.lane + 64 * j] = 0; } }
        rope_heads<16>(h + 1920, kpe + (size_t)tok * 32, 1, rt, 1.0f, C.lane);
    }
}
__device__ __forceinline__ void phase_kmean(const Ctx& C) {
    const bf16_t* Ka = WSP(bf16_t, A_K1); float* km = WSP(float, WS_KMEAN);
    for (int idx = C.bid * NTHREADS + C.tid; idx < NBATCH * 16 * 512; idx += C.G * NTHREADS) {
        const int c = idx & 511, bj = idx >> 9, b = bj >> 4, j = bj & 15; const bf16_t* p = Ka + ((size_t)b * SEQ + j * 256) * 512 + c;
        float s = 0.f;
        for (int r = 0; r < 256; ++r) s += bf2f(p[(size_t)r * 512]);
        km[(((size_t)b * 8 + (c >> 6)) * 16 + j) * 64 + (c & 63)] = s * (1.0f / 256.0f);
    }
}
__device__ __forceinline__ void phase_prep_mla(const Ctx& C) {
    const bf16_t *qf = WSP(bf16_t, A_QF), *kvf = WSP(bf16_t, A_KVF), *kpe = WSP(bf16_t, A_X2); const f32x2* rope = WSP(f32x2, WS_ROPE);
    bf16_t *Qb = WSP(bf16_t, A_Q2), *Kb = WSP(bf16_t, A_Q2 + 48 * MiB), *Vb = WSP(bf16_t, A_Q2 + 96 * MiB);
    const float sc = 0.10206207261596577f * LOG2E;
    for (int tok = C.gw; tok < NTOK; tok += C.NGW) {
        const bf16_t* q = qf + (size_t)tok * 768; const bf16_t* kv = kvf + (size_t)tok * 1024; const f32x2* rt = rope + (size_t)tok * 32;
        bf16_t* qo = Qb + (size_t)tok * 768; bf16_t* ko = Kb + (size_t)tok * 768; bf16_t* vo = Vb + (size_t)tok * 512;
        for (int p = C.lane; p < 512; p += 64) { const int hh = p >> 6, d = p & 63; qo[hh * 96 + d] = (bf16_t)f2bf(bf2f(q[hh * 96 + d]) * sc); ko[hh * 96 + d] = kv[hh * 128 + d]; vo[hh * 64 + d] = kv[hh * 128 + 64 + d]; }
        for (int p = C.lane; p < 128; p += 64) { const int hh = p >> 4, i2 = p & 15;
            const float x1 = bf2f(q[hh * 96 + 64 + i2]), x2 = bf2f(q[hh * 96 + 80 + i2]); const f32x2 cs = rt[2 * i2];
            qo[hh * 96 + 64 + i2] = (bf16_t)f2bf((x1 * cs.x - x2 * cs.y) * sc); qo[hh * 96 + 80 + i2] = (bf16_t)f2bf((x2 * cs.x + x1 * cs.y) * sc); }
        for (int p = C.lane; p < 256; p += 64) { const int hh = p >> 5, d = p & 31; ko[hh * 96 + 64 + d] = kpe[(size_t)tok * 32 + d]; }
    }
}
__device__ __forceinline__ void phase_prep_odd(const Ctx& C) {
    const bf16_t* hb = WSP(bf16_t, A_HB); const f32x2* rope = WSP(f32x2, WS_ROPE);
    bf16_t *Qc = WSP(bf16_t, A_Q1), *Kc = WSP(bf16_t, A_K1), *Vc = WSP(bf16_t, A_K1 + 8 * MiB), *Qd = WSP(bf16_t, A_V1), *Kd = WSP(bf16_t, A_X1), *Vd = WSP(bf16_t, A_X2);
    const float sc = 0.125f * LOG2E;
    for (int tok = C.gw; tok < NTOK; tok += C.NGW) {
        const bf16_t* h = hb + (size_t)tok * HB_LD; const f32x2* rt = rope + (size_t)tok * 32;
        rope_heads<32>(h, Qc + (size_t)tok * 512, 8, rt, sc, C.lane);
        rope_heads<32>(h + 512, Kc + (size_t)tok * 128, 2, rt, 1.0f, C.lane);
        copy_cols(h + 640, Vc + (size_t)tok * 128, 128, C.lane);
        rope_heads<32>(h + 768, Qd + (size_t)tok * 512, 8, rt, sc, C.lane);
        rope_heads<32>(h + 1280, Kd + (size_t)tok * 512, 8, rt, 1.0f, C.lane);
        copy_cols(h + 1792, Vd + (size_t)tok * 512, 512, C.lane);
    }
}
__device__ __forceinline__ void phase_attn_even(const Ctx& C) {
    const bf16_t *Qa = WSP(bf16_t, A_Q1), *Ka = WSP(bf16_t, A_K1), *Va = WSP(bf16_t, A_V1), *Qb = WSP(bf16_t, A_Q2), *Kb = WSP(bf16_t, A_Q2 + 48 * MiB), *Vb = WSP(bf16_t, A_Q2 + 96 * MiB);
    bf16_t* ob = WSP(bf16_t, A_OB); const float* km = WSP(float, WS_KMEAN);
    for (int P = C.bid; P < 512; P += C.G) { const int bh = P >> 3, pi = P & 7, b = bh >> 3, h = bh & 7;
#pragma unroll 1
        for (int s = 0; s < 2; ++s) { const int qb = s ? pi : 15 - pi;
            att::Tens T{Qb + 96 * h, Kb + 96 * h, Vb + 64 * h, ob + 512 + 64 * h, 768, 768, 512, 1024};
            att::unit<96, 64, att::M_CAUSAL>(T, b, qb, nullptr, 0.f, 0.f, nullptr, 0.f, C.lds, C.tid); } }
    int tid2 = C.tid; asm volatile("" : "+v"(tid2));
    for (int P = C.bid; P < 512; P += C.G) { const int bh = P >> 3, pi = P & 7, b = bh >> 3, h = bh & 7;
#pragma unroll 1
        for (int s = 0; s < 2; ++s) { const int qb = s ? pi : 15 - pi;
            att::Tens T{Qa + 64 * h, Ka + 64 * h, Va + 64 * h, ob + 64 * h, 512, 512, 512, 1024};
            att::unit<64, 64, att::M_MOBA>(T, b, qb, km + ((size_t)b * 8 + h) * 2048, 0.f, 0.f, nullptr, 0.f, C.lds, tid2); } }
}
__device__ __forceinline__ void phase_attn_odd(const Ctx& C, const Args& a, int i, int l) {
    const bf16_t *Qc = WSP(bf16_t, A_Q1), *Kc = WSP(bf16_t, A_K1), *Vc = WSP(bf16_t, A_K1 + 8 * MiB), *Qd = WSP(bf16_t, A_V1), *Kd = WSP(bf16_t, A_X1), *Vd = WSP(bf16_t, A_X2);
    bf16_t* ob = WSP(bf16_t, A_OB);
    const float* lp = a.diff_lambda + i * 256;
    const float d01 = wave_sum(lp[C.lane] * lp[64 + C.lane]), d23 = wave_sum(lp[128 + C.lane] * lp[192 + C.lane]);
    const float lam_init = 0.8f - 0.6f * expf(-0.3f * (float)l);
    const float lam = expf(d01) - expf(d23) + lam_init;
    for (int P = C.bid; P < 512; P += C.G) { const int bh = P >> 4, pi = P & 15, b = bh >> 2, h = bh & 3;
#pragma unroll 1
        for (int s = 0; s < 2; ++s) { const int qb = s ? pi : 31 - pi;
            att::Tens T{Qd + 128 * h, Kd + 128 * h, Vd + 128 * h, ob + 512 + 128 * h, 512, 512, 512, 1024};
            att::unit<64, 128, att::M_DIFF>(T, b, qb, nullptr, 0.f, lam, a.diff_g_subln + i * 128, 1.0f - lam_init, C.lds, C.tid); } }
    int tid2 = C.tid; asm volatile("" : "+v"(tid2));
    for (int P = C.bid; P < 512; P += C.G) { const int bh = P >> 3, pi = P & 7, b = bh >> 3, h = bh & 7;
        const float sink = a.swa_sinks[i * 8 + h] * LOG2E;
#pragma unroll 1
        for (int s = 0; s < 2; ++s) { const int qb = s ? pi : 15 - pi;
            att::Tens T{Qc + 64 * h, Kc + 64 * (h >> 2), Vc + 64 * (h >> 2), ob + 64 * h, 512, 128, 128, 1024};
            att::unit<64, 64, att::M_SWA>(T, b, qb, nullptr, sink, 0.f, nullptr, 0.f, C.lds, tid2); } }
}
__device__ __forceinline__ void ln_row(f32x4 (&v)[4], const float* g, const float* bb, int lane) {
    float s = 0.f;
#pragma unroll
    for (int j = 0; j < 4; ++j) s += (v[j][0] + v[j][1]) + (v[j][2] + v[j][3]);
    const float mean = wave_sum(s) * (1.0f / DM); float s2 = 0.f;
#pragma unroll
    for (int j = 0; j < 4; ++j) { v[j] = v[j] - mean; s2 += (v[j][0] * v[j][0] + v[j][1] * v[j][1]) + (v[j][2] * v[j][2] + v[j][3] * v[j][3]); }
    const float rstd = 1.0f / sqrtf(wave_sum(s2) * (1.0f / DM) + 1e-5f);
#pragma unroll
    for (int j = 0; j < 4; ++j) { const f32x4 gg = *(const f32x4*)(g + 4 * lane + 256 * j), b4 = *(const f32x4*)(bb + 4 * lane + 256 * j); v[j] = v[j] * rstd * gg + b4; }
}
__device__ __forceinline__ void phase_ln1(const Ctx& C, const Args& a, int l) {
    float* xf = WSP(float, WS_XF); bf16_t* xs = WSP(bf16_t, A_XS);
    const float* g = a.ln_g + (size_t)(l * 2) * DM; const float* bb = a.ln_b + (size_t)(l * 2) * DM;
    for (int tok = C.gw; tok < NTOK; tok += C.NGW) {
        f32x4 v[4]; float* xr = xf + (size_t)tok * DM + 4 * C.lane;
#pragma unroll
        for (int j = 0; j < 4; ++j) v[j] = *(const f32x4*)(xr + 256 * j);
        ln_row(v, g, bb, C.lane);
        bf16_t* xo = xs + (size_t)tok * 2048 + 4 * C.lane;
#pragma unroll
        for (int j = 0; j < 4; ++j) { *(f32x4*)(xr + 256 * j) = v[j];
            const unsigned h0 = f2bf(v[j][0]), h1 = f2bf(v[j][1]), h2 = f2bf(v[j][2]), h3 = f2bf(v[j][3]);
            u32x2 hi2 = {h0 | (h1 << 16), h2 | (h3 << 16)}; *(u32x2*)(xo + 256 * j) = hi2;
            u32x2 lo2 = {pk2(v[j][0] - bf2f(h0), v[j][1] - bf2f(h1)), pk2(v[j][2] - bf2f(h2), v[j][3] - bf2f(h3))}; *(u32x2*)(xo + 1024 + 256 * j) = lo2; }
    }
}
__device__ __forceinline__ void phase_route(const Ctx& C, const Args& a, int l) {
    const float* lg = WSP(float, A_LOG);
    int* rowtok = WSP(int, WS_ROWTOK); float* tokw = WSP(float, WS_WSLOT); int* toke = WSP(int, WS_TOKE); int* tokp = WSP(int, WS_TOKP);
    unsigned* cnt = WSP(unsigned, WS_CTL) + CW_CNT + 64 * l;
    LAS int* cntw = (LAS int*)C.lds; LAS int* base = cntw + 64; LAS int* ent_e = base + 64; LAS int* ent_r = ent_e + 2048; LAS float* ent_w = (LAS float*)(ent_r + 2048);
    const int tpb = NTOK / C.G, tok0 = C.bid * tpb;
    if (C.tid < 64) cntw[C.tid] = 0;
    __syncthreads();
    const float bias = a.moe_bias[l * 64 + C.lane];
    const int g = C.lane >> 3;
    for (int tl = C.wave; tl < tpb; tl += NWAVES) {
        const int tok = tok0 + tl;
        const float z = lg[(size_t)tok * 256 + C.lane] + lg[(size_t)tok * 256 + 64 + C.lane];
        const float s = 1.0f / (1.0f + expf(-z));
        const float c = s + bias;
        float m1 = c; m1 = fmaxf(m1, __shfl_xor(m1, 1)); m1 = fmaxf(m1, __shfl_xor(m1, 2)); m1 = fmaxf(m1, __shfl_xor(m1, 4));
        const unsigned long long eq = __ballot(c == m1);
        const unsigned geq = (unsigned)(eq >> (8 * g)) & 0xffu;
        const bool is_first = (C.lane & 7) == (int)__builtin_ctz(geq);
        float m2 = is_first ? -INFINITY : c; m2 = fmaxf(m2, __shfl_xor(m2, 1)); m2 = fmaxf(m2, __shfl_xor(m2, 2)); m2 = fmaxf(m2, __shfl_xor(m2, 4));
        const float gs = m1 + m2;
        int grank = 0;
#pragma unroll
        for (int j = 0; j < 8; ++j) { const float gj = __builtin_bit_cast(float, __builtin_amdgcn_readlane(__builtin_bit_cast(int, gs), 8 * j)); grank += (gj > gs || (gj == gs && j < g)) ? 1 : 0; }
        const float v = grank < 4 ? c : -INFINITY;
        int rank = 0;
#pragma unroll
        for (int j = 0; j < 64; ++j) { const float vj = __builtin_bit_cast(float, __builtin_amdgcn_readlane(__builtin_bit_cast(int, v), j)); rank += (vj > v || (vj == v && j < C.lane)) ? 1 : 0; }
        const bool sel = rank < 8;
        const float ssum = wave_sum(sel ? s : 0.f);
        if (sel) { const int r = __hip_atomic_fetch_add(&cntw[C.lane], 1, __ATOMIC_RELAXED, __HIP_MEMORY_SCOPE_WORKGROUP);
            ent_e[tl * 8 + rank] = C.lane; ent_r[tl * 8 + rank] = r; ent_w[tl * 8 + rank] = s / ssum * 2.5f; }
    }
    __syncthreads();
    if (C.tid < 64) base[C.tid] = (int)atomicAdd(&cnt[C.tid], (unsigned)cntw[C.tid]);
    __syncthreads();
    for (int idx = C.tid; idx < tpb * 8; idx += NTHREADS) { const int e = ent_e[idx], pos = base[e] + ent_r[idx], tok = tok0 + (idx >> 3);
        if (pos < CAP) rowtok[(size_t)e * CAP + pos] = tok;
        toke[(size_t)tok0 * 8 + idx] = e; tokp[(size_t)tok0 * 8 + idx] = pos; tokw[(size_t)tok0 * 8 + idx] = ent_w[idx]; }
    __syncthreads();
}
__device__ __forceinline__ void moe_tables(const Ctx& C, int l) {
    const unsigned* cnt = WSP(unsigned, WS_CTL) + CW_CNT + 64 * l;
    LAS int* lcnt = (LAS int*)(C.lds + LX_CNT); LAS int* tst = (LAS int*)(C.lds + LX_TST); LAS unsigned char* texp = (LAS unsigned char*)(C.lds + LX_TEXP);
    __syncthreads();
    if (C.tid < 64) { int c = (int)__hip_atomic_load(cnt + C.tid, __ATOMIC_RELAXED, __HIP_MEMORY_SCOPE_AGENT); if (c > CAP) c = CAP; lcnt[C.tid] = c; }
    __syncthreads();
    if (C.tid == 0) { int acc = 0; for (int e = 0; e < 64; ++e) { tst[e] = acc; acc += (lcnt[e] + 255) >> 8; } tst[64] = acc; }
    __syncthreads();
    if (C.tid < 64) { const int t0 = tst[C.tid], t1 = tst[C.tid + 1]; for (int t = t0; t < t1; ++t) texp[t] = (unsigned char)C.tid; }
    __syncthreads();
}
template <bool GATHER_> struct MoeOrder {
    static constexpr bool GATHER = GATHER_;
    const LAS int* lcnt; const LAS int* tst; const LAS unsigned char* texp; const int* rowtok;
    int TR, nsh, NC, G, c; int sh_orow0;
    __device__ __forceinline__ bool next(int i, pg8::Unit& u) const {
        const long L = (long)i * G + c; if (L >= (long)(TR + nsh) * NC) return false;
        const int r = (int)(L / NC), cn = (int)(L % NC);
        if (r < TR) { const int e = __builtin_amdgcn_readfirstlane((int)texp[r]); u.e = e; u.lt = r - __builtin_amdgcn_readfirstlane(tst[e]); u.pm = r; u.orow = r * 256; }
        else { u.e = 64; u.lt = r - TR; u.pm = TR_MAX + (r - TR); u.orow = sh_orow0 + u.lt * 256; }
        u.pn = u.e * NC + cn; u.ocol = cn * (NC == 2 ? 128 : 256);
        return true;
    }
    __device__ __forceinline__ unsigned arow(const pg8::Unit& u, int r) const {
        if (!GATHER) return (unsigned)(u.pm * 256 + r);
        const int loc = u.lt * 256 + r;
        if (u.e == 64) return (unsigned)loc;
        return loc < __builtin_amdgcn_readfirstlane(lcnt[u.e]) ? (unsigned)rowtok[(size_t)u.e * CAP + loc] : 0u;
    }
};
__device__ __forceinline__ void phase_combine_ln2(const Ctx& C, const Args& a, int l) {
    float* xf = WSP(float, WS_XF); bf16_t* xb = WSP(bf16_t, WS_HS); const unsigned char* Ys = WSP(unsigned char, WS_YS);
    const int* toke = WSP(int, WS_TOKE); const int* tokp = WSP(int, WS_TOKP); const float* tokw = WSP(float, WS_WSLOT);
    const LAS int* tst = (const LAS int*)(C.lds + LX_TST);
    const float* g = a.ln_g + (size_t)(l * 2 + 1) * DM; const float* bb = a.ln_b + (size_t)(l * 2 + 1) * DM;
    for (int tok = C.gw; tok < NTOK; tok += C.NGW) {
        f32x4 v[4]; float* xr = xf + (size_t)tok * DM + 4 * C.lane;
#pragma unroll
        for (int j = 0; j < 4; ++j) v[j] = *(const f32x4*)(xr + 256 * j);
#pragma unroll
        for (int k = 0; k < 8; ++k) { const int e = toke[(size_t)tok * 8 + k], pos = tokp[(size_t)tok * 8 + k]; const float gw = tokw[(size_t)tok * 8 + k] * (1.0f / YS_SCALE); const size_t slot = (size_t)tst[e] * 256 + pos;
            const unsigned char* yr = Ys + slot * DM + 4 * C.lane;
#pragma unroll
            for (int j = 0; j < 4; ++j) { const int w = *(const int*)(yr + 256 * j);
                v[j][0] += gw * __builtin_amdgcn_cvt_f32_fp8(w, 0); v[j][1] += gw * __builtin_amdgcn_cvt_f32_fp8(w, 1); v[j][2] += gw * __builtin_amdgcn_cvt_f32_fp8(w, 2); v[j][3] += gw * __builtin_amdgcn_cvt_f32_fp8(w, 3); } }
        ln_row(v, g, bb, C.lane);
        bf16_t* xo = xb + (size_t)tok * DM + 4 * C.lane;
#pragma unroll
        for (int j = 0; j < 4; ++j) { *(f32x4*)(xr + 256 * j) = v[j]; u32x2 w = {pk2(v[j][0], v[j][1]), pk2(v[j][2], v[j][3])}; *(u32x2*)(xo + 256 * j) = w;
            if (l == DEPTH - 1) *(f32x4*)(a.out + (size_t)tok * DM + 4 * C.lane + 256 * j) = v[j]; }
    }
}
constexpr int STEPS_PER_LAYER = 15, NSTEPS = 1 + STEPS_PER_LAYER * DEPTH;
#define CAS __attribute__((address_space(4)))
template <int STEP> __device__ __forceinline__ void step_fn(const CAS Args* ka, LAS unsigned char* lds_base, int l, int wv) {
#if defined(__HIP_DEVICE_COMPILE__)
    const Args a = *ka;
#else
    const Args a{};
#endif
    int lane_; asm volatile("v_mbcnt_lo_u32_b32 %0, -1, 0\n\tv_mbcnt_hi_u32_b32 %0, -1, %0" : "=v"(lane_)); asm volatile("" : "+s"(wv)); int tid_ = wv * 64 + lane_; asm volatile("" : "+v"(tid_));
    LAS unsigned char* lds_l = lds_base; asm volatile("" : "+s"(lds_l));
    Ctx C; C.lds = lds_l; C.ws = a.ws; C.tid = tid_; C.lane = C.tid & 63; C.wave = __builtin_amdgcn_readfirstlane(C.tid >> 6);
    int G_ = gridDim.x, bid_ = blockIdx.x; asm volatile("" : "+s"(G_), "+s"(bid_));
    C.G = G_; C.bid = bid_; C.gw = C.bid * NWAVES + C.wave; C.NGW = C.G * NWAVES;
    asm volatile("; STEP_BEGIN %0" :: "n"(STEP));
    const int i = l >> 1; const bool even = !(l & 1);
    const size_t swl = WS_SMALLW + (size_t)l * SW_LAYER;
    if constexpr (STEP == 99) phase_init(C, a);
    if constexpr (STEP == 0) phase_convert(C, a, l);
    if constexpr (STEP == 1) { pg8::Gemm g{WSP(bf16_t, WS_HS), WSP(bf16_t, swl), DM, DM}; pg8::StaticOrder S; S.init(NTOK, even ? 2048 : 2304, C.G, C.bid);
        EpiWin E{C.ws, even ? 1 : 0, a.mla_g_qa + i * 256, a.mla_g_kva + i * 128}; pg8::gemm_phase<EpiWin, pg8::StaticOrder, true>(C.lds, g, S, E, C.tid); }
    if constexpr (STEP == 3) {
        { pg8::Gemm g{WSP(bf16_t, A_X1), WSP(bf16_t, swl + SW_WQB), 256, 256}; pg8::StaticOrder S; S.init(NTOK, 768, C.G, C.bid);
          EpiMlaQ E{C.ws}; pg8::gemm_phase<EpiMlaQ, pg8::StaticOrder, true>(C.lds, g, S, E, C.tid); }
        { int tid3 = C.tid; asm volatile("" : "+v"(tid3)); unsigned char* ws3 = C.ws; asm volatile("" : "+s"(ws3));
          pg8::Gemm g{(bf16_t*)(ws3 + A_X1 + 16 * MiB), (bf16_t*)(ws3 + swl + SW_WKVB), 256, 256}; pg8::StaticOrder S; S.init(NTOK, 1024, C.G, C.bid);
          EpiMlaKV E{ws3}; pg8::gemm_phase<EpiMlaKV, pg8::StaticOrder, true>(C.lds, g, S, E, tid3); } }
    if constexpr (STEP == 5) { if (even) phase_attn_even(C); else phase_attn_odd(C, a, i, l); }
    if constexpr (STEP == 7) { pg8::Gemm g{WSP(bf16_t, A_OB), WSP(bf16_t, swl + SW_WOUT), DM, DM}; pg8::StaticOrder S; S.init(NTOK, DM, C.G, C.bid);
        pg8::EpiResid E{l == 0 ? a.x : WSP(float, WS_XF), WSP(float, WS_XF), DN_ALPHA}; pg8::gemm_phase<pg8::EpiResid, pg8::StaticOrder, true>(C.lds, g, S, E, C.tid); }
    if constexpr (STEP == 8) phase_ln1(C, a, l);
    if constexpr (STEP == 9) { pg8::Gemm g{WSP(bf16_t, A_XS), WSP(bf16_t, WS_WR + (size_t)l * MiB), 2048, 2048}; pg8::StaticOrder S; S.init(NTOK, 256, C.G, C.bid);
        pg8::EpiF32 E{WSP(float, A_LOG), 256}; pg8::gemm_phase<pg8::EpiF32, pg8::StaticOrder, true>(C.lds, g, S, E, C.tid); }
    if constexpr (STEP == 10) phase_route(C, a, l);
    if constexpr (STEP == 11) { moe_tables(C, l);
        const LAS int* tst = (const LAS int*)(C.lds + LX_TST);
        MoeOrder<true> S{(const LAS int*)(C.lds + LX_CNT), tst, (const LAS unsigned char*)(C.lds + LX_TEXP), WSP(int, WS_ROWTOK), __builtin_amdgcn_readfirstlane(tst[64]), 128, 2, C.G, C.bid, SLOTS_R};
        pg8::Gemm g{WSP(bf16_t, A_XS), WSP(bf16_t, WS_WGU), 2048, DM}; pg8::EpiSwiGLU E{WSP(bf16_t, WS_HS)};
        pg8::gemm_phase<pg8::EpiSwiGLU, MoeOrder<true>, true>(C.lds, g, S, E, C.tid); }
    if constexpr (STEP == 12) { moe_tables(C, l);
        const LAS int* tst = (const LAS int*)(C.lds + LX_TST);
        MoeOrder<false> S{(const LAS int*)(C.lds + LX_CNT), tst, (const LAS unsigned char*)(C.lds + LX_TEXP), WSP(int, WS_ROWTOK), __builtin_amdgcn_readfirstlane(tst[64]), 128, 4, C.G, C.bid, 0};
        pg8::Gemm g{WSP(bf16_t, WS_HS), WSP(bf16_t, WS_WD), DE, DE}; EpiDownAll E{C.ws};
        pg8::gemm_phase<EpiDownAll, MoeOrder<false>, true>(C.lds, g, S, E, C.tid); }
    if constexpr (STEP == 14) { moe_tables(C, l); phase_combine_ln2(C, a, l); }
}
__global__ void __launch_bounds__(NTHREADS, 2) mega_fwd(Args a) {
    extern __shared__ __attribute__((aligned(16))) unsigned char lds_raw[];
    LAS unsigned char* lds = (LAS unsigned char*)lds_raw;
    const CAS Args* ka = (const CAS Args*)__builtin_amdgcn_kernarg_segment_ptr();
    const int wv = __builtin_amdgcn_readfirstlane(threadIdx.x >> 6);
    if (threadIdx.x < 4) ((LAS unsigned*)(lds + LX_BAR))[threadIdx.x] = 0u;
    __syncthreads();
    unsigned* barw = (unsigned*)(a.ws + WS_CTL) + CW_BAR;
    XcdBarrier bar; bar.bar = barw; bar.x = 0; bar.st = nullptr;
    if (a.use_bar) bar = xcd_barrier_post(barw, (volatile LAS unsigned*)(lds + LX_BAR));
    int step = 0;
#ifndef DUP_MASK
#define DUP_MASK 0u
#endif
#define BARRIER_NOW() do { XcdBarrier b2 = bar; asm volatile("" : "+s"(b2.bar)); int w2 = wv; asm volatile("" : "+s"(w2)); int l2_; asm volatile("v_mbcnt_lo_u32_b32 %0, -1, 0\n\tv_mbcnt_hi_u32_b32 %0, -1, %0" : "=v"(l2_)); xcd_barrier(b2, w2 == 0 && l2_ == 0); } while (0)
#define RUN(K, cond) do { if (step >= a.st_lo && step < a.st_hi) { if (cond) { const CAS Args* kp = ka; asm volatile("" : "+s"(kp)); step_fn<K>(kp, lds, l, wv); \
        if constexpr (K < 32 && ((DUP_MASK >> (K & 31)) & 1u)) { BARRIER_NOW(); const CAS Args* kp2 = ka; asm volatile("" : "+s"(kp2)); step_fn<K>(kp2, lds, l, wv); } if (a.use_bar && step + 1 < a.st_hi) BARRIER_NOW(); } } ++step; } while (0)
    { const int l = 0; RUN(99, true); }
#pragma unroll 1
    for (int l = 0; l < DEPTH; ++l) {
        const bool even = !(l & 1);
        RUN(0, true); RUN(1, true); RUN(2, false); RUN(3, even); RUN(4, false); RUN(5, true); RUN(6, false); RUN(7, true);
        RUN(8, true); RUN(9, true); RUN(10, true); RUN(11, true); RUN(12, true); RUN(13, false); RUN(14, true);
    }
#undef RUN
}

extern "C" void kernel_launch(void* const* d_in, const int* in_sizes, int n_in, void* d_out, int out_size, void* d_ws, size_t ws_size, hipStream_t stream) {
    static int grid = 0;
    if (grid == 0) {
        if (n_in != 23 || out_size != NTOK * DM || ws_size < WS_END) { fprintf(stderr, "kernel_launch: unexpected problem shape (n_in %d out %d ws %zu)\n", n_in, out_size, ws_size); grid = -1; return; }
        int dev = 0, cus = 0;
        if (hipGetDevice(&dev) != hipSuccess || hipDeviceGetAttribute(&cus, hipDeviceAttributeMultiprocessorCount, dev) != hipSuccess) { grid = -1; return; }
        if (hipFuncSetAttribute((const void*)mega_fwd, hipFuncAttributeMaxDynamicSharedMemorySize, LDS_BYTES) != hipSuccess) { fprintf(stderr, "kernel_launch: hipFuncSetAttribute failed\n"); grid = -1; return; }
        int per_cu = 0;
        if (hipOccupancyMaxActiveBlocksPerMultiprocessor(&per_cu, (const void*)mega_fwd, NTHREADS, LDS_BYTES) != hipSuccess || per_cu < 1) { fprintf(stderr, "kernel_launch: occupancy query says %d\n", per_cu); }
        (void)hipGetLastError();
        grid = cus;
    }
    if (grid < 0) return;
    if (hipMemsetAsync((char*)d_ws + WS_CTL, 0, CTL_ZERO_BYTES, stream) != hipSuccess) return;
    Args a{};
    a.x = (const float*)d_in[0]; a.pos = (const int*)d_in[1];
    a.ev_w_in = (const float*)d_in[2]; a.ev_w_out = (const float*)d_in[3]; a.mla_g_qa = (const float*)d_in[4]; a.mla_w_qb = (const float*)d_in[5]; a.mla_g_kva = (const float*)d_in[6]; a.mla_w_kvb = (const float*)d_in[7];
    a.od_w_in = (const float*)d_in[8]; a.od_w_out = (const float*)d_in[9]; a.swa_sinks = (const float*)d_in[10]; a.diff_lambda = (const float*)d_in[11]; a.diff_g_subln = (const float*)d_in[12];
    a.ln_g = (const float*)d_in[13]; a.ln_b = (const float*)d_in[14]; a.moe_w_router = (const float*)d_in[15]; a.moe_bias = (const float*)d_in[16];
    a.moe_w_gate = (const float*)d_in[17]; a.moe_w_up = (const float*)d_in[18]; a.moe_w_down = (const float*)d_in[19]; a.sh_w_gate = (const float*)d_in[20]; a.sh_w_up = (const float*)d_in[21]; a.sh_w_down = (const float*)d_in[22];
    a.out = (float*)d_out; a.ws = (unsigned char*)d_ws;
#ifndef MK_ONE_LAUNCH
#define MK_ONE_LAUNCH 1
#endif
    if (MK_ONE_LAUNCH) {
        a.st_lo = 0; a.st_hi = NSTEPS; a.use_bar = 1;
        hipLaunchKernelGGL(mega_fwd, dim3(grid), dim3(NTHREADS), LDS_BYTES, stream, a);
    } else {
        for (int s = 0; s < NSTEPS; ++s) {
            if (s > 0) { const int ls = (s - 1) % STEPS_PER_LAYER, l = (s - 1) / STEPS_PER_LAYER; const bool even = !(l & 1);
                if (ls == 2 || ls == 4 || ls == 6 || ls == 13) continue; if (!even && ls == 3) continue; }
            a.st_lo = s; a.st_hi = s + 1; a.use_bar = 0;
            hipLaunchKernelGGL(mega_fwd, dim3(grid), dim3(NTHREADS), LDS_BYTES, stream, a);
        }
    }
}
```

```cpp
#include <hip/hip_runtime.h>
#include <cstdio>
#include <cstdint>
#include <utility>

#define GAS __attribute__((address_space(1)))
#define LAS __attribute__((address_space(3)))
typedef unsigned short bf16_t;
typedef short bf16x8 __attribute__((ext_vector_type(8)));
typedef short s16x4 __attribute__((ext_vector_type(4)));
typedef float f32x2 __attribute__((ext_vector_type(2)));
typedef float f32x4 __attribute__((ext_vector_type(4)));
typedef float f32x16 __attribute__((ext_vector_type(16)));
typedef unsigned u32x2 __attribute__((ext_vector_type(2)));
typedef unsigned u32x4 __attribute__((ext_vector_type(4)));

constexpr int NTOK = 32768, DM = 1024, SEQ = 4096, NBATCH = 8, DEPTH = 4;
constexpr int EV_IN = 1952, OD_IN = 2304, HB_LD = 2304;
constexpr int NE = 64, DE = 256, TOPK = 8, CAP = 32768;
constexpr int TR_MAX = 1088;
constexpr int SLOTS_R = TR_MAX * 256;
constexpr int SLOTS = SLOTS_R + NTOK;
constexpr float DN_ALPHA = 1.681792830507429f;
constexpr float LOG2E = 1.4426950408889634f;

__device__ __forceinline__ unsigned f2bf(float f) { unsigned u = __builtin_bit_cast(unsigned, f); return (u + 0x7fffu + ((u >> 16) & 1u)) >> 16; }
__device__ __forceinline__ float bf2f(unsigned b) { return __builtin_bit_cast(float, b << 16); }
__device__ __forceinline__ unsigned pk2(float lo, float hi) { return f2bf(lo) | (f2bf(hi) << 16); }
template <int M> __device__ __forceinline__ float shx(float v) {
    if constexpr (M == 32) { const auto rr = __builtin_amdgcn_permlane32_swap(__builtin_bit_cast(unsigned, v), __builtin_bit_cast(unsigned, v), false, false); return __builtin_bit_cast(float, rr[0] == __builtin_bit_cast(unsigned, v) ? rr[1] : rr[0]); }
    else return __builtin_bit_cast(float, __builtin_amdgcn_ds_swizzle(__builtin_bit_cast(int, v), 0x1F | (M << 10)));
}
__device__ __forceinline__ float wave_sum(float v) { v += shx<1>(v); v += shx<2>(v); v += shx<4>(v); v += shx<8>(v); v += shx<16>(v); v += shx<32>(v); return v; }
namespace pg8 {
constexpr int BM = 256, BK = 64, HALF = 128, HTB = HALF * BK * 2  , STAGE_BYTES = 8 * HTB, NXCD = 8, WGM = 8;
__host__ __device__ __forceinline__ int lds_byte(int r, int c) { const int st = (r >> 4) * 2 + (c >> 5), rr = r & 15, cc = c & 31, ob = rr * 64 + cc * 2; return st * 1024 + (ob ^ (((ob >> 9) & 1) << 5)); }
__host__ __device__ __forceinline__ void stage_rc(int b, int& R, int& C) { const int st = b / 1024, sb = b % 1024, swz = sb ^ (((sb >> 9) & 1) << 5); R = (st >> 1) * 16 + swz / 64; C = (st & 1) * 32 + (swz % 64) / 2; }
__host__ __device__ __forceinline__ int perm32(int rho) { const int n = rho >> 4, i = rho & 15; return 8 * (i >> 2) + 4 * n + (i & 3); }

struct Unit { int pm, pn, orow, ocol, e, lt; };
struct Gemm { const bf16_t* A; const bf16_t* Bt; int lda, K; };

struct StaticOrder {
    static constexpr bool GATHER = false;
    int nM, nN, nwg, G, c;
    __device__ void init(int M, int N, int G_, int c_) { nM = M / BM; nN = N / BM; nwg = nM * nN; G = G_; c = c_; }
    __device__ __forceinline__ bool next(int i, Unit& u) const {
        const long L = (long)i * G + c; if (L >= nwg) return false;
        int wgid = (int)L; { const int q = nwg / NXCD, r = nwg % NXCD, xcd = wgid % NXCD, off = wgid / NXCD; wgid = (xcd < r ? xcd * (q + 1) : r * (q + 1) + (xcd - r) * q) + off; }
        const int nig = WGM * nN, gid = wgid / nig, fm = gid * WGM, gsz = (nM - fm) < WGM ? (nM - fm) : WGM;
        u.pm = fm + ((wgid % nig) % gsz); u.pn = (wgid % nig) / gsz; u.orow = u.pm * BM; u.ocol = u.pn * BM; u.e = 0; u.lt = u.pm; return true;
    }
    __device__ __forceinline__ unsigned arow(const Unit& u, int r) const { return (unsigned)(u.pm * BM + r); }
};

__device__ __forceinline__ unsigned cvt_pk_bf16(float lo, float hi) { unsigned r; asm volatile("v_cvt_pk_bf16_f32 %0, %1, %2" : "=v"(r) : "v"(lo), "v"(hi)); return r; }

struct EpiBf16 {
    static constexpr bool PERM = true;
    bf16_t* O; int ldc;
    __device__ __forceinline__ void operator()(const f32x4 (&acc)[2][2][4][2], const Unit& u, int wr, int wc, int fr, int fq) const {
        const int row0 = u.orow + wr * 64 + fr, col0 = u.ocol + wc * 32 + 8 * fq;
#pragma unroll
        for (int ai = 0; ai < 2; ++ai)
#pragma unroll
            for (int m = 0; m < 4; ++m) { bf16_t* rowp = O + (size_t)(row0 + ai * HALF + m * 16) * ldc + col0;
#pragma unroll
                for (int bj = 0; bj < 2; ++bj) { const f32x4 v0 = acc[ai][bj][m][0], v1 = acc[ai][bj][m][1];
                    u32x4 w; w.x = cvt_pk_bf16(v0[0], v0[1]); w.y = cvt_pk_bf16(v0[2], v0[3]); w.z = cvt_pk_bf16(v1[0], v1[1]); w.w = cvt_pk_bf16(v1[2], v1[3]);
                    *(u32x4*)(rowp + bj * HALF) = w; } }
    }
};
struct EpiF32 {
    static constexpr bool PERM = false;
    float* C; int ldc;
    __device__ __forceinline__ void operator()(const f32x4 (&acc)[2][2][4][2], const Unit& u, int wr, int wc, int fr, int fq) const {
        const int row0 = u.orow + wr * 64 + fr, col0 = u.ocol + wc * 32 + 4 * fq;
#pragma unroll
        for (int ai = 0; ai < 2; ++ai)
#pragma unroll
            for (int m = 0; m < 4; ++m) { float* rowp = C + (size_t)(row0 + ai * HALF + m * 16) * ldc + col0;
#pragma unroll
                for (int bj = 0; bj < 2; ++bj)
#pragma unroll
                    for (int n = 0; n < 2; ++n) *(f32x4*)(rowp + bj * HALF + n * 16) = acc[ai][bj][m][n]; }
    }
};
struct EpiResid {
    static constexpr bool PERM = false;
    const float* src; float* dst; float alpha;
    __device__ __forceinline__ void operator()(const f32x4 (&acc)[2][2][4][2], const Unit& u, int wr, int wc, int fr, int fq) const {
        const int row0 = u.orow + wr * 64 + fr, col0 = u.ocol + wc * 32 + 4 * fq;
#pragma unroll
        for (int ai = 0; ai < 2; ++ai)
#pragma unroll
            for (int m = 0; m < 4; ++m) { const size_t ro = (size_t)(row0 + ai * HALF + m * 16) * DM + col0;
#pragma unroll
                for (int bj = 0; bj < 2; ++bj)
#pragma unroll
                    for (int n = 0; n < 2; ++n) { const f32x4 s = *(const f32x4*)(src + ro + bj * HALF + n * 16); *(f32x4*)(dst + ro + bj * HALF + n * 16) = s * alpha + acc[ai][bj][m][n]; } }
    }
};
struct EpiSwiGLU {
    static constexpr bool PERM = true;
    bf16_t* H;
    __device__ __forceinline__ void operator()(const f32x4 (&acc)[2][2][4][2], const Unit& u, int wr, int wc, int fr, int fq) const {
        const int row0 = u.orow + wr * 64 + fr, col0 = u.ocol + wc * 32 + 8 * fq;
#pragma unroll
        for (int ai = 0; ai < 2; ++ai)
#pragma unroll
            for (int m = 0; m < 4; ++m) { bf16_t* rowp = H + (size_t)(row0 + ai * HALF + m * 16) * DE + col0;
                float h[8];
#pragma unroll
                for (int n = 0; n < 2; ++n)
#pragma unroll
                    for (int j = 0; j < 4; ++j) { const float g = acc[ai][0][m][n][j], up = acc[ai][1][m][n][j]; h[n * 4 + j] = g / (1.0f + __expf(-g)) * up; }
                u32x4 w; w.x = cvt_pk_bf16(h[0], h[1]); w.y = cvt_pk_bf16(h[2], h[3]); w.z = cvt_pk_bf16(h[4], h[5]); w.w = cvt_pk_bf16(h[6], h[7]);
                *(u32x4*)rowp = w; }
    }
};
struct EpiDown {
    static constexpr bool PERM = true;
    bf16_t* Y; const float* wslot; const LAS int* cnt;
    __device__ __forceinline__ void operator()(const f32x4 (&acc)[2][2][4][2], const Unit& u, int wr, int wc, int fr, int fq) const {
        const int rl0 = wr * 64 + fr, col0 = u.ocol + wc * 32 + 8 * fq; const int ce = cnt[u.e];
#pragma unroll
        for (int ai = 0; ai < 2; ++ai)
#pragma unroll
            for (int m = 0; m < 4; ++m) { const int rl = rl0 + ai * HALF + m * 16, loc = u.lt * BM + rl;
                const float gw = loc < ce ? wslot[(size_t)u.e * CAP + loc] : 0.f;
                bf16_t* rowp = Y + (size_t)(u.orow + rl) * DM + col0;
#pragma unroll
                for (int bj = 0; bj < 2; ++bj) { const f32x4 v0 = acc[ai][bj][m][0] * gw, v1 = acc[ai][bj][m][1] * gw;
                    u32x4 w; w.x = cvt_pk_bf16(v0[0], v0[1]); w.y = cvt_pk_bf16(v0[2], v0[3]); w.z = cvt_pk_bf16(v1[0], v1[1]); w.w = cvt_pk_bf16(v1[2], v1[3]);
                    *(u32x4*)(rowp + bj * HALF) = w; } }
    }
};

template <class Epi, class Sched, bool ALIGN_EPI>
__device__ __forceinline__ void gemm_phase(LAS unsigned char* lds, const Gemm g, const Sched& S, const Epi& E, const int tid) {
    const int wid = __builtin_amdgcn_readfirstlane(tid >> 6), lane = tid & 63, wr = wid >> 2, wc = wid & 3, fr = lane & 15, fq = lane >> 4;
    const int K = g.K, nt = K / BK;
    constexpr bool GATHER = Sched::GATHER;
    int Ra[2]; unsigned Ca[2], voffA[2], voffB[2];
    const unsigned ldab = (unsigned)g.lda * 2u;
#pragma unroll
    for (int i = 0; i < 2; ++i) { int R, C; stage_rc(tid * 16 + i * 8192, R, C); const int Rb = Epi::PERM ? ((R & ~31) + perm32(R & 31)) : R;
        Ra[i] = R; Ca[i] = (unsigned)C * 2u; voffA[i] = (unsigned)R * ldab + (unsigned)C * 2u; voffB[i] = (unsigned)(Rb * K + C) * 2u; }
    const size_t hstepA = (size_t)HALF * ldab;
    const size_t kstep = (size_t)(BK * 2);
    const size_t hstep = (size_t)HALF * K * 2;
    const size_t tstep = 2 * hstep;
    const unsigned ldsw = (unsigned)wid * 1024u;
    const int aoff = lds_byte(wr * 64 + fr, fq * 8), boff = lds_byte(wc * 32 + fr, fq * 8);
    const char* Ab = (const char*)g.A;
#define PG8_SA(b, h) (((b) * 2 + (h)) * HTB)
#define PG8_SB(b, h) ((4 + (b) * 2 + (h)) * HTB)
#define PG8_STAGE(bufoff, gbase, voff) do { _Pragma("unroll") for (int _i = 0; _i < 2; ++_i) \
        __builtin_amdgcn_global_load_lds((const unsigned*)((const char*)(gbase) + (voff)[_i]), (LAS unsigned*)(lds + (bufoff) + ldsw + _i * 8192), 16, 0, 0); } while (0)
#define PG8_STAGEA(bufoff, offs, ubase, h, kbyte) do { _Pragma("unroll") for (int _i = 0; _i < 2; ++_i) { \
        const char* _src = GATHER ? Ab + (size_t)(offs)[h][_i] + (size_t)(kbyte) : (ubase) + (size_t)(h) * hstepA + (size_t)(kbyte) + voffA[_i]; \
        __builtin_amdgcn_global_load_lds((const unsigned*)_src, (LAS unsigned*)(lds + (bufoff) + ldsw + _i * 8192), 16, 0, 0); } } while (0)
#define PG8_OFFS(dst, u) do { if constexpr (GATHER) { _Pragma("unroll") for (int _h = 0; _h < 2; ++_h) _Pragma("unroll") for (int _i = 0; _i < 2; ++_i) dst[_h][_i] = S.arow(u, _h * HALF + Ra[_i]) * ldab + Ca[_i]; } } while (0)
#define PG8_LDA(dst, b, h) do { _Pragma("unroll") for (int m = 0; m < 4; ++m) _Pragma("unroll") for (int k = 0; k < 2; ++k) dst[m][k] = *(const LAS bf16x8*)(lds + PG8_SA(b, h) + aoff + m * 2048 + k * 1024); } while (0)
#define PG8_LDB(dst, b, h) do { _Pragma("unroll") for (int n = 0; n < 2; ++n) _Pragma("unroll") for (int k = 0; k < 2; ++k) dst[n][k] = *(const LAS bf16x8*)(lds + PG8_SB(b, h) + boff + n * 2048 + k * 1024); } while (0)
#define PG8_MMA(ai, bj, At, Bt) do { __builtin_amdgcn_s_setprio(1); _Pragma("unroll") for (int m = 0; m < 4; ++m) _Pragma("unroll") for (int n = 0; n < 2; ++n) _Pragma("unroll") for (int k = 0; k < 2; ++k) \
        acc[ai][bj][m][n] = __builtin_amdgcn_mfma_f32_16x16x32_bf16(Bt[n][k], At[m][k], acc[ai][bj][m][n], 0, 0, 0); __builtin_amdgcn_s_setprio(0); } while (0)
#define PG8_WAIT_V(n) asm volatile("s_waitcnt vmcnt(" #n ")" ::: "memory")
#define PG8_WAIT_L(n) asm volatile("s_waitcnt lgkmcnt(" #n ")" ::: "memory")
#define PG8_BAR __builtin_amdgcn_s_barrier()
#define PG8_SCHED __builtin_amdgcn_sched_barrier(0)
    Unit cur, nxt; int ui = 0;
    if (!S.next(0, cur)) return;
    f32x4 acc[2][2][4][2];
#pragma unroll
    for (int a = 0; a < 2; ++a)
#pragma unroll
        for (int b = 0; b < 2; ++b)
#pragma unroll
            for (int m = 0; m < 4; ++m)
#pragma unroll
                for (int n = 0; n < 2; ++n) acc[a][b][m][n] = (f32x4){0.f, 0.f, 0.f, 0.f};
    bf16x8 At[4][2], B0[2][2], B1[2][2];
    unsigned oc[2][2] = {{0u, 0u}, {0u, 0u}}, on[2][2] = {{0u, 0u}, {0u, 0u}};
    PG8_OFFS(oc, cur);
    const char* cA = Ab + (size_t)S.arow(cur, 0) * ldab;
    const char* cB = (const char*)g.Bt + (size_t)cur.pn * tstep;
    PG8_STAGE(PG8_SB(0, 0), cB, voffB); PG8_STAGE(PG8_SB(0, 1), cB + hstep, voffB); PG8_STAGEA(PG8_SA(0, 0), oc, cA, 0, 0); PG8_STAGEA(PG8_SA(0, 1), oc, cA, 1, 0);
    if (wr == 1) PG8_BAR;
    PG8_WAIT_V(2); PG8_BAR;
    PG8_STAGE(PG8_SB(1, 0), cB + kstep, voffB); PG8_STAGEA(PG8_SA(1, 0), oc, cA, 0, kstep); PG8_STAGE(PG8_SB(1, 1), cB + hstep + kstep, voffB);
    PG8_WAIT_V(6); PG8_BAR;
    for (;;) {
        const bool has_next = S.next(ui + 1, nxt);
        if (has_next) { PG8_OFFS(on, nxt); } else {
#pragma unroll
            for (int h = 0; h < 2; ++h)
#pragma unroll
                for (int i = 0; i < 2; ++i) on[h][i] = oc[h][i]; }
        const char* nB = has_next ? (const char*)g.Bt + (size_t)nxt.pn * tstep : cB;
        const char* nA = has_next ? Ab + (size_t)S.arow(nxt, 0) * ldab : cA;
        for (int t = 0; t < nt; t += 2) {
            const bool last = (t == nt - 2);
            const size_t k1 = (size_t)(t + 1) * kstep;
            const size_t k2 = last ? 0 : (size_t)(t + 2) * kstep, k3 = k2 + kstep;
            const char* b2 = last ? nB : cB + (size_t)(t + 2) * kstep; const char* b3 = b2 + kstep;
            unsigned o2[2][2]; const char* a2 = last ? nA : cA;
#pragma unroll
            for (int h = 0; h < 2; ++h)
#pragma unroll
                for (int i = 0; i < 2; ++i) o2[h][i] = last ? on[h][i] : oc[h][i];
            PG8_LDB(B0, 0, 0); PG8_LDB(B1, 0, 1); PG8_SCHED; PG8_LDA(At, 0, 0); PG8_STAGEA(PG8_SA(1, 1), oc, cA, 1, k1);
            PG8_WAIT_V(8); PG8_WAIT_L(0); PG8_BAR; PG8_MMA(0, 0, At, B0); PG8_MMA(0, 1, At, B1); PG8_BAR; PG8_SCHED;
            PG8_LDA(At, 0, 1); PG8_STAGE(PG8_SB(0, 0), b2, voffB); PG8_STAGE(PG8_SB(0, 1), b2 + hstep, voffB); PG8_STAGEA(PG8_SA(0, 0), o2, a2, 0, k2);
            PG8_WAIT_V(8); PG8_WAIT_L(0); PG8_BAR; PG8_MMA(1, 0, At, B0); PG8_MMA(1, 1, At, B1); PG8_BAR; PG8_SCHED;
            PG8_LDB(B0, 1, 0); PG8_LDB(B1, 1, 1); PG8_SCHED; PG8_LDA(At, 1, 0); PG8_STAGEA(PG8_SA(0, 1), o2, a2, 1, k2);
            PG8_WAIT_V(8); PG8_WAIT_L(0); PG8_BAR; PG8_MMA(0, 0, At, B0); PG8_MMA(0, 1, At, B1); PG8_BAR; PG8_SCHED;
            PG8_LDA(At, 1, 1); PG8_STAGE(PG8_SB(1, 0), b3, voffB); PG8_STAGE(PG8_SB(1, 1), b3 + hstep, voffB); PG8_STAGEA(PG8_SA(1, 0), o2, a2, 0, k3);
            PG8_WAIT_V(8); PG8_WAIT_L(0); PG8_BAR; PG8_MMA(1, 0, At, B0); PG8_MMA(1, 1, At, B1); PG8_BAR; PG8_SCHED;
        }
        if constexpr (ALIGN_EPI) { if (wr == 0) PG8_BAR; }
        { int l2; asm volatile("v_mbcnt_lo_u32_b32 %0, -1, 0\n\tv_mbcnt_hi_u32_b32 %0, -1, %0" : "=v"(l2)); E(acc, cur, wr, wc, l2 & 15, l2 >> 4); }
        if (!has_next) break;
#pragma unroll
        for (int a = 0; a < 2; ++a)
#pragma unroll
            for (int b = 0; b < 2; ++b)
#pragma unroll
                for (int m = 0; m < 4; ++m)
#pragma unroll
                    for (int n = 0; n < 2; ++n) acc[a][b][m][n] = (f32x4){0.f, 0.f, 0.f, 0.f};
        cur = nxt; cB = nB; cA = nA; ++ui;
#pragma unroll
        for (int h = 0; h < 2; ++h)
#pragma unroll
            for (int i = 0; i < 2; ++i) oc[h][i] = on[h][i];
        if constexpr (ALIGN_EPI) { if (wr == 1) PG8_BAR; }
    }
    PG8_WAIT_V(0);
    if constexpr (!ALIGN_EPI) { if (wr == 0) PG8_BAR; }
    PG8_BAR;
#undef PG8_SA
#undef PG8_SB
#undef PG8_STAGE
#undef PG8_STAGEA
#undef PG8_OFFS
#undef PG8_LDA
#undef PG8_LDB
#undef PG8_MMA
#undef PG8_WAIT_V
#undef PG8_WAIT_L
#undef PG8_BAR
#undef PG8_SCHED
}
}
namespace att {
#ifndef ATT_INTERLEAVE
#define ATT_INTERLEAVE 0
#endif
constexpr int M_CAUSAL = 0, M_MOBA = 1, M_SWA = 2, M_DIFF = 3;
constexpr float RESCALE_THR = 8.0f;
__device__ __forceinline__ unsigned cvtpk(float lo, float hi) { unsigned r; asm volatile("v_cvt_pk_bf16_f32 %0, %1, %2" : "=v"(r) : "v"(lo), "v"(hi)); return r; }
__device__ __forceinline__ float max3f(float a, float b, float c) { float r; asm("v_max3_f32 %0, %1, %2, %3" : "=v"(r) : "v"(a), "v"(b), "v"(c)); return r; }
__device__ __forceinline__ float xhalf_max(float m) { const auto rr = __builtin_amdgcn_permlane32_swap(__float_as_uint(m), __float_as_uint(m), false, false); return fmaxf(__uint_as_float(rr[0]), __uint_as_float(rr[1])); }
__device__ __forceinline__ float xhalf_sum(float m) { const auto rr = __builtin_amdgcn_permlane32_swap(__float_as_uint(m), __float_as_uint(m), false, false); return __uint_as_float(rr[0]) + __uint_as_float(rr[1]); }
__device__ __forceinline__ void glds16(const void* sbase, unsigned voff, unsigned lds_dst) { unsigned keep;
    asm volatile("s_mov_b32 %0, m0\n\ts_mov_b32 m0, %3\n\ts_nop 0\n\tglobal_load_lds_dwordx4 %1, %2\n\ts_mov_b32 m0, %0" : "=&s"(keep) : "v"(voff), "s"(sbase), "s"(lds_dst) : "memory"); }
template <int DK, int DV, int MODE> struct Cfg {
    static constexpr int KCOLS = (MODE == M_DIFF) ? 2 * DK : DK;
    static constexpr int NKP = KCOLS / 16 * 2, NVP = 4 * (DV / 32), NP = NKP + NVP;
    static constexpr int KBYTES = NKP * 1024, VBYTES = NVP * 1024, BUF = KBYTES + VBYTES;
    static constexpr int QROWS = (MODE == M_DIFF) ? 128 : 256;
    static constexpr int LDS_BYTES = 2 * BUF;
};
struct Tens { const bf16_t* Q; const bf16_t* K; const bf16_t* V; bf16_t* O; int ldq, ldk, ldv, ldo; };


template <int NCH, int C, int MODE, bool MASKED>
__device__ __forceinline__ void sm_part(f32x16& p, float& mh, float& ls, bf16x8& pfA, bf16x8& pfB, int kvh  , int qabs, int hi) {
    if constexpr (C == 0) {
        if constexpr (MASKED) {
#pragma unroll
            for (int i = 0; i < 16; ++i) { const int kv = kvh + 16 * (i >> 3) + 8 * hi + (i & 7); bool m = kv > qabs; if constexpr (MODE == M_SWA) m = m || (kv < qabs - 127); if (m) p[i] = -INFINITY; }
        }
        float a = max3f(p[0], p[1], p[2]), b = max3f(p[3], p[4], p[5]);
        a = max3f(a, p[6], p[7]); b = max3f(b, p[8], p[9]); a = max3f(a, p[10], p[11]); b = max3f(b, p[12], p[13]); a = max3f(a, p[14], p[15]);
        mh = fmaxf(a, b);
    }
    constexpr int lo = 16 * C / NCH, hi_ = 16 * (C + 1) / NCH;
#pragma unroll
    for (int i = lo; i < hi_; ++i) p[i] = __builtin_amdgcn_exp2f(p[i]);
    if constexpr (C == NCH - 1) {
        float s0 = (p[0] + p[1]) + (p[2] + p[3]), s1 = (p[4] + p[5]) + (p[6] + p[7]), s2 = (p[8] + p[9]) + (p[10] + p[11]), s3 = (p[12] + p[13]) + (p[14] + p[15]);
        ls += (s0 + s1) + (s2 + s3);
        u32x4 w; w.x = cvtpk(p[0], p[1]); w.y = cvtpk(p[2], p[3]); w.z = cvtpk(p[4], p[5]); w.w = cvtpk(p[6], p[7]); pfA = __builtin_bit_cast(bf16x8, w);
        w.x = cvtpk(p[8], p[9]); w.y = cvtpk(p[10], p[11]); w.z = cvtpk(p[12], p[13]); w.w = cvtpk(p[14], p[15]); pfB = __builtin_bit_cast(bf16x8, w);
    }
}
__device__ __forceinline__ bf16x8 vtr_frag(const LAS unsigned char* vp) {
    const s16x4 lo = __builtin_bit_cast(s16x4, __builtin_amdgcn_ds_read_tr16_b64_v4i16((LAS s16x4*)(vp))); const s16x4 hh = __builtin_bit_cast(s16x4, __builtin_amdgcn_ds_read_tr16_b64_v4i16((LAS s16x4*)(vp + 256)));
    return (bf16x8){lo[0], lo[1], lo[2], lo[3], hh[0], hh[1], hh[2], hh[3]}; }
#define ATT_SB() __builtin_amdgcn_sched_barrier(0)
#define ATT_VGRP(dst, h_, g_) do { _Pragma("unroll") for (int dd_ = 0; dd_ < 2; ++dd_) _Pragma("unroll") for (int j_ = 0; j_ < 2; ++j_) dst[dd_][j_] = vtr_frag(bb + vfo + (4 * (2 * (g_) + dd_) + 2 * (h_) + j_) * 1024); } while (0)
#define ATT_PV1(frag, g_, c_, PA, PB) (o[2 * (g_) + ((c_) & 1)] = __builtin_amdgcn_mfma_f32_32x32x16_bf16(frag[(c_) & 1][(c_) >> 1], ((c_) >> 1) ? PB : PA, o[2 * (g_) + ((c_) & 1)], 0, 0, 0))
template <int DK, int DV, int MODE, bool MASKED>
__device__ __forceinline__ void tile_body(const LAS unsigned char* bb, const int kfo, const int vfo, const bf16x8 (&qf)[DK / 16], const float cinit, f32x16 (&o)[DV / 32], float& lsum, float& mxout, const int kv0, const int qabs, const int hi) {
    constexpr int NQK = DK / 16, ND = DV / 32, NPV = 2 * ND;
    bf16x8 kf[NQK][2];
#pragma unroll
    for (int d0 = 0; d0 < NQK; ++d0) { kf[d0][0] = *(const LAS bf16x8*)(bb + kfo + (2 * d0) * 1024); kf[d0][1] = *(const LAS bf16x8*)(bb + kfo + (2 * d0 + 1) * 1024); }
    f32x16 p0, p1;
#pragma unroll
    for (int i = 0; i < 16; ++i) { p0[i] = cinit; p1[i] = cinit; }
    ATT_SB();
#pragma unroll
    for (int d0 = 0; d0 < NQK; ++d0) p0 = __builtin_amdgcn_mfma_f32_32x32x16_bf16(kf[d0][0], qf[d0], p0, 0, 0, 0);
    ATT_SB();
    bf16x8 fa[2][2], fb[2][2]; bf16x8 pfA, pfB, pfC, pfD; float mh0 = 0.f, mh1 = 0.f, ls = 0.f;
    ATT_VGRP(fa, 0, 0);
    ATT_SB();
#define ATT_PIN2(a_, b_) asm volatile("" : "+v"(a_), "+v"(b_))
#define ATT_PIN1(a_) asm volatile("" : "+v"(a_))
#define ATT_QK1(c_) do { p1 = __builtin_amdgcn_mfma_f32_32x32x16_bf16(kf[c_][1], qf[c_], p1, 0, 0, 0); sm_part<NQK, c_, MODE, MASKED>(p0, mh0, ls, pfA, pfB, kv0, qabs, hi); \
        if constexpr ((c_) + 1 < NQK) ATT_PIN2(p0, kf[((c_) + 1) % NQK][1]); else ATT_PIN2(p0, fa[0][0]); } while (0)
    ATT_QK1(0); ATT_QK1(1); ATT_QK1(2); ATT_QK1(3);
    if constexpr (NQK == 6) { ATT_QK1(4); ATT_QK1(5); }
#undef ATT_QK1
#define ATT_PVSM(frag, g_, c_, part_, nxt_) do { ATT_PV1(frag, g_, c_, pfA, pfB); sm_part<NPV, part_, MODE, MASKED>(p1, mh1, ls, pfC, pfD, kv0 + 32, qabs, hi); ATT_PIN2(p1, nxt_); } while (0)
    if constexpr (ND == 2) {
        ATT_VGRP(fb, 1, 0);
        ATT_PVSM(fa, 0, 0, 0, fa[1][0]); ATT_PVSM(fa, 0, 1, 1, fa[0][1]); ATT_PVSM(fa, 0, 2, 2, fa[1][1]); ATT_PVSM(fa, 0, 3, 3, fb[0][0]);
        ATT_PV1(fb, 0, 0, pfC, pfD); ATT_PV1(fb, 0, 1, pfC, pfD); ATT_PV1(fb, 0, 2, pfC, pfD); ATT_PV1(fb, 0, 3, pfC, pfD);
    } else {
        ATT_VGRP(fb, 0, 1);
        ATT_PVSM(fa, 0, 0, 0, fa[1][0]); ATT_PVSM(fa, 0, 1, 1, fa[0][1]); ATT_PVSM(fa, 0, 2, 2, fa[1][1]); ATT_PVSM(fa, 0, 3, 3, fb[0][0]);
        ATT_VGRP(fa, 1, 0);
        ATT_PVSM(fb, 1, 0, 4, fb[1][0]); ATT_PVSM(fb, 1, 1, 5, fb[0][1]); ATT_PVSM(fb, 1, 2, 6, fb[1][1]); ATT_PVSM(fb, 1, 3, 7, fa[0][0]);
        ATT_VGRP(fb, 1, 1);
        ATT_PV1(fa, 0, 0, pfC, pfD); ATT_PV1(fa, 0, 1, pfC, pfD); ATT_PV1(fa, 0, 2, pfC, pfD); ATT_PV1(fa, 0, 3, pfC, pfD);
        ATT_PV1(fb, 1, 0, pfC, pfD); ATT_PV1(fb, 1, 1, pfC, pfD); ATT_PV1(fb, 1, 2, pfC, pfD); ATT_PV1(fb, 1, 3, pfC, pfD);
    }
#undef ATT_PVSM
#undef ATT_PIN2
#undef ATT_PIN1
    lsum += ls;
    mxout = xhalf_max(fmaxf(mh0, mh1));
}
#undef ATT_VGRP
#undef ATT_PV1

template <int DK, int DV, int MODE, int ABL = 0>
__device__ __forceinline__ void unit(const Tens& T, int b, int qb, const float* kmean, float sink, float lam, const float* gsub, float gscale, LAS unsigned char* lds, const int tid) {
    typedef Cfg<DK, DV, MODE> G;
    asm volatile("; UNIT_BEGIN %0 %1 %2" :: "n"(DK), "n"(DV), "n"(MODE));
    const int lane = tid & 63, r32 = lane & 31, hi = lane >> 5; const int wid = __builtin_amdgcn_readfirstlane(tid >> 6);
    const int strm = (MODE == M_DIFF) ? (wid >> 2) : 0, wq = (MODE == M_DIFF) ? (wid & 3) : wid;
    const size_t rowbase = (size_t)b * SEQ;
    const int q0 = qb * G::QROWS, qw0 = q0 + wq * 32, qabs = qw0 + r32;
    bf16x8 qf[DK / 16];
    { const char* qrow = (const char*)(T.Q + (rowbase + qw0) * T.ldq + strm * DK);
      unsigned qlo = (unsigned)(r32 * T.ldq + 8 * hi) * 2u; asm volatile("" : "+v"(qlo));
#pragma unroll
      for (int d0 = 0; d0 < DK / 16; ++d0) qf[d0] = *(const bf16x8*)(qrow + qlo + 32 * d0); }
    int sel0 = -1, sel1 = -1, sel2 = -1;
    int t_lo = 0; const int t_hi = (q0 + G::QROWS) >> 6;
    if constexpr (MODE == M_SWA) t_lo = qb == 0 ? 0 : qb * 4 - 2;
    const int krow = (r32 & 0x13) | ((r32 & 4) << 1) | ((r32 & 8) >> 1);
    const unsigned koff = (unsigned)(krow * T.ldk + 8 * hi) * 2u, voff = (unsigned)((lane >> 2) * T.ldv + 8 * (lane & 3)) * 2u;
    const char* Kg = (const char*)(T.K + rowbase * T.ldk); const char* Vg = (const char*)(T.V + rowbase * T.ldv);
    const unsigned lds0 = (unsigned)(uintptr_t)lds;
#define ATT_DMA(t, bsel) do { _Pragma("unroll") for (int p_ = 0; p_ < (G::NP + 7) / 8; ++p_) { const int pc_ = wid + 8 * p_; if (pc_ < G::NP) { \
        if (pc_ < G::NKP) { const char* s_ = Kg + ((size_t)((t) * 64 + 32 * (pc_ & 1)) * T.ldk + 16 * (pc_ >> 1)) * 2; \
            glds16(s_, koff, (unsigned)__builtin_amdgcn_readfirstlane((int)(lds0 + (bsel) * G::BUF + pc_ * 1024))); } \
        else { const int pv_ = pc_ - G::NKP; const char* s_ = Vg + ((size_t)((t) * 64 + 16 * (pv_ & 3)) * T.ldv + 32 * (pv_ >> 2)) * 2; \
            glds16(s_, voff, (unsigned)__builtin_amdgcn_readfirstlane((int)(lds0 + (bsel) * G::BUF + G::KBYTES + pv_ * 1024))); } } } } while (0)
    float mref = 0.f, lsum = 0.f, mxprev = -INFINITY;
    if constexpr (MODE == M_SWA) lsum = hi == 0 ? __builtin_amdgcn_exp2f(sink) : 0.f;
    f32x16 o[DV / 32];
#pragma unroll
    for (int d = 0; d < DV / 32; ++d) o[d] = f32x16{};
    const int kfo = (strm * (DK / 16) * 2) * 1024 + hi * 512 + r32 * 16;
    const int i16 = lane & 15;
    const int vfo = G::KBYTES + (8 * hi + (i16 >> 2)) * 64 + (16 * (r32 >> 4) + 4 * (i16 & 3)) * 2;
    if constexpr (MODE == M_MOBA) {
        LAS float* ks = (LAS float*)(lds + 49152);
        if (tid < 256) { const int j = tid >> 4, d4 = (tid & 15) * 4; const f32x4 a = *(const f32x4*)(kmean + j * 128 + d4), c = *(const f32x4*)(kmean + j * 128 + 64 + d4); *(LAS f32x4*)(ks + j * 64 + d4) = a + c; }
        asm volatile("s_waitcnt lgkmcnt(0)" ::: "memory");
    }
    __builtin_amdgcn_s_barrier();
    ATT_DMA(t_lo, 0);
    if constexpr (MODE == M_MOBA) {
        float b0 = -INFINITY, b1 = -INFINITY, b2 = -INFINITY;
        float qv[32];
#pragma unroll
        for (int d0 = 0; d0 < 4; ++d0)
#pragma unroll
            for (int e = 0; e < 8; ++e) qv[8 * d0 + e] = bf2f((unsigned short)qf[d0][e]);
        const LAS float* kp = (const LAS float*)(lds + 49152) + 8 * hi;
#pragma unroll 1
        for (int j = 0; j < qb; ++j, kp += 64) {
            float a = 0.f;
#pragma unroll
            for (int d0 = 0; d0 < 4; ++d0) { const f32x4 k0 = *(const LAS f32x4*)(kp + 16 * d0), k1 = *(const LAS f32x4*)(kp + 16 * d0 + 4);
#pragma unroll
                for (int e = 0; e < 4; ++e) { a += qv[8 * d0 + e] * k0[e]; a += qv[8 * d0 + 4 + e] * k1[e]; } }
            a += shx<32>(a);
            if (a > b0) { b2 = b1; sel2 = sel1; b1 = b0; sel1 = sel0; b0 = a; sel0 = j; }
            else if (a > b1) { b2 = b1; sel2 = sel1; b1 = a; sel1 = j; }
            else if (a > b2) { b2 = a; sel2 = j; }
        }
    }
    for (int t = t_lo; t < t_hi; ++t) {
        const int bsel = (t - t_lo) & 1;
        __builtin_amdgcn_s_waitcnt(0x0F70);
        __builtin_amdgcn_s_barrier();
        if (t + 1 < t_hi) ATT_DMA(t + 1, bsel ^ 1);
        const int kv0 = t * 64;
        bool skip = kv0 > qw0 + 31;
        if constexpr (MODE == M_SWA) skip = skip || (kv0 + 63 < qw0 - 127);
        bool lane_on = true;
        if constexpr (MODE == M_MOBA) { if (kv0 < q0) { const int jb = kv0 >> 8; lane_on = (jb == sel0 || jb == sel1 || jb == sel2); skip = skip || !__any(lane_on); } }
        if (skip) continue;
        if (!__all(mxprev <= RESCALE_THR)) {
            const float dm = fmaxf(mxprev, 0.f), alpha = __builtin_amdgcn_exp2f(-dm);
            mref += dm; lsum *= alpha;
#pragma unroll
            for (int d = 0; d < DV / 32; ++d)
#pragma unroll
                for (int i = 0; i < 16; ++i) o[d][i] *= alpha;
        }
        const float cinit = lane_on ? -mref : -INFINITY;
        if constexpr (DV == 64 && ATT_INTERLEAVE) {
        const LAS unsigned char* bb = lds + bsel * G::BUF;
        bool need_mask = kv0 + 63 > qw0;
        if constexpr (MODE == M_SWA) need_mask = need_mask || (kv0 < qw0 + 31 - 127);
        if (need_mask) tile_body<DK, DV, MODE, true>(bb, kfo, vfo, qf, cinit, o, lsum, mxprev, kv0, qabs, hi);
        else tile_body<DK, DV, MODE, false>(bb, kfo, vfo, qf, cinit, o, lsum, mxprev, kv0, qabs, hi);
        } else {
        const LAS unsigned char* bb = lds + bsel * G::BUF;
        bf16x8 kf[DK / 16][2];
#pragma unroll
        for (int d0 = 0; d0 < DK / 16; ++d0) { kf[d0][0] = *(const LAS bf16x8*)(bb + kfo + (2 * d0) * 1024); kf[d0][1] = *(const LAS bf16x8*)(bb + kfo + (2 * d0 + 1) * 1024); }
        f32x16 p0, p1;
#pragma unroll
        for (int i = 0; i < 16; ++i) { p0[i] = cinit; p1[i] = cinit; }
        __builtin_amdgcn_sched_barrier(0);
#pragma unroll
        for (int d0 = 0; d0 < DK / 16; ++d0) {
            p0 = __builtin_amdgcn_mfma_f32_32x32x16_bf16(kf[d0][0], qf[d0], p0, 0, 0, 0);
            p1 = __builtin_amdgcn_mfma_f32_32x32x16_bf16(kf[d0][1], qf[d0], p1, 0, 0, 0);
        }
        __builtin_amdgcn_sched_barrier(0);
        bf16x8 vf[2][4];
#define ATT_VLOAD(dbase) do { _Pragma("unroll") for (int d_ = 0; d_ < 2; ++d_) _Pragma("unroll") for (int s2 = 0; s2 < 4; ++s2) { const LAS unsigned char* vp = bb + vfo + (4 * ((dbase) + d_) + s2) * 1024; \
            const s16x4 lo = __builtin_bit_cast(s16x4, __builtin_amdgcn_ds_read_tr16_b64_v4i16((LAS s16x4*)(vp))); const s16x4 hh = __builtin_bit_cast(s16x4, __builtin_amdgcn_ds_read_tr16_b64_v4i16((LAS s16x4*)(vp + 256))); \
            vf[d_][s2] = (bf16x8){lo[0], lo[1], lo[2], lo[3], hh[0], hh[1], hh[2], hh[3]}; } } while (0)
        ATT_VLOAD(0);
        __builtin_amdgcn_sched_barrier(0);
        bool need_mask = kv0 + 63 > qw0;
        if constexpr (MODE == M_SWA) need_mask = need_mask || (kv0 < qw0 + 31 - 127);
        if (need_mask) {
#pragma unroll
            for (int i = 0; i < 16; ++i) { const int kv = kv0 + 16 * (i >> 3) + 8 * hi + (i & 7);
                bool m0 = kv > qabs, m1 = kv + 32 > qabs;
                if constexpr (MODE == M_SWA) { m0 = m0 || (kv < qabs - 127); m1 = m1 || (kv + 32 < qabs - 127); }
                if (m0) p0[i] = -INFINITY; if (m1) p1[i] = -INFINITY; }
        }
        float mx = max3f(p0[0], p1[0], p0[1]), mxb = max3f(p1[1], p0[2], p1[2]);
#pragma unroll
        for (int i = 3; i < 15; i += 2) { mx = max3f(mx, p0[i], p1[i]); mxb = max3f(mxb, p0[i + 1], p1[i + 1]); }
        mx = max3f(mx, p0[15], p1[15]); mx = fmaxf(mx, mxb);
        mx = xhalf_max(mx);
        mxprev = mx;
        float ls0 = 0.f, ls1 = 0.f;
#pragma unroll
        for (int i = 0; i < 16; ++i) { p0[i] = __builtin_amdgcn_exp2f(p0[i]); p1[i] = __builtin_amdgcn_exp2f(p1[i]); ls0 += p0[i]; ls1 += p1[i]; }
        lsum += ls0 + ls1;
        bf16x8 pf[4];
#pragma unroll
        for (int s2 = 0; s2 < 4; ++s2) { const f32x16& pp = (s2 >> 1) ? p1 : p0; const int b0 = 8 * (s2 & 1);
            u32x4 w; w.x = cvtpk(pp[b0 + 0], pp[b0 + 1]); w.y = cvtpk(pp[b0 + 2], pp[b0 + 3]); w.z = cvtpk(pp[b0 + 4], pp[b0 + 5]); w.w = cvtpk(pp[b0 + 6], pp[b0 + 7]);
            pf[s2] = __builtin_bit_cast(bf16x8, w); }
        __builtin_amdgcn_sched_barrier(0);
        if constexpr (DV == 64) {
#pragma unroll
            for (int d = 0; d < 2; ++d)
#pragma unroll
                for (int s2 = 0; s2 < 4; ++s2) o[d] = __builtin_amdgcn_mfma_f32_32x32x16_bf16(vf[d][s2], pf[s2], o[d], 0, 0, 0);
        } else {
            bf16x8 vg[2][4];
#pragma unroll
            for (int d_ = 0; d_ < 2; ++d_)
#pragma unroll
                for (int s2 = 0; s2 < 4; ++s2) { const LAS unsigned char* vp = bb + vfo + (4 * (2 + d_) + s2) * 1024;
                    const s16x4 lo = __builtin_bit_cast(s16x4, __builtin_amdgcn_ds_read_tr16_b64_v4i16((LAS s16x4*)(vp))); const s16x4 hh = __builtin_bit_cast(s16x4, __builtin_amdgcn_ds_read_tr16_b64_v4i16((LAS s16x4*)(vp + 256)));
                    vg[d_][s2] = (bf16x8){lo[0], lo[1], lo[2], lo[3], hh[0], hh[1], hh[2], hh[3]}; }
            __builtin_amdgcn_sched_barrier(0);
#pragma unroll
            for (int d = 0; d < 2; ++d)
#pragma unroll
                for (int s2 = 0; s2 < 4; ++s2) o[d] = __builtin_amdgcn_mfma_f32_32x32x16_bf16(vf[d][s2], pf[s2], o[d], 0, 0, 0);
            __builtin_amdgcn_sched_barrier(0);
#pragma unroll
            for (int d = 0; d < 2; ++d)
#pragma unroll
                for (int s2 = 0; s2 < 4; ++s2) o[2 + d] = __builtin_amdgcn_mfma_f32_32x32x16_bf16(vg[d][s2], pf[s2], o[2 + d], 0, 0, 0);
        }
        }
    }
#undef ATT_DMA
    const float inv = 1.0f / xhalf_sum(lsum);
    if constexpr (MODE == M_DIFF) {
        LAS float* xch = (LAS float*)lds;
        __builtin_amdgcn_s_barrier();
        if (strm == 1) {
#pragma unroll
            for (int d = 0; d < DV / 32; ++d)
#pragma unroll
                for (int i = 0; i < 16; ++i) xch[((wq * (DV / 32) + d) * 16 + i) * 64 + lane] = o[d][i] * inv;
        }
        asm volatile("s_waitcnt lgkmcnt(0)" ::: "memory");
        __builtin_amdgcn_s_barrier();
        if (strm == 0) {
            float ss = 0.f;
#pragma unroll
            for (int d = 0; d < DV / 32; ++d)
#pragma unroll
                for (int i = 0; i < 16; ++i) { const float v = o[d][i] * inv - lam * xch[((wq * (DV / 32) + d) * 16 + i) * 64 + lane]; o[d][i] = v; ss += v * v; }
            ss = xhalf_sum(ss);
            const float rr = gscale / sqrtf(ss * (1.0f / DV) + 1e-5f);
            char* orow = (char*)(T.O + (rowbase + qw0) * T.ldo); unsigned olo = (unsigned)(r32 * T.ldo + 4 * hi) * 2u; asm volatile("" : "+v"(olo)); bf16_t* op = (bf16_t*)(orow + olo);
#pragma unroll
            for (int d = 0; d < DV / 32; ++d)
#pragma unroll
                for (int g4 = 0; g4 < 4; ++g4) { const f32x4 gg = *(const f32x4*)(gsub + 32 * d + 8 * g4 + 4 * hi);
                    u32x2 w; w.x = cvtpk(o[d][4 * g4] * rr * gg[0], o[d][4 * g4 + 1] * rr * gg[1]); w.y = cvtpk(o[d][4 * g4 + 2] * rr * gg[2], o[d][4 * g4 + 3] * rr * gg[3]); *(u32x2*)(op + 32 * d + 8 * g4) = w; }
        }
    } else {
        char* orow = (char*)(T.O + (rowbase + qw0) * T.ldo); unsigned olo = (unsigned)(r32 * T.ldo + 4 * hi) * 2u; asm volatile("" : "+v"(olo)); bf16_t* op = (bf16_t*)(orow + olo);
#pragma unroll
        for (int d = 0; d < DV / 32; ++d)
#pragma unroll
            for (int g4 = 0; g4 < 4; ++g4) { u32x2 w; w.x = cvtpk(o[d][4 * g4] * inv, o[d][4 * g4 + 1] * inv); w.y = cvtpk(o[d][4 * g4 + 2] * inv, o[d][4 * g4 + 3] * inv); *(u32x2*)(op + 32 * d + 8 * g4) = w; }
    }
}
}
constexpr int NWAVES = 8, NTHREADS = 512;
constexpr size_t MiB = 1u << 20;
constexpr size_t WS_CTL = 0, CTL_ZERO_BYTES = 1 * MiB;
constexpr size_t WS_SMALLW = 1 * MiB;
constexpr size_t SW_LAYER = 8 * MiB, SW_WOUT = 4608 * 1024, SW_WQB = SW_WOUT + 2 * MiB, SW_WKVB = SW_WQB + 384 * 1024;
static_assert(SW_WKVB + 512 * 1024 <= SW_LAYER, "small weights");
constexpr size_t WS_WR = WS_SMALLW + 4 * SW_LAYER;
constexpr size_t WS_ROPE = WS_WR + 4 * MiB;
constexpr size_t WS_KMEAN = WS_ROPE + 8 * MiB;
constexpr size_t WS_WGU = WS_KMEAN + 1 * MiB;
constexpr size_t WS_WD = WS_WGU + 65 * MiB;
constexpr size_t WS_ROWTOK = WS_WD + 33 * MiB;
constexpr size_t WS_WSLOT = WS_ROWTOK + 8 * MiB;
constexpr size_t WS_TOKE = WS_WSLOT + 8 * MiB;
constexpr size_t WS_TOKP = WS_TOKE + 1 * MiB;
constexpr size_t WS_XF = WS_TOKP + 1 * MiB;
constexpr size_t WS_HS = WS_XF + 128 * MiB;
constexpr size_t WS_YS = WS_HS + 152 * MiB;
constexpr size_t WS_END = WS_YS + 544 * MiB;
static_assert(WS_END <= 1024 * MiB, "workspace map exceeds 1 GiB");
constexpr size_t A_HB = WS_YS;
constexpr size_t A_QF = A_HB, A_KVF = A_HB + 48 * MiB;
constexpr size_t A_SSQ = A_HB;
constexpr size_t A_Q1 = A_HB + 144 * MiB;
constexpr size_t A_K1 = A_Q1 + 32 * MiB;
constexpr size_t A_V1 = A_K1 + 32 * MiB;
constexpr size_t A_X1 = A_V1 + 32 * MiB;
constexpr size_t A_X2 = A_X1 + 32 * MiB;
constexpr size_t A_Q2 = A_X2 + 32 * MiB;
constexpr size_t A_OB = A_Q2 + 128 * MiB;
static_assert(A_OB + 64 * MiB <= WS_END, "attention overlay");
constexpr size_t A_XS = WS_YS;
constexpr size_t A_LOG = WS_YS + 128 * MiB;
constexpr int CW_BAR = 4096;
constexpr int CW_CNT = 16384;
constexpr int RING_BYTES = 131072;
constexpr int LX_BAR = RING_BYTES;
constexpr int LX_CNT = RING_BYTES + 64;
constexpr int LX_TST = LX_CNT + 256;
constexpr int LX_TEXP = LX_TST + 320;
constexpr int LDS_BYTES = 147456;
static_assert(LX_TEXP + 1280 <= LDS_BYTES, "LDS map");

#define XB_TMO      128
#define XB_XCNT(j)  (256  + 64 * (j))
#define XB_XSUB(j)  (1280 + 64 * (j))
#define XB_XGEN(j)  (2304 + 64 * (j))
#define XB_TOP      3328
#define XB_TOPGEN   3392
#define XCD_BAR_WORDS 3456
#define XB_SPIN_CAP (1u << 20)
__device__ __forceinline__ unsigned xb_ld(unsigned* p)              { return __hip_atomic_load(p, __ATOMIC_RELAXED, __HIP_MEMORY_SCOPE_AGENT); }
__device__ __forceinline__ unsigned xb_add(unsigned* p, unsigned v) { return __hip_atomic_fetch_add(p, v, __ATOMIC_RELAXED, __HIP_MEMORY_SCOPE_AGENT); }
__device__ __forceinline__ unsigned xb_xcc_id() { return (unsigned)__builtin_amdgcn_s_getreg((3 << 11) | 20) & 0xFu; }
#define XB_SPIN(cond, bar) do { unsigned _sp = 0; while (cond) { __builtin_amdgcn_s_sleep(1); \
    if ((++_sp & 255u) == 0u) { if (xb_ld(&(bar)[XB_TMO])) break; if (_sp > XB_SPIN_CAP) { atomicAdd(&(bar)[XB_TMO], 1u); break; } } } } while (0)
struct XcdBarrier { unsigned* bar; unsigned x; volatile LAS unsigned* st; };
__device__ __forceinline__ XcdBarrier xcd_barrier_post(unsigned* bar, volatile LAS unsigned* st) {
    XcdBarrier b; b.bar = bar; b.x = xb_xcc_id(); b.st = st;
    if (threadIdx.x == 0) (void)xb_add(&bar[XB_XCNT(b.x)], 1u);
    return b;
}
__device__ __forceinline__ void xcd_barrier_complete(unsigned* bar, unsigned x, unsigned& nloc, unsigned& nx) {
    const unsigned G = gridDim.x * gridDim.y * gridDim.z;
    unsigned sum, cnt, mine, sp = 0u;
    for (;;) {
        sum = 0u; cnt = 0u; mine = 0u;
#pragma unroll
        for (unsigned j = 0; j < 16; ++j) { const unsigned c = xb_ld(&bar[XB_XCNT(j)]); sum += c; cnt += (c > 0u) ? 1u : 0u; mine = (j == x) ? c : mine; }
        if (sum == G) break;
        __builtin_amdgcn_s_sleep(1);
        if ((++sp & 255u) == 0u) { if (xb_ld(&bar[XB_TMO])) break; if (sp > XB_SPIN_CAP) { atomicAdd(&bar[XB_TMO], 1u); break; } }
    }
    nloc = mine > 0u ? mine : 1u; nx = cnt > 0u ? cnt : 1u;
}
__device__ __forceinline__ void xcd_barrier(const XcdBarrier& b, const bool leader) {
    asm volatile("s_waitcnt vmcnt(0)" ::: "memory");
    __syncthreads();
    if (leader) {
        unsigned* bar = b.bar; const unsigned bx = xb_xcc_id();
        __builtin_amdgcn_s_waitcnt(0);
        unsigned nloc = b.st[0], nx = b.st[1];
        if (nloc == 0u) { xcd_barrier_complete(bar, bx, nloc, nx); b.st[0] = nloc; b.st[1] = nx; }
        const unsigned old = xb_add(&bar[XB_XSUB(bx)], 1u);
        const unsigned gen = old / nloc;
        if (old + 1u == (gen + 1u) * nloc) {
            __builtin_amdgcn_fence(__ATOMIC_RELEASE, "agent");
            asm volatile("s_waitcnt vmcnt(0)" ::: "memory");
            const unsigned og = xb_add(&bar[XB_TOP], 1u);
            const unsigned tg = og / nx;
            if (og + 1u == (tg + 1u) * nx) xb_add(&bar[XB_TOPGEN], 1u);
            else XB_SPIN(xb_ld(&bar[XB_TOPGEN]) == tg, bar);
            __builtin_amdgcn_fence(__ATOMIC_ACQUIRE, "agent");
            xb_add(&bar[XB_XGEN(bx)], 1u);
            asm volatile("s_waitcnt vmcnt(0)" ::: "memory");
        } else {
            XB_SPIN(xb_ld(&bar[XB_XGEN(bx)]) == gen, bar);
            __builtin_amdgcn_fence(__ATOMIC_ACQUIRE, "agent");
            asm volatile("s_waitcnt vmcnt(0)" ::: "memory");
        }
    }
    __syncthreads();
}

struct Args {
    const float* x; const int* pos;
    const float *ev_w_in, *ev_w_out, *mla_g_qa, *mla_w_qb, *mla_g_kva, *mla_w_kvb, *od_w_in, *od_w_out, *swa_sinks, *diff_lambda, *diff_g_subln, *ln_g, *ln_b,
                *moe_w_router, *moe_bias, *moe_w_gate, *moe_w_up, *moe_w_down, *sh_w_gate, *sh_w_up, *sh_w_down;
    float* out; unsigned char* ws;
    int st_lo, st_hi, use_bar, pad;
};

__device__ __forceinline__ int wrow_map(int mode, int n);
__device__ __forceinline__ void transpose_item(const float* W, int N, int k0, int n0, bf16_t* WT, int ldk, int dst_row0, LAS float* scr, int lane, int mode = 0) {
#pragma unroll 8
    for (int i = 0; i < 32; ++i) { const int kk = 2 * i + (lane >> 5); scr[kk * 33 + (lane & 31)] = W[(size_t)(k0 + kk) * N + n0 + (lane & 31)]; }
    asm volatile("s_waitcnt lgkmcnt(0)" ::: "memory");
    const int c = lane & 7;
#pragma unroll
    for (int j = 0; j < 4; ++j) { const int n = (lane >> 3) + 8 * j; const LAS float* s = scr + (8 * c) * 33 + n;
        u32x4 o; o.x = pk2(s[0 * 33], s[1 * 33]); o.y = pk2(s[2 * 33], s[3 * 33]); o.z = pk2(s[4 * 33], s[5 * 33]); o.w = pk2(s[6 * 33], s[7 * 33]);
        const int drow = mode ? wrow_map(mode, n0 + n) : dst_row0 + n;
        *(u32x4*)(WT + (size_t)drow * ldk + k0 + 8 * c) = o; }
    asm volatile("s_waitcnt lgkmcnt(0)" ::: "memory");
}
__device__ __forceinline__ void sincos_acc(float angf, float& c, float& s) {
    const double x = (double)angf;
    const double n = __builtin_rint(x * 0.63661977236758134308);
    double r = x - n * 1.57079632679489655800; r -= n * 6.12323399573676603587e-17;
    const long q = (long)n;
    const double r2 = r * r;
    double sp = -2.5052108385441718775e-08; sp = sp * r2 + 2.7557319223985890653e-06; sp = sp * r2 - 1.9841269841269841270e-04; sp = sp * r2 + 8.3333333333333333333e-03; sp = sp * r2 - 1.6666666666666666667e-01;
    const double sn = r + r * r2 * sp;
    double cp = 2.0876756987868098979e-09; cp = cp * r2 - 2.7557319223985890653e-07; cp = cp * r2 + 2.4801587301587301587e-05; cp = cp * r2 - 1.3888888888888888889e-03; cp = cp * r2 + 4.1666666666666666667e-02; cp = cp * r2 - 0.5;
    const double cs = 1.0 + r2 * cp;
    double so, co;
    switch ((int)(q & 3)) { case 0: so = sn; co = cs; break; case 1: so = cs; co = -sn; break; case 2: so = -sn; co = -cs; break; default: so = -cs; co = sn; break; }
    s = (float)so; c = (float)co;
}
__host__ __device__ __forceinline__ int perm64(int f) { const int n = f >> 5, r = f & 31, G = r >> 4, fq = (r & 15) >> 2, i = r & 3; return 32 * G + 8 * fq + 4 * n + i; }
__host__ __device__ __forceinline__ int perm_pe(int f) { const int n = f >> 4, r = f & 15, fq = r >> 2, i = r & 3; return 8 * fq + 4 * n + i; }
__device__ __forceinline__ int wrow_map(int mode, int n) {
    if (mode == 1) { if (n < 1024) return (n & ~63) + perm64(n & 63); if (n >= 1920) return 1920 + perm_pe(n - 1920); return n; }
    if (mode == 2) { if (n < 640 || (n >= 768 && n < 1792)) return (n & ~63) + perm64(n & 63); return n; }
    if (mode == 3) { const int h = n / 96, w = n - 96 * h; return w < 64 ? n : 96 * h + 64 + perm_pe(w - 64); }
    return n;
}
constexpr float QS_64 = 0.125f * LOG2E;
constexpr float QS_96 = 0.10206207261596577f * LOG2E;

__device__ __forceinline__ u32x2 pack4(float a, float b, float c, float d) { u32x2 w; w.x = pg8::cvt_pk_bf16(a, b); w.y = pg8::cvt_pk_bf16(c, d); return w; }
__device__ __forceinline__ u32x4 pack8(const f32x4& v0, const f32x4& v1) { u32x4 w; w.x = pg8::cvt_pk_bf16(v0[0], v0[1]); w.y = pg8::cvt_pk_bf16(v0[2], v0[3]); w.z = pg8::cvt_pk_bf16(v1[0], v1[1]); w.w = pg8::cvt_pk_bf16(v1[2], v1[3]); return w; }

struct EpiWin {
    static constexpr bool PERM = true;
    unsigned char* ws; int even; const float* g_qa; const float* g_kva;
    __device__ __forceinline__ void rope_half(const f32x4 (&acc)[2][2][4][2], int bj, const pg8::Unit& u, int rowl, int wr, int wc, int fr, int fq, bf16_t* dst, int ld, int head0, float sc, bool km) const {
        const f32x2* rope = (const f32x2*)(ws + WS_ROPE);
        const int head = head0 + (wc >> 1), G = wc & 1, f0 = 16 * G + 4 * fq;
        float s1[4] = {0.f, 0.f, 0.f, 0.f}, s2[4] = {0.f, 0.f, 0.f, 0.f};
#pragma unroll
        for (int ai = 0; ai < 2; ++ai)
#pragma unroll
            for (int m = 0; m < 4; ++m) { const size_t r = (size_t)(u.orow + rowl + ai * 128 + m * 16);
                const f32x4 c01 = *(const f32x4*)(rope + r * 32 + f0), c23 = *(const f32x4*)(rope + r * 32 + f0 + 2);
                const f32x4 x1 = acc[ai][bj][m][0], x2 = acc[ai][bj][m][1];
                float o1[4], o2[4];
                o1[0] = x1[0] * c01[0] - x2[0] * c01[1]; o2[0] = x2[0] * c01[0] + x1[0] * c01[1];
                o1[1] = x1[1] * c01[2] - x2[1] * c01[3]; o2[1] = x2[1] * c01[2] + x1[1] * c01[3];
                o1[2] = x1[2] * c23[0] - x2[2] * c23[1]; o2[2] = x2[2] * c23[0] + x1[2] * c23[1];
                o1[3] = x1[3] * c23[2] - x2[3] * c23[3]; o2[3] = x2[3] * c23[2] + x1[3] * c23[3];
                bf16_t* dp = dst + r * ld + 64 * head + f0;
                *(u32x2*)dp = pack4(o1[0] * sc, o1[1] * sc, o1[2] * sc, o1[3] * sc); *(u32x2*)(dp + 32) = pack4(o2[0] * sc, o2[1] * sc, o2[2] * sc, o2[3] * sc);
                if (km) {
#pragma unroll
                    for (int i = 0; i < 4; ++i) { s1[i] += o1[i]; s2[i] += o2[i]; } } }
        if (km) {
#pragma unroll
            for (int i = 0; i < 4; ++i) {
                s1[i] += shx<1>(s1[i]); s1[i] += shx<2>(s1[i]); s1[i] += shx<4>(s1[i]); s1[i] += shx<8>(s1[i]);
                s2[i] += shx<1>(s2[i]); s2[i] += shx<2>(s2[i]); s2[i] += shx<4>(s2[i]); s2[i] += shx<8>(s2[i]); }
            if (fr == 0) { const int t = u.orow >> 8, b = t >> 4, j = t & 15; float* kp = (float*)(ws + WS_KMEAN) + ((((size_t)b * 8 + head) * 16 + j) * 2 + wr) * 64 + f0;
                *(f32x4*)kp = (f32x4){s1[0], s1[1], s1[2], s1[3]}; *(f32x4*)(kp + 32) = (f32x4){s2[0], s2[1], s2[2], s2[3]}; }
        }
    }
    __device__ __forceinline__ void plain_half(const f32x4 (&acc)[2][2][4][2], int bj, const pg8::Unit& u, int rowl, int wc, int fq, bf16_t* dst, int ld) const {
#pragma unroll
        for (int ai = 0; ai < 2; ++ai)
#pragma unroll
            for (int m = 0; m < 4; ++m) { const size_t r = (size_t)(u.orow + rowl + ai * 128 + m * 16); *(u32x4*)(dst + r * ld + 32 * wc + 8 * fq) = pack8(acc[ai][bj][m][0], acc[ai][bj][m][1]); }
    }
    __device__ __forceinline__ void lat_half(const f32x4 (&acc)[2][2][4][2], int bj, const pg8::Unit& u, int rowl, int wc, int fq, bf16_t* dst, int col0, const float* g, float* ssq, int nparts, int part) const {
        const int c = col0 + 32 * wc + 8 * fq; const f32x4 g0 = *(const f32x4*)(g + c), g1 = *(const f32x4*)(g + c + 4);
#pragma unroll
        for (int ai = 0; ai < 2; ++ai)
#pragma unroll
            for (int m = 0; m < 4; ++m) { const size_t r = (size_t)(u.orow + rowl + ai * 128 + m * 16); const f32x4 x0 = acc[ai][bj][m][0], x1 = acc[ai][bj][m][1];
                float ss = (x0[0] * x0[0] + x0[1] * x0[1]) + (x0[2] * x0[2] + x0[3] * x0[3]) + (x1[0] * x1[0] + x1[1] * x1[1]) + (x1[2] * x1[2] + x1[3] * x1[3]);
                ss += shx<16>(ss); ss += shx<32>(ss);
                *(u32x4*)(dst + r * 256 + c) = pack8(x0 * g0, x1 * g1);
                if (fq == 0) ssq[r * nparts + part] = ss; }
    }
    __device__ __forceinline__ void operator()(const f32x4 (&acc)[2][2][4][2], const pg8::Unit& u, int wr, int wc, int fr, int fq) const {
        const int rowl = wr * 64 + fr;
#pragma unroll
        for (int bj = 0; bj < 2; ++bj) {
            const int hk = (u.ocol >> 7) + bj;
            if (even) {
                if (hk < 4) rope_half(acc, bj, u, rowl, wr, wc, fr, fq, (bf16_t*)(ws + A_Q1), 512, 2 * hk, QS_64, false);
                else if (hk < 8) rope_half(acc, bj, u, rowl, wr, wc, fr, fq, (bf16_t*)(ws + A_K1), 512, 2 * (hk - 4), 1.0f, true);
                else if (hk < 12) plain_half(acc, bj, u, rowl, wc, fq, (bf16_t*)(ws + A_V1) + 128 * (hk - 8), 512);
                else if (hk < 14) lat_half(acc, bj, u, rowl, wc, fq, (bf16_t*)(ws + A_X1), 128 * (hk - 12), g_qa, (float*)(ws + A_SSQ), 8, 4 * (hk - 12) + wc);
                else if (hk == 14) lat_half(acc, bj, u, rowl, wc, fq, (bf16_t*)(ws + A_X1 + 16 * MiB), 0, g_kva, (float*)(ws + A_SSQ + 1 * MiB), 4, wc);
                else {
                    bf16_t* kvlat = (bf16_t*)(ws + A_X1 + 16 * MiB); bf16_t* Kb = (bf16_t*)(ws + A_Q2 + 48 * MiB); const f32x2* rope = (const f32x2*)(ws + WS_ROPE);
                    unsigned z0 = 0u; asm volatile("" : "+v"(z0));
#pragma unroll
                    for (int ai = 0; ai < 2; ++ai)
#pragma unroll
                        for (int m = 0; m < 4; ++m) { const size_t r = (size_t)(u.orow + rowl + ai * 128 + m * 16);
                            *(u32x4*)(kvlat + r * 256 + 128 + 32 * wc + 8 * fq) = (u32x4){z0, z0, z0, z0};
                            if (wc == 0) { const f32x4 x1 = acc[ai][bj][m][0], x2 = acc[ai][bj][m][1]; const f32x2* rt = rope + r * 32 + 8 * fq;
                                const f32x2 c0 = rt[0], c1 = rt[2], c2 = rt[4], c3 = rt[6];
                                const u32x2 w1 = pack4(x1[0] * c0.x - x2[0] * c0.y, x1[1] * c1.x - x2[1] * c1.y, x1[2] * c2.x - x2[2] * c2.y, x1[3] * c3.x - x2[3] * c3.y);
                                const u32x2 w2 = pack4(x2[0] * c0.x + x1[0] * c0.y, x2[1] * c1.x + x1[1] * c1.y, x2[2] * c2.x + x1[2] * c2.y, x2[3] * c3.x + x1[3] * c3.y);
#pragma unroll
                                for (int hh = 0; hh < 8; ++hh) { bf16_t* kp = Kb + r * 768 + 96 * hh + 64 + 4 * fq; *(u32x2*)kp = w1; *(u32x2*)(kp + 16) = w2; } } }
                }
            } else {
                if (hk < 4) rope_half(acc, bj, u, rowl, wr, wc, fr, fq, (bf16_t*)(ws + A_Q1), 512, 2 * hk, QS_64, false);
                else if (hk == 4) rope_half(acc, bj, u, rowl, wr, wc, fr, fq, (bf16_t*)(ws + A_K1), 128, 0, 1.0f, false);
                else if (hk == 5) plain_half(acc, bj, u, rowl, wc, fq, (bf16_t*)(ws + A_K1 + 8 * MiB), 128);
                else if (hk < 10) rope_half(acc, bj, u, rowl, wr, wc, fr, fq, (bf16_t*)(ws + A_V1), 512, 2 * (hk - 6), QS_64, false);
                else if (hk < 14) rope_half(acc, bj, u, rowl, wr, wc, fr, fq, (bf16_t*)(ws + A_X1), 512, 2 * (hk - 10), 1.0f, false);
                else plain_half(acc, bj, u, rowl, wc, fq, (bf16_t*)(ws + A_X2) + 128 * (hk - 14), 512);
            }
        }
    }
};
struct EpiMlaQ {
    static constexpr bool PERM = true;
    unsigned char* ws;
    __device__ __forceinline__ void operator()(const f32x4 (&acc)[2][2][4][2], const pg8::Unit& u, int wr, int wc, int fr, int fq) const {
        const int rowl = wr * 64 + fr; bf16_t* Qb = (bf16_t*)(ws + A_Q2); const float* ssq = (const float*)(ws + A_SSQ); const f32x2* rope = (const f32x2*)(ws + WS_ROPE);
#pragma unroll
        for (int ai = 0; ai < 2; ++ai)
#pragma unroll
            for (int m = 0; m < 4; ++m) { const size_t r = (size_t)(u.orow + rowl + ai * 128 + m * 16);
                const f32x4 q0 = *(const f32x4*)(ssq + r * 8), q1 = *(const f32x4*)(ssq + r * 8 + 4);
                const float rr = QS_96 / sqrtf(((q0[0] + q0[1]) + (q0[2] + q0[3]) + (q1[0] + q1[1]) + (q1[2] + q1[3])) * (1.0f / 256.0f) + 1e-6f);
#pragma unroll
                for (int bj = 0; bj < 2; ++bj) { const int gidx = (u.ocol >> 5) + 4 * bj + wc, head = gidx / 3, part = gidx - 3 * head;
                    const f32x4 x1 = acc[ai][bj][m][0] * rr, x2 = acc[ai][bj][m][1] * rr;
                    if (part < 2) *(u32x4*)(Qb + r * 768 + 96 * head + 32 * part + 8 * fq) = pack8(x1, x2);
                    else { const f32x2* rt = rope + r * 32 + 8 * fq; const f32x2 c0 = rt[0], c1 = rt[2], c2 = rt[4], c3 = rt[6]; bf16_t* qp = Qb + r * 768 + 96 * head + 64 + 4 * fq;
                        *(u32x2*)qp = pack4(x1[0] * c0.x - x2[0] * c0.y, x1[1] * c1.x - x2[1] * c1.y, x1[2] * c2.x - x2[2] * c2.y, x1[3] * c3.x - x2[3] * c3.y);
                        *(u32x2*)(qp + 16) = pack4(x2[0] * c0.x + x1[0] * c0.y, x2[1] * c1.x + x1[1] * c1.y, x2[2] * c2.x + x1[2] * c2.y, x2[3] * c3.x + x1[3] * c3.y); } } }
    }
};
struct EpiMlaKV {
    static constexpr bool PERM = true;
    unsigned char* ws;
    __device__ __forceinline__ void operator()(const f32x4 (&acc)[2][2][4][2], const pg8::Unit& u, int wr, int wc, int fr, int fq) const {
        const int rowl = wr * 64 + fr; bf16_t* Kb = (bf16_t*)(ws + A_Q2 + 48 * MiB); bf16_t* Vb = (bf16_t*)(ws + A_Q2 + 96 * MiB); const float* ssq = (const float*)(ws + A_SSQ + 1 * MiB);
#pragma unroll
        for (int ai = 0; ai < 2; ++ai)
#pragma unroll
            for (int m = 0; m < 4; ++m) { const size_t r = (size_t)(u.orow + rowl + ai * 128 + m * 16);
                const f32x4 q0 = *(const f32x4*)(ssq + r * 4);
                const float rr = 1.0f / sqrtf(((q0[0] + q0[1]) + (q0[2] + q0[3])) * (1.0f / 128.0f) + 1e-6f);
#pragma unroll
                for (int bj = 0; bj < 2; ++bj) { const int gidx = (u.ocol >> 5) + 4 * bj + wc, head = gidx >> 2, part = gidx & 3;
                    const u32x4 w = pack8(acc[ai][bj][m][0] * rr, acc[ai][bj][m][1] * rr);
                    if (part < 2) *(u32x4*)(Kb + r * 768 + 96 * head + 32 * part + 8 * fq) = w; else *(u32x4*)(Vb + r * 512 + 64 * head + 32 * (part - 2) + 8 * fq) = w; } }
    }
};

constexpr float YS_SCALE = 64.0f;
__device__ __forceinline__ unsigned pk_fp8x4(float a, float b, float c, float d) {
    a = fminf(fmaxf(a, -440.f), 440.f); b = fminf(fmaxf(b, -440.f), 440.f); c = fminf(fmaxf(c, -440.f), 440.f); d = fminf(fmaxf(d, -440.f), 440.f);
    int w = __builtin_amdgcn_cvt_pk_fp8_f32(a, b, 0, false); w = __builtin_amdgcn_cvt_pk_fp8_f32(c, d, w, true); return (unsigned)w; }
struct EpiDownAll {
    static constexpr bool PERM = true;
    unsigned char* ws;
    __device__ __forceinline__ void operator()(const f32x4 (&acc)[2][2][4][2], const pg8::Unit& u, int wr, int wc, int fr, int fq) const {
        const int rowl = wr * 64 + fr, c0 = u.ocol + 32 * wc + 8 * fq;
        if (u.e == 64) { float* xf = (float*)(ws + WS_XF);
#pragma unroll
            for (int ai = 0; ai < 2; ++ai)
#pragma unroll
                for (int m = 0; m < 4; ++m) { float* rp = xf + (size_t)(u.lt * 256 + rowl + ai * 128 + m * 16) * DM + c0;
#pragma unroll
                    for (int bj = 0; bj < 2; ++bj) { const f32x4 s0 = *(const f32x4*)(rp + bj * 128), s1 = *(const f32x4*)(rp + bj * 128 + 4);
                        *(f32x4*)(rp + bj * 128) = s0 * DN_ALPHA + acc[ai][bj][m][0]; *(f32x4*)(rp + bj * 128 + 4) = s1 * DN_ALPHA + acc[ai][bj][m][1]; } }
        } else { unsigned char* Y8 = ws + WS_YS;
#pragma unroll
            for (int ai = 0; ai < 2; ++ai)
#pragma unroll
                for (int m = 0; m < 4; ++m) { unsigned char* rp = Y8 + (size_t)(u.orow + rowl + ai * 128 + m * 16) * DM + c0;
#pragma unroll
                    for (int bj = 0; bj < 2; ++bj) { const f32x4 v0 = acc[ai][bj][m][0] * YS_SCALE, v1 = acc[ai][bj][m][1] * YS_SCALE;
                        u32x2 w; w.x = pk_fp8x4(v0[0], v0[1], v0[2], v0[3]); w.y = pk_fp8x4(v1[0], v1[1], v1[2], v1[3]); *(u32x2*)(rp + bj * 128) = w; } }
        }
    }
};
struct Ctx {
    LAS unsigned char* lds; unsigned char* ws; int tid, lane, wave, G, bid, gw, NGW;
};
#define WSP(T, off) ((T*)(C.ws + (off)))

__device__ __forceinline__ void phase_convert(const Ctx& C, const Args& a, int L) {
    LAS float* scr = (LAS float*)(C.lds + C.wave * 16384);
    {
        constexpr int IT_G = (1024 / 64) * (256 / 32);
        constexpr int IT_D = (256 / 64) * (1024 / 32);
        const int total = 65 * (2 * IT_G + IT_D);
        bf16_t* Wgu = WSP(bf16_t, WS_WGU); bf16_t* Wd = WSP(bf16_t, WS_WD);
        for (int it = C.gw; it < total; it += C.NGW) {
            const int e = it / (2 * IT_G + IT_D); int r = it % (2 * IT_G + IT_D);
            if (r < 2 * IT_G) {
                const int up = r >= IT_G; if (up) r -= IT_G;
                const float* W = e < 64 ? (up ? a.moe_w_up : a.moe_w_gate) + ((size_t)L * 64 + e) * 1024 * 256 : (up ? a.sh_w_up : a.sh_w_gate) + (size_t)L * 1024 * 256;
                const int kb = r / 8, nb = r % 8, n0 = nb * 32;
                transpose_item(W, 256, kb * 64, n0, Wgu + (size_t)e * 512 * 1024, 1024, (n0 >> 7) * 256 + up * 128 + (n0 & 127), scr, C.lane);
            } else {
                r -= 2 * IT_G;
                const float* W = e < 64 ? a.moe_w_down + ((size_t)L * 64 + e) * 256 * 1024 : a.sh_w_down + (size_t)L * 256 * 1024;
                const int kb = r / 32, nb = r % 32, n0 = nb * 32;
                transpose_item(W, 1024, kb * 64, n0, Wd + (size_t)e * 1024 * 256, 256, n0, scr, C.lane);
            }
        }
    }
}
__device__ __forceinline__ void phase_init(const Ctx& C, const Args& a) {
    LAS float* scr = (LAS float*)(C.lds + C.wave * 16384);
    for (int l = 0; l < DEPTH; ++l) {
        const int i = l >> 1; const bool even = !(l & 1);
        bf16_t* Win = WSP(bf16_t, WS_SMALLW + l * SW_LAYER); bf16_t* Wout = WSP(bf16_t, WS_SMALLW + l * SW_LAYER + SW_WOUT);
        const int nin = even ? EV_IN : OD_IN;
        const float* win = even ? a.ev_w_in + (size_t)i * 1024 * EV_IN : a.od_w_in + (size_t)i * 1024 * OD_IN;
        const float* wout = even ? a.ev_w_out + (size_t)i * 1024 * 1024 : a.od_w_out + (size_t)i * 1024 * 1024;
        const int it_in = 16 * (nin / 32), it_out = 16 * 32;
        for (int it = C.gw; it < it_in + it_out; it += C.NGW) {
            if (it < it_in) { const int kb = it / (nin / 32), nb = it % (nin / 32); transpose_item(win, nin, kb * 64, nb * 32, Win, 1024, nb * 32, scr, C.lane, even ? 1 : 2); }
            else { const int r = it - it_in, kb = r / 32, nb = r % 32; transpose_item(wout, 1024, kb * 64, nb * 32, Wout, 1024, nb * 32, scr, C.lane); }
        }
        if (even) {
            for (int idx = C.bid * NTHREADS + C.tid; idx < (2048 - EV_IN) * 1024 / 8; idx += C.G * NTHREADS) *(u32x4*)(Win + (size_t)EV_IN * 1024 + (size_t)idx * 8) = (u32x4){0u, 0u, 0u, 0u};
            bf16_t* Wqb = WSP(bf16_t, WS_SMALLW + l * SW_LAYER + SW_WQB); bf16_t* Wkvb = WSP(bf16_t, WS_SMALLW + l * SW_LAYER + SW_WKVB);
            const float* wqb = a.mla_w_qb + (size_t)i * 256 * 768; const float* wkvb = a.mla_w_kvb + (size_t)i * 128 * 1024;
            const int it_q = 4 * 24, it_kv = 2 * 32;
            for (int it = C.gw; it < it_q + it_kv; it += C.NGW) {
                if (it < it_q) { const int kb = it / 24, nb = it % 24; transpose_item(wqb, 768, kb * 64, nb * 32, Wqb, 256, nb * 32, scr, C.lane, 3); }
                else { const int r = it - it_q, kb = r / 32, nb = r % 32; transpose_item(wkvb, 1024, kb * 64, nb * 32, Wkvb, 256, nb * 32, scr, C.lane); }
            }
            for (int idx = C.bid * NTHREADS + C.tid; idx < 1024 * 16; idx += C.G * NTHREADS) { const int row = idx >> 4, ch = idx & 15; *(u32x4*)(Wkvb + (size_t)row * 256 + 128 + ch * 8) = (u32x4){0u, 0u, 0u, 0u}; }
        }
        bf16_t* Wr = WSP(bf16_t, WS_WR + (size_t)l * MiB); const float* wr = a.moe_w_router + (size_t)l * 1024 * 64;
        for (int idx = C.bid * NTHREADS + C.tid; idx < 256 * 2048; idx += C.G * NTHREADS) {
            const int n = idx >> 11, k = idx & 2047; unsigned v = 0;
            if (n < 128) { const int e = n & 63, kk = k & 1023; const float w = wr[(size_t)kk * 64 + e]; const unsigned wh = f2bf(w);
                if (n < 64) v = wh; else if (k < 1024) v = f2bf(w - bf2f(wh)); }
            Wr[idx] = (bf16_t)v;
        }
    }
    { f32x2* rope = WSP(f32x2, WS_ROPE);
      for (int idx = C.bid * NTHREADS + C.tid; idx < NTOK * 32; idx += C.G * NTHREADS) { const int tok = idx >> 5, j = idx & 31;
          const float inv = (float)exp2(-(double)j * (13.287712379549449 / 32.0));
          const float ang = (float)a.pos[tok] * inv; float cs, sn; sincos_acc(ang, cs, sn); rope[idx] = (f32x2){cs, sn}; } }
    { bf16_t* xb = WSP(bf16_t, WS_HS);
      for (size_t idx = (size_t)C.bid * NTHREADS + C.tid; idx < (size_t)NTOK * DM / 8; idx += (size_t)C.G * NTHREADS) { const f32x4 v0 = *(const f32x4*)(a.x + idx * 8), v1 = *(const f32x4*)(a.x + idx * 8 + 4);
          u32x4 o; o.x = pk2(v0[0], v0[1]); o.y = pk2(v0[2], v0[3]); o.z = pk2(v1[0], v1[1]); o.w = pk2(v1[2], v1[3]); *(u32x4*)(xb + idx * 8) = o; } }
}

template <int HW>
__device__ __forceinline__ void rope_heads(const bf16_t* src, bf16_t* dst, int nh, const f32x2* rope_tok, float scale, int lane) {
    const int npairs = nh * HW;
    for (int p = lane; p < npairs; p += 64) { const int hh = p / HW, i = p % HW;
        const float x1 = bf2f(src[hh * 2 * HW + i]), x2 = bf2f(src[hh * 2 * HW + i + HW]); const f32x2 cs = rope_tok[i * (32 / HW)];
        dst[hh * 2 * HW + i] = (bf16_t)f2bf((x1 * cs.x - x2 * cs.y) * scale); dst[hh * 2 * HW + i + HW] = (bf16_t)f2bf((x2 * cs.x + x1 * cs.y) * scale); }
}
__device__ __forceinline__ void copy_cols(const bf16_t* src, bf16_t* dst, int n, int lane) { for (int c = lane; c < n / 8; c += 64) *(u32x4*)(dst + c * 8) = *(const u32x4*)(src + c * 8); }

__device__ __forceinline__ void phase_prep_even(const Ctx& C, const Args& a, int i) {
    const bf16_t* hb = WSP(bf16_t, A_HB); const f32x2* rope = WSP(f32x2, WS_ROPE);
    bf16_t *Qa = WSP(bf16_t, A_Q1), *Ka = WSP(bf16_t, A_K1), *Va = WSP(bf16_t, A_V1), *qlat = WSP(bf16_t, A_X1), *kvlat = WSP(bf16_t, A_X1 + 16 * MiB), *kpe = WSP(bf16_t, A_X2);
    const float* gqa = a.mla_g_qa + i * 256; const float* gkva = a.mla_g_kva + i * 128;
    const float sc = 0.125f * LOG2E;
    for (int tok = C.gw; tok < NTOK; tok += C.NGW) {
        const bf16_t* h = hb + (size_t)tok * HB_LD; const f32x2* rt = rope + (size_t)tok * 32;
        rope_heads<32>(h, Qa + (size_t)tok * 512, 8, rt, sc, C.lane);
        rope_heads<32>(h + 512, Ka + (size_t)tok * 512, 8, rt, 1.0f, C.lane);
        copy_cols(h + 1024, Va + (size_t)tok * 512, 512, C.lane);
        { float v[4]; float ss = 0.f;
#pragma unroll
          for (int j = 0; j < 4; ++j) { v[j] = bf2f(h[1536 + C.lane + 64 * j]); ss += v[j] * v[j]; }
          const float r = 1.0f / sqrtf(wave_sum(ss) * (1.0f / 256.0f) + 1e-6f);
#pragma unroll
          for (int j = 0; j < 4; ++j) qlat[(size_t)tok * 256 + C.lane + 64 * j] = (bf16_t)f2bf(v[j] * r * gqa[C.lane + 64 * j]); }
        { float v[2]; float ss = 0.f;
#pragma unroll
          for (int j = 0; j < 2; ++j) { v[j] = bf2f(h[1792 + C.lane + 64 * j]); ss += v[j] * v[j]; }
          const float r = 1.0f / sqrtf(wave_sum(ss) * (1.0f / 128.0f) + 1e-6f);
#pragma unroll
          for (int j = 0; j < 2; ++j) { kvlat[(size_t)tok * 256 + C.lane + 64 * j] = (bf16_t)f2bf(v[j] * r * gkva[C.lane + 64 * j]); kvlat[(size_t)tok * 256 + 128 + C.lane + 64 * j] = 0; } }
        rope_heads<16>(h + 1920, kpe + (size_t)tok * 32, 1, rt, 1.0f, C.lane);
    }
}
__device__ __forceinline__ void phase_kmean(const Ctx& C) {
    const bf16_t* Ka = WSP(bf16_t, A_K1); float* km = WSP(float, WS_KMEAN);
    for (int idx = C.bid * NTHREADS + C.tid; idx < NBATCH * 16 * 512; idx += C.G * NTHREADS) {
        const int c = idx & 511, bj = idx >> 9, b = bj >> 4, j = bj & 15; const bf16_t* p = Ka + ((size_t)b * SEQ + j * 256) * 512 + c;
        float s = 0.f;
        for (int r = 0; r < 256; ++r) s += bf2f(p[(size_t)r * 512]);
        km[(((size_t)b * 8 + (c >> 6)) * 16 + j) * 64 + (c & 63)] = s * (1.0f / 256.0f);
    }
}
__device__ __forceinline__ void phase_prep_mla(const Ctx& C) {
    const bf16_t *qf = WSP(bf16_t, A_QF), *kvf = WSP(bf16_t, A_KVF), *kpe = WSP(bf16_t, A_X2); const f32x2* rope = WSP(f32x2, WS_ROPE);
    bf16_t *Qb = WSP(bf16_t, A_Q2), *Kb = WSP(bf16_t, A_Q2 + 48 * MiB), *Vb = WSP(bf16_t, A_Q2 + 96 * MiB);
    const float sc = 0.10206207261596577f * LOG2E;
    for (int tok = C.gw; tok < NTOK; tok += C.NGW) {
        const bf16_t* q = qf + (size_t)tok * 768; const bf16_t* kv = kvf + (size_t)tok * 1024; const f32x2* rt = rope + (size_t)tok * 32;
        bf16_t* qo = Qb + (size_t)tok * 768; bf16_t* ko = Kb + (size_t)tok * 768; bf16_t* vo = Vb + (size_t)tok * 512;
        for (int p = C.lane; p < 512; p += 64) { const int hh = p >> 6, d = p & 63; qo[hh * 96 + d] = (bf16_t)f2bf(bf2f(q[hh * 96 + d]) * sc); ko[hh * 96 + d] = kv[hh * 128 + d]; vo[hh * 64 + d] = kv[hh * 128 + 64 + d]; }
        for (int p = C.lane; p < 128; p += 64) { const int hh = p >> 4, i2 = p & 15;
            const float x1 = bf2f(q[hh * 96 + 64 + i2]), x2 = bf2f(q[hh * 96 + 80 + i2]); const f32x2 cs = rt[2 * i2];
            qo[hh * 96 + 64 + i2] = (bf16_t)f2bf((x1 * cs.x - x2 * cs.y) * sc); qo[hh * 96 + 80 + i2] = (bf16_t)f2bf((x2 * cs.x + x1 * cs.y) * sc); }
        for (int p = C.lane; p < 256; p += 64) { const int hh = p >> 5, d = p & 31; ko[hh * 96 + 64 + d] = kpe[(size_t)tok * 32 + d]; }
    }
}
__device__ __forceinline__ void phase_prep_odd(const Ctx& C) {
    const bf16_t* hb = WSP(bf16_t, A_HB); const f32x2* rope = WSP(f32x2, WS_ROPE);
    bf16_t *Qc = WSP(bf16_t, A_Q1), *Kc = WSP(bf16_t, A_K1), *Vc = WSP(bf16_t, A_K1 + 8 * MiB), *Qd = WSP(bf16_t, A_V1), *Kd = WSP(bf16_t, A_X1), *Vd = WSP(bf16_t, A_X2);
    const float sc = 0.125f * LOG2E;
    for (int tok = C.gw; tok < NTOK; tok += C.NGW) {
        const bf16_t* h = hb + (size_t)tok * HB_LD; const f32x2* rt = rope + (size_t)tok * 32;
        rope_heads<32>(h, Qc + (size_t)tok * 512, 8, rt, sc, C.lane);
        rope_heads<32>(h + 512, Kc + (size_t)tok * 128, 2, rt, 1.0f, C.lane);
        copy_cols(h + 640, Vc + (size_t)tok * 128, 128, C.lane);
        rope_heads<32>(h + 768, Qd + (size_t)tok * 512, 8, rt, sc, C.lane);
        rope_heads<32>(h + 1280, Kd + (size_t)tok * 512, 8, rt, 1.0f, C.lane);
        copy_cols(h + 1792, Vd + (size_t)tok * 512, 512, C.lane);
    }
}
template <int ABL = 0> __device__ __forceinline__ void phase_attn_even(const Ctx& C) {
    const int vc = (C.G & 7) ? C.bid : (C.bid & 7) * (C.G >> 3) + (C.bid >> 3);
    const bf16_t *Qa = WSP(bf16_t, A_Q1), *Ka = WSP(bf16_t, A_K1), *Va = WSP(bf16_t, A_V1), *Qb = WSP(bf16_t, A_Q2), *Kb = WSP(bf16_t, A_Q2 + 48 * MiB), *Vb = WSP(bf16_t, A_Q2 + 96 * MiB);
    bf16_t* ob = ABL ? WSP(bf16_t, A_HB + 8 * MiB) : WSP(bf16_t, A_OB); const float* km = WSP(float, WS_KMEAN);
    for (int P = vc; P < 512; P += C.G) { const int bh = P >> 3, pi = P & 7, b = bh >> 3, h = bh & 7;
#pragma unroll 1
        for (int s = 0; s < 2; ++s) { const int qb = s ? pi : 15 - pi;
            att::Tens T{Qb + 96 * h, Kb + 96 * h, Vb + 64 * h, ob + 512 + 64 * h, 768, 768, 512, 1024};
            att::unit<96, 64, att::M_CAUSAL, ABL>(T, b, qb, nullptr, 0.f, 0.f, nullptr, 0.f, C.lds, C.tid); } }
    int tid2 = C.tid; asm volatile("" : "+v"(tid2));
    for (int P = vc; P < 512; P += C.G) { const int bh = P >> 3, pi = P & 7, b = bh >> 3, h = bh & 7;
#pragma unroll 1
        for (int s = 0; s < 2; ++s) { const int qb = s ? pi : 15 - pi;
            att::Tens T{Qa + 64 * h, Ka + 64 * h, Va + 64 * h, ob + 64 * h, 512, 512, 512, 1024};
            att::unit<64, 64, att::M_MOBA, ABL>(T, b, qb, km + ((size_t)b * 8 + h) * 2048, 0.f, 0.f, nullptr, 0.f, C.lds, tid2); } }
}
template <int ABL = 0> __device__ __forceinline__ void phase_attn_odd(const Ctx& C, const Args& a, int i, int l) {
    const int vc = (C.G & 7) ? C.bid : (C.bid & 7) * (C.G >> 3) + (C.bid >> 3);
    const bf16_t *Qc = WSP(bf16_t, A_Q1), *Kc = WSP(bf16_t, A_K1), *Vc = WSP(bf16_t, A_K1 + 8 * MiB), *Qd = WSP(bf16_t, A_V1), *Kd = WSP(bf16_t, A_X1), *Vd = WSP(bf16_t, A_X2);
    bf16_t* ob = ABL ? WSP(bf16_t, A_HB + 8 * MiB) : WSP(bf16_t, A_OB);
    const float* lp = a.diff_lambda + i * 256;
    const float d01 = wave_sum(lp[C.lane] * lp[64 + C.lane]), d23 = wave_sum(lp[128 + C.lane] * lp[192 + C.lane]);
    const float lam_init = 0.8f - 0.6f * expf(-0.3f * (float)l);
    const float lam = expf(d01) - expf(d23) + lam_init;
    for (int P = vc; P < 512; P += C.G) { const int bh = P >> 4, pi = P & 15, b = bh >> 2, h = bh & 3;
#pragma unroll 1
        for (int s = 0; s < 2; ++s) { const int qb = s ? pi : 31 - pi;
            att::Tens T{Qd + 128 * h, Kd + 128 * h, Vd + 128 * h, ob + 512 + 128 * h, 512, 512, 512, 1024};
            att::unit<64, 128, att::M_DIFF, ABL>(T, b, qb, nullptr, 0.f, lam, a.diff_g_subln + i * 128, 1.0f - lam_init, C.lds, C.tid); } }
    int tid2 = C.tid; asm volatile("" : "+v"(tid2));
    for (int P = vc; P < 512; P += C.G) { const int bh = P >> 3, pi = P & 7, b = bh >> 3, h = bh & 7;
        const float sink = a.swa_sinks[i * 8 + h] * LOG2E;
#pragma unroll 1
        for (int s = 0; s < 2; ++s) { const int qb = s ? pi : 15 - pi;
            att::Tens T{Qc + 64 * h, Kc + 64 * (h >> 2), Vc + 64 * (h >> 2), ob + 64 * h, 512, 128, 128, 1024};
            att::unit<64, 64, att::M_SWA, ABL>(T, b, qb, nullptr, sink, 0.f, nullptr, 0.f, C.lds, tid2); } }
}
__device__ __forceinline__ void ln_row(f32x4 (&v)[4], const float* g, const float* bb, int lane) {
    float s = 0.f;
#pragma unroll
    for (int j = 0; j < 4; ++j) s += (v[j][0] + v[j][1]) + (v[j][2] + v[j][3]);
    const float mean = wave_sum(s) * (1.0f / DM); float s2 = 0.f;
#pragma unroll
    for (int j = 0; j < 4; ++j) { v[j] = v[j] - mean; s2 += (v[j][0] * v[j][0] + v[j][1] * v[j][1]) + (v[j][2] * v[j][2] + v[j][3] * v[j][3]); }
    const float rstd = 1.0f / sqrtf(wave_sum(s2) * (1.0f / DM) + 1e-5f);
#pragma unroll
    for (int j = 0; j < 4; ++j) { const f32x4 gg = *(const f32x4*)(g + 4 * lane + 256 * j), b4 = *(const f32x4*)(bb + 4 * lane + 256 * j); v[j] = v[j] * rstd * gg + b4; }
}
__device__ __forceinline__ void phase_ln1(const Ctx& C, const Args& a, int l) {
    float* xf = WSP(float, WS_XF); bf16_t* xs = WSP(bf16_t, A_XS);
    const float* g = a.ln_g + (size_t)(l * 2) * DM; const float* bb = a.ln_b + (size_t)(l * 2) * DM;
    for (int tok = C.gw; tok < NTOK; tok += C.NGW) {
        f32x4 v[4]; float* xr = xf + (size_t)tok * DM + 4 * C.lane;
#pragma unroll
        for (int j = 0; j < 4; ++j) v[j] = *(const f32x4*)(xr + 256 * j);
        ln_row(v, g, bb, C.lane);
        bf16_t* xo = xs + (size_t)tok * 2048 + 4 * C.lane;
#pragma unroll
        for (int j = 0; j < 4; ++j) { *(f32x4*)(xr + 256 * j) = v[j];
            const unsigned h0 = f2bf(v[j][0]), h1 = f2bf(v[j][1]), h2 = f2bf(v[j][2]), h3 = f2bf(v[j][3]);
            u32x2 hi2 = {h0 | (h1 << 16), h2 | (h3 << 16)}; *(u32x2*)(xo + 256 * j) = hi2;
            u32x2 lo2 = {pk2(v[j][0] - bf2f(h0), v[j][1] - bf2f(h1)), pk2(v[j][2] - bf2f(h2), v[j][3] - bf2f(h3))}; *(u32x2*)(xo + 1024 + 256 * j) = lo2; }
    }
}
__device__ __forceinline__ void phase_route(const Ctx& C, const Args& a, int l, const int tok0, const int tpb) {
    const float* lg = WSP(float, A_LOG);
    int* rowtok = WSP(int, WS_ROWTOK); float* tokw = WSP(float, WS_WSLOT); int* toke = WSP(int, WS_TOKE); int* tokp = WSP(int, WS_TOKP);
    unsigned* cnt = WSP(unsigned, WS_CTL) + CW_CNT + 64 * l;
    LAS int* cntw = (LAS int*)C.lds; LAS int* base = cntw + 64; LAS int* ent_e = base + 64; LAS int* ent_r = ent_e + 2048; LAS float* ent_w = (LAS float*)(ent_r + 2048);
    __syncthreads();
    if (C.tid < 64) cntw[C.tid] = 0;
    __syncthreads();
    const float bias = a.moe_bias[l * 64 + C.lane];
    const int g = C.lane >> 3;
    for (int tl = C.wave; tl < tpb; tl += NWAVES) {
        const int tok = tok0 + tl;
        const float z = __hip_atomic_load(lg + (size_t)tok * 256 + C.lane, __ATOMIC_RELAXED, __HIP_MEMORY_SCOPE_AGENT) + __hip_atomic_load(lg + (size_t)tok * 256 + 64 + C.lane, __ATOMIC_RELAXED, __HIP_MEMORY_SCOPE_AGENT);
        const float s = 1.0f / (1.0f + expf(-z));
        const float c = s + bias;
        float m1 = c; m1 = fmaxf(m1, shx<1>(m1)); m1 = fmaxf(m1, shx<2>(m1)); m1 = fmaxf(m1, shx<4>(m1));
        const unsigned long long eq = __ballot(c == m1);
        const unsigned geq = (unsigned)(eq >> (8 * g)) & 0xffu;
        const bool is_first = (C.lane & 7) == (int)__builtin_ctz(geq);
        float m2 = is_first ? -INFINITY : c; m2 = fmaxf(m2, shx<1>(m2)); m2 = fmaxf(m2, shx<2>(m2)); m2 = fmaxf(m2, shx<4>(m2));
        const float gs = m1 + m2;
        int grank = 0;
#pragma unroll
        for (int j = 0; j < 8; ++j) { const float gj = __builtin_bit_cast(float, __builtin_amdgcn_readlane(__builtin_bit_cast(int, gs), 8 * j)); grank += (gj > gs || (gj == gs && j < g)) ? 1 : 0; }
        const float v = grank < 4 ? c : -INFINITY;
        int rank = 0;
#pragma unroll
        for (int j = 0; j < 64; ++j) { const float vj = __builtin_bit_cast(float, __builtin_amdgcn_readlane(__builtin_bit_cast(int, v), j)); rank += (vj > v || (vj == v && j < C.lane)) ? 1 : 0; }
        const bool sel = rank < 8;
        const float ssum = wave_sum(sel ? s : 0.f);
        if (sel) { const int r = __hip_atomic_fetch_add(&cntw[C.lane], 1, __ATOMIC_RELAXED, __HIP_MEMORY_SCOPE_WORKGROUP);
            ent_e[tl * 8 + rank] = C.lane; ent_r[tl * 8 + rank] = r; ent_w[tl * 8 + rank] = s / ssum * 2.5f; }
    }
    __syncthreads();
    if (C.tid < 64) base[C.tid] = (int)atomicAdd(&cnt[C.tid], (unsigned)cntw[C.tid]);
    __syncthreads();
    for (int idx = C.tid; idx < tpb * 8; idx += NTHREADS) { const int e = ent_e[idx], pos = base[e] + ent_r[idx], tok = tok0 + (idx >> 3);
        if (pos < CAP) rowtok[(size_t)e * CAP + pos] = tok;
        toke[(size_t)tok0 * 8 + idx] = e; tokp[(size_t)tok0 * 8 + idx] = pos; tokw[(size_t)tok0 * 8 + idx] = ent_w[idx]; }
    __syncthreads();
}
__device__ __forceinline__ void moe_tables(const Ctx& C, int l) {
    const unsigned* cnt = WSP(unsigned, WS_CTL) + CW_CNT + 64 * l;
    LAS int* lcnt = (LAS int*)(C.lds + LX_CNT); LAS int* tst = (LAS int*)(C.lds + LX_TST); LAS unsigned char* texp = (LAS unsigned char*)(C.lds + LX_TEXP);
    __syncthreads();
    if (C.tid < 64) { int c = (int)__hip_atomic_load(cnt + C.tid, __ATOMIC_RELAXED, __HIP_MEMORY_SCOPE_AGENT); if (c > CAP) c = CAP; lcnt[C.tid] = c; }
    __syncthreads();
    if (C.tid == 0) { int acc = 0; for (int e = 0; e < 64; ++e) { tst[e] = acc; acc += (lcnt[e] + 255) >> 8; } tst[64] = acc; }
    __syncthreads();
    if (C.tid < 64) { const int t0 = tst[C.tid], t1 = tst[C.tid + 1]; for (int t = t0; t < t1; ++t) texp[t] = (unsigned char)C.tid; }
    __syncthreads();
}
template <bool GATHER_> struct MoeOrder {
    static constexpr bool GATHER = GATHER_;
    const LAS int* lcnt; const LAS int* tst; const LAS unsigned char* texp; const int* rowtok;
    int TR, nsh, NC, G, c; int sh_orow0;
    __device__ __forceinline__ bool next(int i, pg8::Unit& u) const {
        const int vc = (G & 7) ? c : (c & 7) * (G >> 3) + (c >> 3);
        const long L = (long)i * G + vc; if (L >= (long)(TR + nsh) * NC) return false;
        const int r = (int)(L / NC), cn = (int)(L % NC);
        if (r < TR) { const int e = __builtin_amdgcn_readfirstlane((int)texp[r]); u.e = e; u.lt = r - __builtin_amdgcn_readfirstlane(tst[e]); u.pm = r; u.orow = r * 256; }
        else { u.e = 64; u.lt = r - TR; u.pm = TR_MAX + (r - TR); u.orow = sh_orow0 + u.lt * 256; }
        u.pn = u.e * NC + cn; u.ocol = cn * (NC == 2 ? 128 : 256);
        return true;
    }
    __device__ __forceinline__ unsigned arow(const pg8::Unit& u, int r) const {
        if (!GATHER) return (unsigned)(u.pm * 256 + r);
        const int loc = u.lt * 256 + r;
        if (u.e == 64) return (unsigned)loc;
        return loc < __builtin_amdgcn_readfirstlane(lcnt[u.e]) ? (unsigned)rowtok[(size_t)u.e * CAP + loc] : 0u;
    }
};
__device__ __forceinline__ void phase_combine_ln2(const Ctx& C, const Args& a, int l) {
    float* xf = WSP(float, WS_XF); bf16_t* xb = WSP(bf16_t, WS_HS); const unsigned char* Ys = WSP(unsigned char, WS_YS);
    const int* toke = WSP(int, WS_TOKE); const int* tokp = WSP(int, WS_TOKP); const float* tokw = WSP(float, WS_WSLOT);
    const LAS int* tst = (const LAS int*)(C.lds + LX_TST);
    const float* g = a.ln_g + (size_t)(l * 2 + 1) * DM; const float* bb = a.ln_b + (size_t)(l * 2 + 1) * DM;
    for (int tok = C.gw; tok < NTOK; tok += C.NGW) {
        f32x4 v[4]; float* xr = xf + (size_t)tok * DM + 4 * C.lane;
#pragma unroll
        for (int j = 0; j < 4; ++j) v[j] = *(const f32x4*)(xr + 256 * j);
#pragma unroll
        for (int k = 0; k < 8; ++k) { const int e = toke[(size_t)tok * 8 + k], pos = tokp[(size_t)tok * 8 + k]; const float gw = tokw[(size_t)tok * 8 + k] * (1.0f / YS_SCALE); const size_t slot = (size_t)tst[e] * 256 + pos;
            const unsigned char* yr = Ys + slot * DM + 4 * C.lane;
#pragma unroll
            for (int j = 0; j < 4; ++j) { const int w = *(const int*)(yr + 256 * j);
                v[j][0] += gw * __builtin_amdgcn_cvt_f32_fp8(w, 0); v[j][1] += gw * __builtin_amdgcn_cvt_f32_fp8(w, 1); v[j][2] += gw * __builtin_amdgcn_cvt_f32_fp8(w, 2); v[j][3] += gw * __builtin_amdgcn_cvt_f32_fp8(w, 3); } }
        ln_row(v, g, bb, C.lane);
        bf16_t* xo = xb + (size_t)tok * DM + 4 * C.lane;
#pragma unroll
        for (int j = 0; j < 4; ++j) { *(f32x4*)(xr + 256 * j) = v[j]; u32x2 w = {pk2(v[j][0], v[j][1]), pk2(v[j][2], v[j][3])}; *(u32x2*)(xo + 256 * j) = w;
            if (l == DEPTH - 1) *(f32x4*)(a.out + (size_t)tok * DM + 4 * C.lane + 256 * j) = v[j]; }
    }
}
constexpr int STEPS_PER_LAYER = 15, NSTEPS = 1 + STEPS_PER_LAYER * DEPTH;
#define CAS __attribute__((address_space(4)))
template <int STEP> __device__ __forceinline__ void step_fn(const CAS Args* ka, LAS unsigned char* lds_base, int l, int wv) {
#if defined(__HIP_DEVICE_COMPILE__)
    const Args a = *ka;
#else
    const Args a{};
#endif
    int lane_; asm volatile("v_mbcnt_lo_u32_b32 %0, -1, 0\n\tv_mbcnt_hi_u32_b32 %0, -1, %0" : "=v"(lane_)); asm volatile("" : "+s"(wv)); int tid_ = wv * 64 + lane_; asm volatile("" : "+v"(tid_));
    LAS unsigned char* lds_l = lds_base; asm volatile("" : "+s"(lds_l));
    Ctx C; C.lds = lds_l; C.ws = a.ws; C.tid = tid_; C.lane = C.tid & 63; C.wave = __builtin_amdgcn_readfirstlane(C.tid >> 6);
    int G_ = gridDim.x, bid_ = blockIdx.x; asm volatile("" : "+s"(G_), "+s"(bid_));
    C.G = G_; C.bid = bid_; C.gw = C.bid * NWAVES + C.wave; C.NGW = C.G * NWAVES;
    asm volatile("; STEP_BEGIN %0" :: "n"(STEP));
    const int i = l >> 1; const bool even = !(l & 1);
    const size_t swl = WS_SMALLW + (size_t)l * SW_LAYER;
    if constexpr (STEP == 99) phase_init(C, a);
    if constexpr (STEP == 0) phase_convert(C, a, l);
    if constexpr (STEP == 1) { phase_convert(C, a, l); __syncthreads();
        pg8::Gemm g{WSP(bf16_t, WS_HS), WSP(bf16_t, swl), DM, DM}; pg8::StaticOrder S; S.init(NTOK, even ? 2048 : 2304, C.G, C.bid);
        EpiWin E{C.ws, even ? 1 : 0, a.mla_g_qa + i * 256, a.mla_g_kva + i * 128}; pg8::gemm_phase<EpiWin, pg8::StaticOrder, true>(C.lds, g, S, E, C.tid); }
    if constexpr (STEP == 3) {
        { pg8::Gemm g{WSP(bf16_t, A_X1), WSP(bf16_t, swl + SW_WQB), 256, 256}; pg8::StaticOrder S; S.init(NTOK, 768, C.G, C.bid);
          EpiMlaQ E{C.ws}; pg8::gemm_phase<EpiMlaQ, pg8::StaticOrder, true>(C.lds, g, S, E, C.tid); }
        { int lane3; asm volatile("v_mbcnt_lo_u32_b32 %0, -1, 0\n\tv_mbcnt_hi_u32_b32 %0, -1, %0" : "=v"(lane3)); int tid3 = C.wave * 64 + lane3; asm volatile("" : "+v"(tid3)); unsigned char* ws3 = C.ws; asm volatile("" : "+s"(ws3));
          pg8::Gemm g{(bf16_t*)(ws3 + A_X1 + 16 * MiB), (bf16_t*)(ws3 + swl + SW_WKVB), 256, 256}; pg8::StaticOrder S; S.init(NTOK, 1024, C.G, C.bid);
          EpiMlaKV E{ws3}; pg8::gemm_phase<EpiMlaKV, pg8::StaticOrder, true>(C.lds, g, S, E, tid3); } }
    if constexpr (STEP == 5) { if (even) phase_attn_even(C); else phase_attn_odd(C, a, i, l); }
#ifdef ATT_ABL
    if constexpr (STEP == 40) { if (even) phase_attn_even<ATT_ABL>(C); else phase_attn_odd<ATT_ABL>(C, a, i, l); }
#endif
    if constexpr (STEP == 7) { pg8::Gemm g{WSP(bf16_t, A_OB), WSP(bf16_t, swl + SW_WOUT), DM, DM}; pg8::StaticOrder S; S.init(NTOK, DM, C.G, C.bid);
        pg8::EpiResid E{l == 0 ? a.x : WSP(float, WS_XF), WSP(float, WS_XF), DN_ALPHA}; pg8::gemm_phase<pg8::EpiResid, pg8::StaticOrder, true>(C.lds, g, S, E, C.tid); }
    if constexpr (STEP == 8) phase_ln1(C, a, l);
    if constexpr (STEP == 9) { pg8::Gemm g{WSP(bf16_t, A_XS), WSP(bf16_t, WS_WR + (size_t)l * MiB), 2048, 2048}; pg8::StaticOrder S; S.init(NTOK, 256, C.G, C.bid);
        pg8::EpiF32 E{WSP(float, A_LOG), 256}; pg8::gemm_phase<pg8::EpiF32, pg8::StaticOrder, true>(C.lds, g, S, E, C.tid);
    }
    if constexpr (STEP == 10) phase_route(C, a, l, C.bid * (NTOK / C.G), NTOK / C.G);
    if constexpr (STEP == 11) { moe_tables(C, l);
        const LAS int* tst = (const LAS int*)(C.lds + LX_TST);
        MoeOrder<true> S{(const LAS int*)(C.lds + LX_CNT), tst, (const LAS unsigned char*)(C.lds + LX_TEXP), WSP(int, WS_ROWTOK), __builtin_amdgcn_readfirstlane(tst[64]), 128, 2, C.G, C.bid, SLOTS_R};
        pg8::Gemm g{WSP(bf16_t, A_XS), WSP(bf16_t, WS_WGU), 2048, DM}; pg8::EpiSwiGLU E{WSP(bf16_t, WS_HS)};
        pg8::gemm_phase<pg8::EpiSwiGLU, MoeOrder<true>, true>(C.lds, g, S, E, C.tid); }
    if constexpr (STEP == 12) { moe_tables(C, l);
        const LAS int* tst = (const LAS int*)(C.lds + LX_TST);
        MoeOrder<false> S{(const LAS int*)(C.lds + LX_CNT), tst, (const LAS unsigned char*)(C.lds + LX_TEXP), WSP(int, WS_ROWTOK), __builtin_amdgcn_readfirstlane(tst[64]), 128, 4, C.G, C.bid, 0};
        pg8::Gemm g{WSP(bf16_t, WS_HS), WSP(bf16_t, WS_WD), DE, DE}; EpiDownAll E{C.ws};
        pg8::gemm_phase<EpiDownAll, MoeOrder<false>, true>(C.lds, g, S, E, C.tid); }
    if constexpr (STEP == 14) { moe_tables(C, l); phase_combine_ln2(C, a, l); }
}
__global__ void __launch_bounds__(NTHREADS, 2) mega_fwd(Args a) {
    extern __shared__ __attribute__((aligned(16))) unsigned char lds_raw[];
    LAS unsigned char* lds = (LAS unsigned char*)lds_raw;
    const CAS Args* ka = (const CAS Args*)__builtin_amdgcn_kernarg_segment_ptr();
    const int wv = __builtin_amdgcn_readfirstlane(threadIdx.x >> 6);
    if (threadIdx.x < 4) ((LAS unsigned*)(lds + LX_BAR))[threadIdx.x] = 0u;
    __syncthreads();
    unsigned* barw = (unsigned*)(a.ws + WS_CTL) + CW_BAR;
    XcdBarrier bar; bar.bar = barw; bar.x = 0; bar.st = nullptr;
    if (a.use_bar) bar = xcd_barrier_post(barw, (volatile LAS unsigned*)(lds + LX_BAR));
    int step = 0;
#ifndef DUP_MASK
#define DUP_MASK 0u
#endif
#define BARRIER_NOW() do { XcdBarrier b2 = bar; asm volatile("" : "+s"(b2.bar)); int w2 = wv; asm volatile("" : "+s"(w2)); int l2_; asm volatile("v_mbcnt_lo_u32_b32 %0, -1, 0\n\tv_mbcnt_hi_u32_b32 %0, -1, %0" : "=v"(l2_)); xcd_barrier(b2, w2 == 0 && l2_ == 0); } while (0)
#define RUN(K, cond) do { if (step >= a.st_lo && step < a.st_hi) { if (cond) { const CAS Args* kp = ka; asm volatile("" : "+s"(kp)); step_fn<K>(kp, lds, l, wv); \
        if constexpr (K < 32 && ((DUP_MASK >> (K & 31)) & 1u)) { BARRIER_NOW(); const CAS Args* kp2 = ka; asm volatile("" : "+s"(kp2)); step_fn<K>(kp2, lds, l, wv); } if (a.use_bar && step + 1 < a.st_hi) BARRIER_NOW(); } } ++step; } while (0)
    { const int l = 0; RUN(99, true); }
#pragma unroll 1
    for (int l = 0; l < DEPTH; ++l) {
        const bool even = !(l & 1);
        RUN(0, false); RUN(1, true); RUN(2, false); RUN(3, even); RUN(4, false); RUN(5, true);
#ifdef ATT_ABL
        --step; RUN(40, true);
#endif
        RUN(6, false); RUN(7, true);
        RUN(8, true); RUN(9, true); RUN(10, true); RUN(11, true); RUN(12, true); RUN(13, false); RUN(14, true);
    }
#undef RUN
}

extern "C" void kernel_launch(void* const* d_in, const int* in_sizes, int n_in, void* d_out, int out_size, void* d_ws, size_t ws_size, hipStream_t stream) {
    static int grid = 0;
    if (grid == 0) {
        if (n_in != 23 || out_size != NTOK * DM || ws_size < WS_END) { fprintf(stderr, "kernel_launch: unexpected problem shape (n_in %d out %d ws %zu)\n", n_in, out_size, ws_size); grid = -1; return; }
        int dev = 0, cus = 0;
        if (hipGetDevice(&dev) != hipSuccess || hipDeviceGetAttribute(&cus, hipDeviceAttributeMultiprocessorCount, dev) != hipSuccess) { grid = -1; return; }
        if (hipFuncSetAttribute((const void*)mega_fwd, hipFuncAttributeMaxDynamicSharedMemorySize, LDS_BYTES) != hipSuccess) { fprintf(stderr, "kernel_launch: hipFuncSetAttribute failed\n"); grid = -1; return; }
        int per_cu = 0;
        if (hipOccupancyMaxActiveBlocksPerMultiprocessor(&per_cu, (const void*)mega_fwd, NTHREADS, LDS_BYTES) != hipSuccess || per_cu < 1) { fprintf(stderr, "kernel_launch: occupancy query says %d\n", per_cu); }
        (void)hipGetLastError();
        grid = cus;
    }
    if (grid < 0) return;
    if (hipMemsetAsync((char*)d_ws + WS_CTL, 0, CTL_ZERO_BYTES, stream) != hipSuccess) return;
    Args a{};
    a.x = (const float*)d_in[0]; a.pos = (const int*)d_in[1];
    a.ev_w_in = (const float*)d_in[2]; a.ev_w_out = (const float*)d_in[3]; a.mla_g_qa = (const float*)d_in[4]; a.mla_w_qb = (const float*)d_in[5]; a.mla_g_kva = (const float*)d_in[6]; a.mla_w_kvb = (const float*)d_in[7];
    a.od_w_in = (const float*)d_in[8]; a.od_w_out = (const float*)d_in[9]; a.swa_sinks = (const float*)d_in[10]; a.diff_lambda = (const float*)d_in[11]; a.diff_g_subln = (const float*)d_in[12];
    a.ln_g = (const float*)d_in[13]; a.ln_b = (const float*)d_in[14]; a.moe_w_router = (const float*)d_in[15]; a.moe_bias = (const float*)d_in[16];
    a.moe_w_gate = (const float*)d_in[17]; a.moe_w_up = (const float*)d_in[18]; a.moe_w_down = (const float*)d_in[19]; a.sh_w_gate = (const float*)d_in[20]; a.sh_w_up = (const float*)d_in[21]; a.sh_w_down = (const float*)d_in[22];
    a.out = (float*)d_out; a.ws = (unsigned char*)d_ws;
#ifndef MK_ONE_LAUNCH
#define MK_ONE_LAUNCH 1
#endif
    if (MK_ONE_LAUNCH) {
        a.st_lo = 0; a.st_hi = NSTEPS; a.use_bar = 1;
        hipLaunchKernelGGL(mega_fwd, dim3(grid), dim3(NTHREADS), LDS_BYTES, stream, a);
    } else {
        for (int s = 0; s < NSTEPS; ++s) {
            if (s > 0) { const int ls = (s - 1) % STEPS_PER_LAYER, l = (s - 1) / STEPS_PER_LAYER; const bool even = !(l & 1);
                if (ls == 0 || ls == 2 || ls == 4 || ls == 6 || ls == 13) continue; if (!even && ls == 3) continue; }
            a.st_lo = s; a.st_hi = s + 1; a.use_bar = 0;
            hipLaunchKernelGGL(mega_fwd, dim3(grid), dim3(NTHREADS), LDS_BYTES, stream, a);
        }
    }
}
```

```cpp
#include <hip/hip_runtime.h>
#include <cstdio>
#include <cstdint>
#include <utility>

#define GAS __attribute__((address_space(1)))
#define LAS __attribute__((address_space(3)))
typedef unsigned short bf16_t;
typedef short bf16x8 __attribute__((ext_vector_type(8)));
typedef short s16x4 __attribute__((ext_vector_type(4)));
typedef float f32x2 __attribute__((ext_vector_type(2)));
typedef float f32x4 __attribute__((ext_vector_type(4)));
typedef float f32x16 __attribute__((ext_vector_type(16)));
typedef unsigned u32x2 __attribute__((ext_vector_type(2)));
typedef unsigned u32x4 __attribute__((ext_vector_type(4)));

constexpr int NTOK = 32768, DM = 1024, SEQ = 4096, NBATCH = 8, DEPTH = 4;
constexpr int EV_IN = 1952, OD_IN = 2304, HB_LD = 2304;
constexpr int NE = 64, DE = 256, TOPK = 8, CAP = 32768;
constexpr int TR_MAX = 1088;
constexpr int SLOTS_R = TR_MAX * 256;
constexpr int SLOTS = SLOTS_R + NTOK;
constexpr float DN_ALPHA = 1.681792830507429f;
constexpr float LOG2E = 1.4426950408889634f;

__device__ __forceinline__ unsigned f2bf(float f) { unsigned u = __builtin_bit_cast(unsigned, f); return (u + 0x7fffu + ((u >> 16) & 1u)) >> 16; }
__device__ __forceinline__ float bf2f(unsigned b) { return __builtin_bit_cast(float, b << 16); }
__device__ __forceinline__ unsigned pk2(float lo, float hi) { return f2bf(lo) | (f2bf(hi) << 16); }
template <int M> __device__ __forceinline__ float shx(float v) {
    if constexpr (M == 32) { const auto rr = __builtin_amdgcn_permlane32_swap(__builtin_bit_cast(unsigned, v), __builtin_bit_cast(unsigned, v), false, false); return __builtin_bit_cast(float, rr[0] == __builtin_bit_cast(unsigned, v) ? rr[1] : rr[0]); }
    else return __builtin_bit_cast(float, __builtin_amdgcn_ds_swizzle(__builtin_bit_cast(int, v), 0x1F | (M << 10)));
}
__device__ __forceinline__ float wave_sum(float v) { v += shx<1>(v); v += shx<2>(v); v += shx<4>(v); v += shx<8>(v); v += shx<16>(v); v += shx<32>(v); return v; }
namespace pg8 {
constexpr int BM = 256, BK = 64, HALF = 128, HTB = HALF * BK * 2  , STAGE_BYTES = 8 * HTB, NXCD = 8, WGM = 8;
__host__ __device__ __forceinline__ int lds_byte(int r, int c) { const int st = (r >> 4) * 2 + (c >> 5), rr = r & 15, cc = c & 31, ob = rr * 64 + cc * 2; return st * 1024 + (ob ^ (((ob >> 9) & 1) << 5)); }
__host__ __device__ __forceinline__ void stage_rc(int b, int& R, int& C) { const int st = b / 1024, sb = b % 1024, swz = sb ^ (((sb >> 9) & 1) << 5); R = (st >> 1) * 16 + swz / 64; C = (st & 1) * 32 + (swz % 64) / 2; }
__host__ __device__ __forceinline__ int perm32(int rho) { const int n = rho >> 4, i = rho & 15; return 8 * (i >> 2) + 4 * n + (i & 3); }

struct Unit { int pm, pn, orow, ocol, e, lt, aoffb; };
struct Gemm { const bf16_t* A; const bf16_t* Bt; int lda, K; };

struct StaticOrder {
    static constexpr bool GATHER = false;
    int nM, nN, nwg, G, c;
    __device__ void init(int M, int N, int G_, int c_) { nM = M / BM; nN = N / BM; nwg = nM * nN; G = G_; c = c_; }
    __device__ __forceinline__ bool next(int i, Unit& u) const {
        const long L = (long)i * G + c; if (L >= nwg) return false;
        int wgid = (int)L; { const int q = nwg / NXCD, r = nwg % NXCD, xcd = wgid % NXCD, off = wgid / NXCD; wgid = (xcd < r ? xcd * (q + 1) : r * (q + 1) + (xcd - r) * q) + off; }
        const int nig = WGM * nN, gid = wgid / nig, fm = gid * WGM, gsz = (nM - fm) < WGM ? (nM - fm) : WGM;
        u.pm = fm + ((wgid % nig) % gsz); u.pn = (wgid % nig) / gsz; u.orow = u.pm * BM; u.ocol = u.pn * BM; u.e = 0; u.lt = u.pm; u.aoffb = 0; return true;
    }
    __device__ __forceinline__ unsigned arow(const Unit& u, int r) const { return (unsigned)(u.pm * BM + r); }
};

__device__ __forceinline__ unsigned cvt_pk_bf16(float lo, float hi) { unsigned r; asm volatile("v_cvt_pk_bf16_f32 %0, %1, %2" : "=v"(r) : "v"(lo), "v"(hi)); return r; }

struct EpiBf16 {
    static constexpr bool PERM = true;
    bf16_t* O; int ldc;
    __device__ __forceinline__ void operator()(const f32x4 (&acc)[2][2][4][2], const Unit& u, int wr, int wc, int fr, int fq) const {
        const int row0 = u.orow + wr * 64 + fr, col0 = u.ocol + wc * 32 + 8 * fq;
#pragma unroll
        for (int ai = 0; ai < 2; ++ai)
#pragma unroll
            for (int m = 0; m < 4; ++m) { bf16_t* rowp = O + (size_t)(row0 + ai * HALF + m * 16) * ldc + col0;
#pragma unroll
                for (int bj = 0; bj < 2; ++bj) { const f32x4 v0 = acc[ai][bj][m][0], v1 = acc[ai][bj][m][1];
                    u32x4 w; w.x = cvt_pk_bf16(v0[0], v0[1]); w.y = cvt_pk_bf16(v0[2], v0[3]); w.z = cvt_pk_bf16(v1[0], v1[1]); w.w = cvt_pk_bf16(v1[2], v1[3]);
                    *(u32x4*)(rowp + bj * HALF) = w; } }
    }
};
struct EpiF32 {
    static constexpr bool PERM = false;
    float* C; int ldc;
    __device__ __forceinline__ void operator()(const f32x4 (&acc)[2][2][4][2], const Unit& u, int wr, int wc, int fr, int fq) const {
        const int row0 = u.orow + wr * 64 + fr, col0 = u.ocol + wc * 32 + 4 * fq;
#pragma unroll
        for (int ai = 0; ai < 2; ++ai)
#pragma unroll
            for (int m = 0; m < 4; ++m) { float* rowp = C + (size_t)(row0 + ai * HALF + m * 16) * ldc + col0;
#pragma unroll
                for (int bj = 0; bj < 2; ++bj)
#pragma unroll
                    for (int n = 0; n < 2; ++n) *(f32x4*)(rowp + bj * HALF + n * 16) = acc[ai][bj][m][n]; }
    }
};
struct EpiResid {
    static constexpr bool PERM = false;
    const float* src; float* dst; float alpha; int split;
    __device__ __forceinline__ void operator()(const f32x4 (&acc)[2][2][4][2], const Unit& u, int wr, int wc, int fr, int fq) const {
        const int row0 = u.orow + wr * 64 + fr, col0 = u.ocol + wc * 32 + 4 * fq;
#pragma unroll
        for (int ai = 0; ai < 2; ++ai)
#pragma unroll
            for (int m = 0; m < 4; ++m) { const size_t ro = (size_t)(row0 + ai * HALF + m * 16) * DM + col0;
                f32x4 s[2][2];
                if (split) { const bf16_t* sp = (const bf16_t*)(src + (size_t)(row0 + ai * HALF + m * 16) * DM) + col0;
#pragma unroll
                    for (int bj = 0; bj < 2; ++bj)
#pragma unroll
                        for (int n = 0; n < 2; ++n) { const u32x2 hw = *(const u32x2*)(sp + bj * HALF + n * 16), lw = *(const u32x2*)(sp + 1024 + bj * HALF + n * 16);
                            s[bj][n] = (f32x4){bf2f(hw.x & 0xffffu) + bf2f(lw.x & 0xffffu), bf2f(hw.x >> 16) + bf2f(lw.x >> 16), bf2f(hw.y & 0xffffu) + bf2f(lw.y & 0xffffu), bf2f(hw.y >> 16) + bf2f(lw.y >> 16)}; }
                } else {
#pragma unroll
                    for (int bj = 0; bj < 2; ++bj)
#pragma unroll
                        for (int n = 0; n < 2; ++n) s[bj][n] = *(const f32x4*)(src + ro + bj * HALF + n * 16); }
#pragma unroll
                for (int bj = 0; bj < 2; ++bj)
#pragma unroll
                    for (int n = 0; n < 2; ++n) *(f32x4*)(dst + ro + bj * HALF + n * 16) = s[bj][n] * alpha + acc[ai][bj][m][n]; }
    }
};
struct EpiSwiGLU {
    static constexpr bool PERM = true;
    bf16_t* H;
    __device__ __forceinline__ void operator()(const f32x4 (&acc)[2][2][4][2], const Unit& u, int wr, int wc, int fr, int fq) const {
        const int row0 = u.orow + wr * 64 + fr, col0 = u.ocol + wc * 32 + 8 * fq;
#pragma unroll
        for (int ai = 0; ai < 2; ++ai)
#pragma unroll
            for (int m = 0; m < 4; ++m) { bf16_t* rowp = H + (size_t)(row0 + ai * HALF + m * 16) * DE + col0;
                float h[8];
#pragma unroll
                for (int n = 0; n < 2; ++n)
#pragma unroll
                    for (int j = 0; j < 4; ++j) { const float g = acc[ai][0][m][n][j], up = acc[ai][1][m][n][j]; h[n * 4 + j] = g / (1.0f + __expf(-g)) * up; }
                u32x4 w; w.x = cvt_pk_bf16(h[0], h[1]); w.y = cvt_pk_bf16(h[2], h[3]); w.z = cvt_pk_bf16(h[4], h[5]); w.w = cvt_pk_bf16(h[6], h[7]);
                *(u32x4*)rowp = w; }
    }
};
struct EpiDown {
    static constexpr bool PERM = true;
    bf16_t* Y; const float* wslot; const LAS int* cnt;
    __device__ __forceinline__ void operator()(const f32x4 (&acc)[2][2][4][2], const Unit& u, int wr, int wc, int fr, int fq) const {
        const int rl0 = wr * 64 + fr, col0 = u.ocol + wc * 32 + 8 * fq; const int ce = cnt[u.e];
#pragma unroll
        for (int ai = 0; ai < 2; ++ai)
#pragma unroll
            for (int m = 0; m < 4; ++m) { const int rl = rl0 + ai * HALF + m * 16, loc = u.lt * BM + rl;
                const float gw = loc < ce ? wslot[(size_t)u.e * CAP + loc] : 0.f;
                bf16_t* rowp = Y + (size_t)(u.orow + rl) * DM + col0;
#pragma unroll
                for (int bj = 0; bj < 2; ++bj) { const f32x4 v0 = acc[ai][bj][m][0] * gw, v1 = acc[ai][bj][m][1] * gw;
                    u32x4 w; w.x = cvt_pk_bf16(v0[0], v0[1]); w.y = cvt_pk_bf16(v0[2], v0[3]); w.z = cvt_pk_bf16(v1[0], v1[1]); w.w = cvt_pk_bf16(v1[2], v1[3]);
                    *(u32x4*)(rowp + bj * HALF) = w; } }
    }
};

template <class Epi, class Sched, bool ALIGN_EPI>
__device__ __forceinline__ void gemm_phase(LAS unsigned char* lds, const Gemm g, const Sched& S, const Epi& E, const int tid) {
    const int wid = __builtin_amdgcn_readfirstlane(tid >> 6), lane = tid & 63, wr = wid >> 2, wc = wid & 3, fr = lane & 15, fq = lane >> 4;
    const int K = g.K, nt = K / BK;
    constexpr bool GATHER = Sched::GATHER;
    int Ra[2]; unsigned Ca[2], voffA[2], voffB[2];
    const unsigned ldab = (unsigned)g.lda * 2u;
#pragma unroll
    for (int i = 0; i < 2; ++i) { int R, C; stage_rc(tid * 16 + i * 8192, R, C); const int Rb = Epi::PERM ? ((R & ~31) + perm32(R & 31)) : R;
        Ra[i] = R; Ca[i] = (unsigned)C * 2u; voffA[i] = (unsigned)R * ldab + (unsigned)C * 2u; voffB[i] = (unsigned)(Rb * K + C) * 2u; }
    const size_t hstepA = (size_t)HALF * ldab;
    const size_t kstep = (size_t)(BK * 2);
    const size_t hstep = (size_t)HALF * K * 2;
    const size_t tstep = 2 * hstep;
    const unsigned ldsw = (unsigned)wid * 1024u;
    const int aoff = lds_byte(wr * 64 + fr, fq * 8), boff = lds_byte(wc * 32 + fr, fq * 8);
    const char* Ab = (const char*)g.A;
#define PG8_SA(b, h) (((b) * 2 + (h)) * HTB)
#define PG8_SB(b, h) ((4 + (b) * 2 + (h)) * HTB)
#define PG8_STAGE(bufoff, gbase, voff) do { _Pragma("unroll") for (int _i = 0; _i < 2; ++_i) \
        __builtin_amdgcn_global_load_lds((const unsigned*)((const char*)(gbase) + (voff)[_i]), (LAS unsigned*)(lds + (bufoff) + ldsw + _i * 8192), 16, 0, 0); } while (0)
#define PG8_STAGEA(bufoff, offs, ubase, h, kbyte) do { _Pragma("unroll") for (int _i = 0; _i < 2; ++_i) { \
        const char* _src = GATHER ? Ab + (size_t)(offs)[h][_i] + (size_t)(kbyte) : (ubase) + (size_t)(h) * hstepA + (size_t)(kbyte) + voffA[_i]; \
        __builtin_amdgcn_global_load_lds((const unsigned*)_src, (LAS unsigned*)(lds + (bufoff) + ldsw + _i * 8192), 16, 0, 0); } } while (0)
#define PG8_OFFS(dst, u) do { if constexpr (GATHER) { _Pragma("unroll") for (int _h = 0; _h < 2; ++_h) _Pragma("unroll") for (int _i = 0; _i < 2; ++_i) dst[_h][_i] = S.arow(u, _h * HALF + Ra[_i]) * ldab + Ca[_i]; } } while (0)
#define PG8_LDA(dst, b, h) do { _Pragma("unroll") for (int m = 0; m < 4; ++m) _Pragma("unroll") for (int k = 0; k < 2; ++k) dst[m][k] = *(const LAS bf16x8*)(lds + PG8_SA(b, h) + aoff + m * 2048 + k * 1024); } while (0)
#define PG8_LDB(dst, b, h) do { _Pragma("unroll") for (int n = 0; n < 2; ++n) _Pragma("unroll") for (int k = 0; k < 2; ++k) dst[n][k] = *(const LAS bf16x8*)(lds + PG8_SB(b, h) + boff + n * 2048 + k * 1024); } while (0)
#define PG8_MMA(ai, bj, At, Bt) do { __builtin_amdgcn_s_setprio(1); _Pragma("unroll") for (int m = 0; m < 4; ++m) _Pragma("unroll") for (int n = 0; n < 2; ++n) _Pragma("unroll") for (int k = 0; k < 2; ++k) \
        acc[ai][bj][m][n] = __builtin_amdgcn_mfma_f32_16x16x32_bf16(Bt[n][k], At[m][k], acc[ai][bj][m][n], 0, 0, 0); __builtin_amdgcn_s_setprio(0); } while (0)
#define PG8_WAIT_V(n) asm volatile("s_waitcnt vmcnt(" #n ")" ::: "memory")
#define PG8_WAIT_L(n) asm volatile("s_waitcnt lgkmcnt(" #n ")" ::: "memory")
#define PG8_BAR __builtin_amdgcn_s_barrier()
#define PG8_SCHED __builtin_amdgcn_sched_barrier(0)
    Unit cur, nxt; int ui = 0;
    if (!S.next(0, cur)) return;
    f32x4 acc[2][2][4][2];
#pragma unroll
    for (int a = 0; a < 2; ++a)
#pragma unroll
        for (int b = 0; b < 2; ++b)
#pragma unroll
            for (int m = 0; m < 4; ++m)
#pragma unroll
                for (int n = 0; n < 2; ++n) acc[a][b][m][n] = (f32x4){0.f, 0.f, 0.f, 0.f};
    bf16x8 At[4][2], B0[2][2], B1[2][2];
    unsigned oc[2][2] = {{0u, 0u}, {0u, 0u}}, on[2][2] = {{0u, 0u}, {0u, 0u}};
    PG8_OFFS(oc, cur);
    const char* cA = Ab + (size_t)S.arow(cur, 0) * ldab + cur.aoffb;
    const char* cB = (const char*)g.Bt + (size_t)cur.pn * tstep;
    PG8_STAGE(PG8_SB(0, 0), cB, voffB); PG8_STAGE(PG8_SB(0, 1), cB + hstep, voffB); PG8_STAGEA(PG8_SA(0, 0), oc, cA, 0, 0); PG8_STAGEA(PG8_SA(0, 1), oc, cA, 1, 0);
    if (wr == 1) PG8_BAR;
    PG8_WAIT_V(2); PG8_BAR;
    PG8_STAGE(PG8_SB(1, 0), cB + kstep, voffB); PG8_STAGEA(PG8_SA(1, 0), oc, cA, 0, kstep); PG8_STAGE(PG8_SB(1, 1), cB + hstep + kstep, voffB);
    PG8_WAIT_V(6); PG8_BAR;
    for (;;) {
        const bool has_next = S.next(ui + 1, nxt);
        if (has_next) { PG8_OFFS(on, nxt); } else {
#pragma unroll
            for (int h = 0; h < 2; ++h)
#pragma unroll
                for (int i = 0; i < 2; ++i) on[h][i] = oc[h][i]; }
        const char* nB = has_next ? (const char*)g.Bt + (size_t)nxt.pn * tstep : cB;
        const char* nA = has_next ? Ab + (size_t)S.arow(nxt, 0) * ldab + nxt.aoffb : cA;
        for (int t = 0; t < nt; t += 2) {
            const bool last = (t == nt - 2);
            const size_t k1 = (size_t)(t + 1) * kstep;
            const size_t k2 = last ? 0 : (size_t)(t + 2) * kstep, k3 = k2 + kstep;
            const char* b2 = last ? nB : cB + (size_t)(t + 2) * kstep; const char* b3 = b2 + kstep;
            unsigned o2[2][2]; const char* a2 = last ? nA : cA;
#pragma unroll
            for (int h = 0; h < 2; ++h)
#pragma unroll
                for (int i = 0; i < 2; ++i) o2[h][i] = last ? on[h][i] : oc[h][i];
            PG8_LDB(B0, 0, 0); PG8_LDB(B1, 0, 1); PG8_SCHED; PG8_LDA(At, 0, 0); PG8_STAGEA(PG8_SA(1, 1), oc, cA, 1, k1);
            PG8_WAIT_V(8); PG8_WAIT_L(0); PG8_BAR; PG8_MMA(0, 0, At, B0); PG8_MMA(0, 1, At, B1); PG8_BAR; PG8_SCHED;
            PG8_LDA(At, 0, 1); PG8_STAGE(PG8_SB(0, 0), b2, voffB); PG8_STAGE(PG8_SB(0, 1), b2 + hstep, voffB); PG8_STAGEA(PG8_SA(0, 0), o2, a2, 0, k2);
            PG8_WAIT_V(8); PG8_WAIT_L(0); PG8_BAR; PG8_MMA(1, 0, At, B0); PG8_MMA(1, 1, At, B1); PG8_BAR; PG8_SCHED;
            PG8_LDB(B0, 1, 0); PG8_LDB(B1, 1, 1); PG8_SCHED; PG8_LDA(At, 1, 0); PG8_STAGEA(PG8_SA(0, 1), o2, a2, 1, k2);
            PG8_WAIT_V(8); PG8_WAIT_L(0); PG8_BAR; PG8_MMA(0, 0, At, B0); PG8_MMA(0, 1, At, B1); PG8_BAR; PG8_SCHED;
            PG8_LDA(At, 1, 1); PG8_STAGE(PG8_SB(1, 0), b3, voffB); PG8_STAGE(PG8_SB(1, 1), b3 + hstep, voffB); PG8_STAGEA(PG8_SA(1, 0), o2, a2, 0, k3);
            PG8_WAIT_V(8); PG8_WAIT_L(0); PG8_BAR; PG8_MMA(1, 0, At, B0); PG8_MMA(1, 1, At, B1); PG8_BAR; PG8_SCHED;
        }
        if constexpr (ALIGN_EPI) { if (wr == 0) PG8_BAR; }
        { int l2; asm volatile("v_mbcnt_lo_u32_b32 %0, -1, 0\n\tv_mbcnt_hi_u32_b32 %0, -1, %0" : "=v"(l2)); E(acc, cur, wr, wc, l2 & 15, l2 >> 4); }
        if (!has_next) break;
#pragma unroll
        for (int a = 0; a < 2; ++a)
#pragma unroll
            for (int b = 0; b < 2; ++b)
#pragma unroll
                for (int m = 0; m < 4; ++m)
#pragma unroll
                    for (int n = 0; n < 2; ++n) acc[a][b][m][n] = (f32x4){0.f, 0.f, 0.f, 0.f};
        cur = nxt; cB = nB; cA = nA; ++ui;
#pragma unroll
        for (int h = 0; h < 2; ++h)
#pragma unroll
            for (int i = 0; i < 2; ++i) oc[h][i] = on[h][i];
        if constexpr (ALIGN_EPI) { if (wr == 1) PG8_BAR; }
    }
    PG8_WAIT_V(0);
    if constexpr (!ALIGN_EPI) { if (wr == 0) PG8_BAR; }
    PG8_BAR;
#undef PG8_SA
#undef PG8_SB
#undef PG8_STAGE
#undef PG8_STAGEA
#undef PG8_OFFS
#undef PG8_LDA
#undef PG8_LDB
#undef PG8_MMA
#undef PG8_WAIT_V
#undef PG8_WAIT_L
#undef PG8_BAR
#undef PG8_SCHED
}
}
namespace att {
#ifndef ATT_INTERLEAVE
#define ATT_INTERLEAVE 0
#endif
constexpr int M_CAUSAL = 0, M_MOBA = 1, M_SWA = 2, M_DIFF = 3;
constexpr float RESCALE_THR = 8.0f;
__device__ __forceinline__ unsigned cvtpk(float lo, float hi) { unsigned r; asm volatile("v_cvt_pk_bf16_f32 %0, %1, %2" : "=v"(r) : "v"(lo), "v"(hi)); return r; }
__device__ __forceinline__ float max3f(float a, float b, float c) { float r; asm("v_max3_f32 %0, %1, %2, %3" : "=v"(r) : "v"(a), "v"(b), "v"(c)); return r; }
__device__ __forceinline__ float xhalf_max(float m) { const auto rr = __builtin_amdgcn_permlane32_swap(__float_as_uint(m), __float_as_uint(m), false, false); return fmaxf(__uint_as_float(rr[0]), __uint_as_float(rr[1])); }
__device__ __forceinline__ float xhalf_sum(float m) { const auto rr = __builtin_amdgcn_permlane32_swap(__float_as_uint(m), __float_as_uint(m), false, false); return __uint_as_float(rr[0]) + __uint_as_float(rr[1]); }
__device__ __forceinline__ void glds16(const void* sbase, unsigned voff, unsigned lds_dst) { unsigned keep;
    asm volatile("s_mov_b32 %0, m0\n\ts_mov_b32 m0, %3\n\ts_nop 0\n\tglobal_load_lds_dwordx4 %1, %2\n\ts_mov_b32 m0, %0" : "=&s"(keep) : "v"(voff), "s"(sbase), "s"(lds_dst) : "memory"); }
template <int DK, int DV, int MODE> struct Cfg {
    static constexpr int KCOLS = (MODE == M_DIFF) ? 2 * DK : DK;
    static constexpr int NKP = KCOLS / 16 * 2, NVP = 4 * (DV / 32), NP = NKP + NVP;
    static constexpr int KBYTES = NKP * 1024, VBYTES = NVP * 1024, BUF = KBYTES + VBYTES;
    static constexpr int QROWS = (MODE == M_DIFF) ? 128 : 256;
    static constexpr int LDS_BYTES = 2 * BUF;
};
struct Tens { const bf16_t* Q; const bf16_t* K; const bf16_t* V; bf16_t* O; int ldq, ldk, ldv, ldo; };


template <int NCH, int C, int MODE, bool MASKED>
__device__ __forceinline__ void sm_part(f32x16& p, float& mh, float& ls, bf16x8& pfA, bf16x8& pfB, int kvh  , int qabs, int hi) {
    if constexpr (C == 0) {
        if constexpr (MASKED) {
#pragma unroll
            for (int i = 0; i < 16; ++i) { const int kv = kvh + 16 * (i >> 3) + 8 * hi + (i & 7); bool m = kv > qabs; if constexpr (MODE == M_SWA) m = m || (kv < qabs - 127); if (m) p[i] = -INFINITY; }
        }
        float a = max3f(p[0], p[1], p[2]), b = max3f(p[3], p[4], p[5]);
        a = max3f(a, p[6], p[7]); b = max3f(b, p[8], p[9]); a = max3f(a, p[10], p[11]); b = max3f(b, p[12], p[13]); a = max3f(a, p[14], p[15]);
        mh = fmaxf(a, b);
    }
    constexpr int lo = 16 * C / NCH, hi_ = 16 * (C + 1) / NCH;
#pragma unroll
    for (int i = lo; i < hi_; ++i) p[i] = __builtin_amdgcn_exp2f(p[i]);
    if constexpr (C == NCH - 1) {
        float s0 = (p[0] + p[1]) + (p[2] + p[3]), s1 = (p[4] + p[5]) + (p[6] + p[7]), s2 = (p[8] + p[9]) + (p[10] + p[11]), s3 = (p[12] + p[13]) + (p[14] + p[15]);
        ls += (s0 + s1) + (s2 + s3);
        u32x4 w; w.x = cvtpk(p[0], p[1]); w.y = cvtpk(p[2], p[3]); w.z = cvtpk(p[4], p[5]); w.w = cvtpk(p[6], p[7]); pfA = __builtin_bit_cast(bf16x8, w);
        w.x = cvtpk(p[8], p[9]); w.y = cvtpk(p[10], p[11]); w.z = cvtpk(p[12], p[13]); w.w = cvtpk(p[14], p[15]); pfB = __builtin_bit_cast(bf16x8, w);
    }
}
__device__ __forceinline__ bf16x8 vtr_frag(const LAS unsigned char* vp) {
    const s16x4 lo = __builtin_bit_cast(s16x4, __builtin_amdgcn_ds_read_tr16_b64_v4i16((LAS s16x4*)(vp))); const s16x4 hh = __builtin_bit_cast(s16x4, __builtin_amdgcn_ds_read_tr16_b64_v4i16((LAS s16x4*)(vp + 256)));
    return (bf16x8){lo[0], lo[1], lo[2], lo[3], hh[0], hh[1], hh[2], hh[3]}; }
#define ATT_SB() __builtin_amdgcn_sched_barrier(0)
#define ATT_VGRP(dst, h_, g_) do { _Pragma("unroll") for (int dd_ = 0; dd_ < 2; ++dd_) _Pragma("unroll") for (int j_ = 0; j_ < 2; ++j_) dst[dd_][j_] = vtr_frag(bb + vfo + (4 * (2 * (g_) + dd_) + 2 * (h_) + j_) * 1024); } while (0)
#define ATT_PV1(frag, g_, c_, PA, PB) (o[2 * (g_) + ((c_) & 1)] = __builtin_amdgcn_mfma_f32_32x32x16_bf16(frag[(c_) & 1][(c_) >> 1], ((c_) >> 1) ? PB : PA, o[2 * (g_) + ((c_) & 1)], 0, 0, 0))
template <int DK, int DV, int MODE, bool MASKED>
__device__ __forceinline__ void tile_body(const LAS unsigned char* bb, const int kfo, const int vfo, const bf16x8 (&qf)[DK / 16], const float cinit, f32x16 (&o)[DV / 32], float& lsum, float& mxout, const int kv0, const int qabs, const int hi) {
    constexpr int NQK = DK / 16, ND = DV / 32, NPV = 2 * ND;
    bf16x8 kf[NQK][2];
#pragma unroll
    for (int d0 = 0; d0 < NQK; ++d0) { kf[d0][0] = *(const LAS bf16x8*)(bb + kfo + (2 * d0) * 1024); kf[d0][1] = *(const LAS bf16x8*)(bb + kfo + (2 * d0 + 1) * 1024); }
    f32x16 p0, p1;
#pragma unroll
    for (int i = 0; i < 16; ++i) { p0[i] = cinit; p1[i] = cinit; }
    ATT_SB();
#pragma unroll
    for (int d0 = 0; d0 < NQK; ++d0) p0 = __builtin_amdgcn_mfma_f32_32x32x16_bf16(kf[d0][0], qf[d0], p0, 0, 0, 0);
    ATT_SB();
    bf16x8 fa[2][2], fb[2][2]; bf16x8 pfA, pfB, pfC, pfD; float mh0 = 0.f, mh1 = 0.f, ls = 0.f;
    ATT_VGRP(fa, 0, 0);
    ATT_SB();
#define ATT_PIN2(a_, b_) asm volatile("" : "+v"(a_), "+v"(b_))
#define ATT_PIN1(a_) asm volatile("" : "+v"(a_))
#define ATT_QK1(c_) do { p1 = __builtin_amdgcn_mfma_f32_32x32x16_bf16(kf[c_][1], qf[c_], p1, 0, 0, 0); sm_part<NQK, c_, MODE, MASKED>(p0, mh0, ls, pfA, pfB, kv0, qabs, hi); \
        if constexpr ((c_) + 1 < NQK) ATT_PIN2(p0, kf[((c_) + 1) % NQK][1]); else ATT_PIN2(p0, fa[0][0]); } while (0)
    ATT_QK1(0); ATT_QK1(1); ATT_QK1(2); ATT_QK1(3);
    if constexpr (NQK == 6) { ATT_QK1(4); ATT_QK1(5); }
#undef ATT_QK1
#define ATT_PVSM(frag, g_, c_, part_, nxt_) do { ATT_PV1(frag, g_, c_, pfA, pfB); sm_part<NPV, part_, MODE, MASKED>(p1, mh1, ls, pfC, pfD, kv0 + 32, qabs, hi); ATT_PIN2(p1, nxt_); } while (0)
    if constexpr (ND == 2) {
        ATT_VGRP(fb, 1, 0);
        ATT_PVSM(fa, 0, 0, 0, fa[1][0]); ATT_PVSM(fa, 0, 1, 1, fa[0][1]); ATT_PVSM(fa, 0, 2, 2, fa[1][1]); ATT_PVSM(fa, 0, 3, 3, fb[0][0]);
        ATT_PV1(fb, 0, 0, pfC, pfD); ATT_PV1(fb, 0, 1, pfC, pfD); ATT_PV1(fb, 0, 2, pfC, pfD); ATT_PV1(fb, 0, 3, pfC, pfD);
    } else {
        ATT_VGRP(fb, 0, 1);
        ATT_PVSM(fa, 0, 0, 0, fa[1][0]); ATT_PVSM(fa, 0, 1, 1, fa[0][1]); ATT_PVSM(fa, 0, 2, 2, fa[1][1]); ATT_PVSM(fa, 0, 3, 3, fb[0][0]);
        ATT_VGRP(fa, 1, 0);
        ATT_PVSM(fb, 1, 0, 4, fb[1][0]); ATT_PVSM(fb, 1, 1, 5, fb[0][1]); ATT_PVSM(fb, 1, 2, 6, fb[1][1]); ATT_PVSM(fb, 1, 3, 7, fa[0][0]);
        ATT_VGRP(fb, 1, 1);
        ATT_PV1(fa, 0, 0, pfC, pfD); ATT_PV1(fa, 0, 1, pfC, pfD); ATT_PV1(fa, 0, 2, pfC, pfD); ATT_PV1(fa, 0, 3, pfC, pfD);
        ATT_PV1(fb, 1, 0, pfC, pfD); ATT_PV1(fb, 1, 1, pfC, pfD); ATT_PV1(fb, 1, 2, pfC, pfD); ATT_PV1(fb, 1, 3, pfC, pfD);
    }
#undef ATT_PVSM
#undef ATT_PIN2
#undef ATT_PIN1
    lsum += ls;
    mxout = xhalf_max(fmaxf(mh0, mh1));
}
#undef ATT_VGRP
#undef ATT_PV1

template <int DK, int DV, int MODE, int ABL = 0>
__device__ __forceinline__ void unit(const Tens& T, int b, int qb, const float* kmean, float sink, float lam, const float* gsub, float gscale, LAS unsigned char* lds, const int tid) {
    typedef Cfg<DK, DV, MODE> G;
    asm volatile("; UNIT_BEGIN %0 %1 %2" :: "n"(DK), "n"(DV), "n"(MODE));
    const int lane = tid & 63, r32 = lane & 31, hi = lane >> 5; const int wid = __builtin_amdgcn_readfirstlane(tid >> 6);
    const int strm = (MODE == M_DIFF) ? (wid >> 2) : 0, wq = (MODE == M_DIFF) ? (wid & 3) : wid;
    const size_t rowbase = (size_t)b * SEQ;
    const int q0 = qb * G::QROWS, qw0 = q0 + wq * 32, qabs = qw0 + r32;
    bf16x8 qf[DK / 16];
    { const char* qrow = (const char*)(T.Q + (rowbase + qw0) * T.ldq + strm * DK);
      unsigned qlo = (unsigned)(r32 * T.ldq + 8 * hi) * 2u; asm volatile("" : "+v"(qlo));
#pragma unroll
      for (int d0 = 0; d0 < DK / 16; ++d0) qf[d0] = *(const bf16x8*)(qrow + qlo + 32 * d0); }
    int sel0 = -1, sel1 = -1, sel2 = -1;
    int t_lo = 0; const int t_hi = (q0 + G::QROWS) >> 6;
    if constexpr (MODE == M_SWA) t_lo = qb == 0 ? 0 : qb * 4 - 2;
    const int krow = (r32 & 0x13) | ((r32 & 4) << 1) | ((r32 & 8) >> 1);
    const unsigned koff = (unsigned)(krow * T.ldk + 8 * hi) * 2u, voff = (unsigned)((lane >> 2) * T.ldv + 8 * (lane & 3)) * 2u;
    const char* Kg = (const char*)(T.K + rowbase * T.ldk); const char* Vg = (const char*)(T.V + rowbase * T.ldv);
    const unsigned lds0 = (unsigned)(uintptr_t)lds;
#define ATT_DMA(t, bsel) do { _Pragma("unroll") for (int p_ = 0; p_ < (G::NP + 7) / 8; ++p_) { const int pc_ = wid + 8 * p_; if (pc_ < G::NP) { \
        if (pc_ < G::NKP) { const char* s_ = Kg + ((size_t)((t) * 64 + 32 * (pc_ & 1)) * T.ldk + 16 * (pc_ >> 1)) * 2; \
            glds16(s_, koff, (unsigned)__builtin_amdgcn_readfirstlane((int)(lds0 + (bsel) * G::BUF + pc_ * 1024))); } \
        else { const int pv_ = pc_ - G::NKP; const char* s_ = Vg + ((size_t)((t) * 64 + 16 * (pv_ & 3)) * T.ldv + 32 * (pv_ >> 2)) * 2; \
            glds16(s_, voff, (unsigned)__builtin_amdgcn_readfirstlane((int)(lds0 + (bsel) * G::BUF + G::KBYTES + pv_ * 1024))); } } } } while (0)
    float mref = 0.f, lsum = 0.f, mxprev = -INFINITY;
    if constexpr (MODE == M_SWA) lsum = hi == 0 ? __builtin_amdgcn_exp2f(sink) : 0.f;
    f32x16 o[DV / 32];
#pragma unroll
    for (int d = 0; d < DV / 32; ++d) o[d] = f32x16{};
    const int kfo = (strm * (DK / 16) * 2) * 1024 + hi * 512 + r32 * 16;
    const int i16 = lane & 15;
    const int vfo = G::KBYTES + (8 * hi + (i16 >> 2)) * 64 + (16 * (r32 >> 4) + 4 * (i16 & 3)) * 2;
    if constexpr (MODE == M_MOBA) {
        LAS float* ks = (LAS float*)(lds + 49152);
        if (tid < 256) { const int j = tid >> 4, d4 = (tid & 15) * 4; const f32x4 a = *(const f32x4*)(kmean + j * 128 + d4), c = *(const f32x4*)(kmean + j * 128 + 64 + d4); *(LAS f32x4*)(ks + j * 64 + d4) = a + c; }
        asm volatile("s_waitcnt lgkmcnt(0)" ::: "memory");
    }
    __builtin_amdgcn_s_barrier();
    ATT_DMA(t_lo, 0);
    if constexpr (MODE == M_MOBA) {
        float b0 = -INFINITY, b1 = -INFINITY, b2 = -INFINITY;
        float qv[32];
#pragma unroll
        for (int d0 = 0; d0 < 4; ++d0)
#pragma unroll
            for (int e = 0; e < 8; ++e) qv[8 * d0 + e] = bf2f((unsigned short)qf[d0][e]);
        const LAS float* kp = (const LAS float*)(lds + 49152) + 8 * hi;
#pragma unroll 1
        for (int j = 0; j < qb; ++j, kp += 64) {
            float a = 0.f;
#pragma unroll
            for (int d0 = 0; d0 < 4; ++d0) { const f32x4 k0 = *(const LAS f32x4*)(kp + 16 * d0), k1 = *(const LAS f32x4*)(kp + 16 * d0 + 4);
#pragma unroll
                for (int e = 0; e < 4; ++e) { a += qv[8 * d0 + e] * k0[e]; a += qv[8 * d0 + 4 + e] * k1[e]; } }
            a += shx<32>(a);
            if (a > b0) { b2 = b1; sel2 = sel1; b1 = b0; sel1 = sel0; b0 = a; sel0 = j; }
            else if (a > b1) { b2 = b1; sel2 = sel1; b1 = a; sel1 = j; }
            else if (a > b2) { b2 = a; sel2 = j; }
        }
    }
    for (int t = t_lo; t < t_hi; ++t) {
        const int bsel = (t - t_lo) & 1;
        __builtin_amdgcn_s_waitcnt(0x0F70);
        if constexpr (!(ABL & 16)) __builtin_amdgcn_s_barrier();
        if (t + 1 < t_hi) ATT_DMA(t + 1, bsel ^ 1);
        const int kv0 = t * 64;
        bool skip = kv0 > qw0 + 31;
        if constexpr (MODE == M_SWA) skip = skip || (kv0 + 63 < qw0 - 127);
        bool lane_on = true;
        if constexpr (MODE == M_MOBA) { if (kv0 < q0) { const int jb = kv0 >> 8; lane_on = (jb == sel0 || jb == sel1 || jb == sel2); skip = skip || !__any(lane_on); } }
        if (skip) continue;
        if constexpr (ABL & 64) { lsum += (float)t; continue; }
        if (!__all(mxprev <= RESCALE_THR)) {
            const float dm = fmaxf(mxprev, 0.f), alpha = __builtin_amdgcn_exp2f(-dm);
            mref += dm; lsum *= alpha;
#pragma unroll
            for (int d = 0; d < DV / 32; ++d)
#pragma unroll
                for (int i = 0; i < 16; ++i) o[d][i] *= alpha;
        }
        const float cinit = lane_on ? -mref : -INFINITY;
        if constexpr (DV == 64 && ATT_INTERLEAVE) {
        const LAS unsigned char* bb = lds + bsel * G::BUF;
        bool need_mask = kv0 + 63 > qw0;
        if constexpr (MODE == M_SWA) need_mask = need_mask || (kv0 < qw0 + 31 - 127);
        if (need_mask) tile_body<DK, DV, MODE, true>(bb, kfo, vfo, qf, cinit, o, lsum, mxprev, kv0, qabs, hi);
        else tile_body<DK, DV, MODE, false>(bb, kfo, vfo, qf, cinit, o, lsum, mxprev, kv0, qabs, hi);
        } else {
        const LAS unsigned char* bb = lds + bsel * G::BUF;
        bf16x8 kf[DK / 16][2];
#pragma unroll
        for (int d0 = 0; d0 < DK / 16; ++d0) { kf[d0][0] = *(const LAS bf16x8*)(bb + kfo + (2 * d0) * 1024); kf[d0][1] = *(const LAS bf16x8*)(bb + kfo + (2 * d0 + 1) * 1024); }
        f32x16 p0, p1;
#pragma unroll
        for (int i = 0; i < 16; ++i) { p0[i] = cinit; p1[i] = cinit; }
        __builtin_amdgcn_sched_barrier(0);
#pragma unroll
        for (int d0 = 0; d0 < DK / 16; ++d0) {
            p0 = __builtin_amdgcn_mfma_f32_32x32x16_bf16(kf[d0][0], qf[d0], p0, 0, 0, 0);
            p1 = __builtin_amdgcn_mfma_f32_32x32x16_bf16(kf[d0][1], qf[d0], p1, 0, 0, 0);
        }
        __builtin_amdgcn_sched_barrier(0);
        bf16x8 vf[2][4];
#define ATT_VLOAD(dbase) do { _Pragma("unroll") for (int d_ = 0; d_ < 2; ++d_) _Pragma("unroll") for (int s2 = 0; s2 < 4; ++s2) { const LAS unsigned char* vp = bb + vfo + (4 * ((dbase) + d_) + s2) * 1024; \
            const s16x4 lo = __builtin_bit_cast(s16x4, __builtin_amdgcn_ds_read_tr16_b64_v4i16((LAS s16x4*)(vp))); const s16x4 hh = __builtin_bit_cast(s16x4, __builtin_amdgcn_ds_read_tr16_b64_v4i16((LAS s16x4*)(vp + 256))); \
            vf[d_][s2] = (bf16x8){lo[0], lo[1], lo[2], lo[3], hh[0], hh[1], hh[2], hh[3]}; } } while (0)
        ATT_VLOAD(0);
        __builtin_amdgcn_sched_barrier(0);
        bool need_mask = kv0 + 63 > qw0;
        if constexpr (MODE == M_SWA) need_mask = need_mask || (kv0 < qw0 + 31 - 127);
        if (need_mask) {
#pragma unroll
            for (int i = 0; i < 16; ++i) { const int kv = kv0 + 16 * (i >> 3) + 8 * hi + (i & 7);
                bool m0 = kv > qabs, m1 = kv + 32 > qabs;
                if constexpr (MODE == M_SWA) { m0 = m0 || (kv < qabs - 127); m1 = m1 || (kv + 32 < qabs - 127); }
                if (m0) p0[i] = -INFINITY; if (m1) p1[i] = -INFINITY; }
        }
        float mx = max3f(p0[0], p1[0], p0[1]), mxb = max3f(p1[1], p0[2], p1[2]);
#pragma unroll
        for (int i = 3; i < 15; i += 2) { mx = max3f(mx, p0[i], p1[i]); mxb = max3f(mxb, p0[i + 1], p1[i + 1]); }
        mx = max3f(mx, p0[15], p1[15]); mx = fmaxf(mx, mxb);
        mx = xhalf_max(mx);
        mxprev = mx;
        float ls0 = 0.f, ls1 = 0.f;
#pragma unroll
        for (int i = 0; i < 16; ++i) { p0[i] = __builtin_amdgcn_exp2f(p0[i]); p1[i] = __builtin_amdgcn_exp2f(p1[i]); ls0 += p0[i]; ls1 += p1[i]; }
        lsum += ls0 + ls1;
        bf16x8 pf[4];
#pragma unroll
        for (int s2 = 0; s2 < 4; ++s2) { const f32x16& pp = (s2 >> 1) ? p1 : p0; const int b0 = 8 * (s2 & 1);
            u32x4 w; w.x = cvtpk(pp[b0 + 0], pp[b0 + 1]); w.y = cvtpk(pp[b0 + 2], pp[b0 + 3]); w.z = cvtpk(pp[b0 + 4], pp[b0 + 5]); w.w = cvtpk(pp[b0 + 6], pp[b0 + 7]);
            pf[s2] = __builtin_bit_cast(bf16x8, w); }
        __builtin_amdgcn_sched_barrier(0);
        if constexpr (DV == 64) {
#pragma unroll
            for (int d = 0; d < 2; ++d)
#pragma unroll
                for (int s2 = 0; s2 < 4; ++s2) o[d] = __builtin_amdgcn_mfma_f32_32x32x16_bf16(vf[d][s2], pf[s2], o[d], 0, 0, 0);
        } else {
            bf16x8 vg[2][4];
#pragma unroll
            for (int d_ = 0; d_ < 2; ++d_)
#pragma unroll
                for (int s2 = 0; s2 < 4; ++s2) { const LAS unsigned char* vp = bb + vfo + (4 * (2 + d_) + s2) * 1024;
                    const s16x4 lo = __builtin_bit_cast(s16x4, __builtin_amdgcn_ds_read_tr16_b64_v4i16((LAS s16x4*)(vp))); const s16x4 hh = __builtin_bit_cast(s16x4, __builtin_amdgcn_ds_read_tr16_b64_v4i16((LAS s16x4*)(vp + 256)));
                    vg[d_][s2] = (bf16x8){lo[0], lo[1], lo[2], lo[3], hh[0], hh[1], hh[2], hh[3]}; }
            __builtin_amdgcn_sched_barrier(0);
#pragma unroll
            for (int d = 0; d < 2; ++d)
#pragma unroll
                for (int s2 = 0; s2 < 4; ++s2) o[d] = __builtin_amdgcn_mfma_f32_32x32x16_bf16(vf[d][s2], pf[s2], o[d], 0, 0, 0);
            __builtin_amdgcn_sched_barrier(0);
#pragma unroll
            for (int d = 0; d < 2; ++d)
#pragma unroll
                for (int s2 = 0; s2 < 4; ++s2) o[2 + d] = __builtin_amdgcn_mfma_f32_32x32x16_bf16(vg[d][s2], pf[s2], o[2 + d], 0, 0, 0);
        }
        }
    }
#undef ATT_DMA
    const float inv = 1.0f / xhalf_sum(lsum);
    if constexpr (MODE == M_DIFF) {
        LAS float* xch = (LAS float*)lds;
        __builtin_amdgcn_s_barrier();
        if (strm == 1) {
#pragma unroll
            for (int d = 0; d < DV / 32; ++d)
#pragma unroll
                for (int i = 0; i < 16; ++i) xch[((wq * (DV / 32) + d) * 16 + i) * 64 + lane] = o[d][i] * inv;
        }
        asm volatile("s_waitcnt lgkmcnt(0)" ::: "memory");
        __builtin_amdgcn_s_barrier();
        if (strm == 0) {
            float ss = 0.f;
#pragma unroll
            for (int d = 0; d < DV / 32; ++d)
#pragma unroll
                for (int i = 0; i < 16; ++i) { const float v = o[d][i] * inv - lam * xch[((wq * (DV / 32) + d) * 16 + i) * 64 + lane]; o[d][i] = v; ss += v * v; }
            ss = xhalf_sum(ss);
            const float rr = gscale / sqrtf(ss * (1.0f / DV) + 1e-5f);
            char* orow = (char*)(T.O + (rowbase + qw0) * T.ldo); unsigned olo = (unsigned)(r32 * T.ldo + 4 * hi) * 2u; asm volatile("" : "+v"(olo)); bf16_t* op = (bf16_t*)(orow + olo);
#pragma unroll
            for (int d = 0; d < DV / 32; ++d)
#pragma unroll
                for (int g4 = 0; g4 < 4; ++g4) { const f32x4 gg = *(const f32x4*)(gsub + 32 * d + 8 * g4 + 4 * hi);
                    u32x2 w; w.x = cvtpk(o[d][4 * g4] * rr * gg[0], o[d][4 * g4 + 1] * rr * gg[1]); w.y = cvtpk(o[d][4 * g4 + 2] * rr * gg[2], o[d][4 * g4 + 3] * rr * gg[3]); *(u32x2*)(op + 32 * d + 8 * g4) = w; }
        }
    } else {
        char* orow = (char*)(T.O + (rowbase + qw0) * T.ldo); unsigned olo = (unsigned)(r32 * T.ldo + 4 * hi) * 2u; asm volatile("" : "+v"(olo)); bf16_t* op = (bf16_t*)(orow + olo);
#pragma unroll
        for (int d = 0; d < DV / 32; ++d)
#pragma unroll
            for (int g4 = 0; g4 < 4; ++g4) { u32x2 w; w.x = cvtpk(o[d][4 * g4] * inv, o[d][4 * g4 + 1] * inv); w.y = cvtpk(o[d][4 * g4 + 2] * inv, o[d][4 * g4 + 3] * inv); *(u32x2*)(op + 32 * d + 8 * g4) = w; }
    }
}
}
constexpr int NWAVES = 8, NTHREADS = 512;
constexpr size_t MiB = 1u << 20;
constexpr size_t WS_CTL = 0, CTL_ZERO_BYTES = 1 * MiB;
constexpr size_t WS_SMALLW = 1 * MiB;
constexpr size_t SW_LAYER = 8 * MiB, SW_WOUT = 4608 * 1024, SW_WQB = SW_WOUT + 2 * MiB, SW_WKVB = SW_WQB + 384 * 1024;
static_assert(SW_WKVB + 512 * 1024 <= SW_LAYER, "small weights");
constexpr size_t WS_WR = WS_SMALLW + 4 * SW_LAYER;
constexpr size_t WS_ROPE = WS_WR + 4 * MiB;
constexpr size_t WS_KMEAN = WS_ROPE + 8 * MiB;
constexpr size_t WS_WGU = WS_KMEAN + 1 * MiB;
constexpr size_t WS_WD = WS_WGU + 65 * MiB;
constexpr size_t WS_ROWTOK = WS_WD + 33 * MiB;
constexpr size_t WS_WSLOT = WS_ROWTOK + 8 * MiB;
constexpr size_t WS_TOKE = WS_WSLOT + 8 * MiB;
constexpr size_t WS_TOKP = WS_TOKE + 1 * MiB;
constexpr size_t WS_XF = WS_TOKP + 1 * MiB;
constexpr size_t WS_HS = WS_XF + 128 * MiB;
constexpr size_t WS_YS = WS_HS + 152 * MiB;
constexpr size_t WS_END = WS_YS + 544 * MiB;
static_assert(WS_END <= 1024 * MiB, "workspace map exceeds 1 GiB");
constexpr size_t A_HB = WS_YS;
constexpr size_t A_QF = A_HB, A_KVF = A_HB + 48 * MiB;
constexpr size_t A_SSQ = A_HB;
constexpr size_t A_Q1 = A_HB + 144 * MiB;
constexpr size_t A_K1 = A_Q1 + 32 * MiB;
constexpr size_t A_V1 = A_K1 + 32 * MiB;
constexpr size_t A_X1 = A_V1 + 32 * MiB;
constexpr size_t A_X2 = A_X1 + 32 * MiB;
constexpr size_t A_Q2 = A_X2 + 32 * MiB;
constexpr size_t A_OB = A_Q2 + 128 * MiB;
static_assert(A_OB + 64 * MiB <= WS_END, "attention overlay");
constexpr size_t A_Y = A_Q1;
constexpr size_t A_XS = WS_YS;
constexpr size_t WS_YSH = WS_YS + 272 * MiB;
constexpr size_t A_LOG = WS_YS + 128 * MiB;
constexpr int CW_BAR = 4096;
constexpr int CW_CNT = 16384;
constexpr int RING_BYTES = 131072;
constexpr int LX_BAR = RING_BYTES;
constexpr int LX_CNT = RING_BYTES + 64;
constexpr int LX_TST = LX_CNT + 256;
constexpr int LX_TEXP = LX_TST + 320;
constexpr int LDS_BYTES = 147456;
static_assert(LX_TEXP + 1280 <= LDS_BYTES, "LDS map");

#define XB_TMO      128
#define XB_XCNT(j)  (256  + 64 * (j))
#define XB_XSUB(j)  (1280 + 64 * (j))
#define XB_XGEN(j)  (2304 + 64 * (j))
#define XB_TOP      3328
#define XB_TOPGEN   3392
#define XCD_BAR_WORDS 3456
#define XB_SPIN_CAP (1u << 20)
__device__ __forceinline__ unsigned xb_ld(unsigned* p)              { return __hip_atomic_load(p, __ATOMIC_RELAXED, __HIP_MEMORY_SCOPE_AGENT); }
__device__ __forceinline__ unsigned xb_add(unsigned* p, unsigned v) { return __hip_atomic_fetch_add(p, v, __ATOMIC_RELAXED, __HIP_MEMORY_SCOPE_AGENT); }
__device__ __forceinline__ unsigned xb_xcc_id() { return (unsigned)__builtin_amdgcn_s_getreg((3 << 11) | 20) & 0xFu; }
#define XB_SPIN(cond, bar) do { unsigned _sp = 0; while (cond) { __builtin_amdgcn_s_sleep(1); \
    if ((++_sp & 255u) == 0u) { if (xb_ld(&(bar)[XB_TMO])) break; if (_sp > XB_SPIN_CAP) { atomicAdd(&(bar)[XB_TMO], 1u); break; } } } } while (0)
struct XcdBarrier { unsigned* bar; unsigned x; volatile LAS unsigned* st; };
__device__ __forceinline__ XcdBarrier xcd_barrier_post(unsigned* bar, volatile LAS unsigned* st) {
    XcdBarrier b; b.bar = bar; b.x = xb_xcc_id(); b.st = st;
    if (threadIdx.x == 0) (void)xb_add(&bar[XB_XCNT(b.x)], 1u);
    return b;
}
__device__ __forceinline__ void xcd_barrier_complete(unsigned* bar, unsigned x, unsigned& nloc, unsigned& nx) {
    const unsigned G = gridDim.x * gridDim.y * gridDim.z;
    unsigned sum, cnt, mine, sp = 0u;
    for (;;) {
        sum = 0u; cnt = 0u; mine = 0u;
#pragma unroll
        for (unsigned j = 0; j < 16; ++j) { const unsigned c = xb_ld(&bar[XB_XCNT(j)]); sum += c; cnt += (c > 0u) ? 1u : 0u; mine = (j == x) ? c : mine; }
        if (sum == G) break;
        __builtin_amdgcn_s_sleep(1);
        if ((++sp & 255u) == 0u) { if (xb_ld(&bar[XB_TMO])) break; if (sp > XB_SPIN_CAP) { atomicAdd(&bar[XB_TMO], 1u); break; } }
    }
    nloc = mine > 0u ? mine : 1u; nx = cnt > 0u ? cnt : 1u;
}
__device__ __forceinline__ void xcd_barrier(const XcdBarrier& b, const bool leader) {
    asm volatile("s_waitcnt vmcnt(0)" ::: "memory");
    __syncthreads();
    if (leader) {
        unsigned* bar = b.bar; const unsigned bx = xb_xcc_id();
        __builtin_amdgcn_s_waitcnt(0);
        unsigned nloc = b.st[0], nx = b.st[1];
        if (nloc == 0u) { xcd_barrier_complete(bar, bx, nloc, nx); b.st[0] = nloc; b.st[1] = nx; }
        const unsigned old = xb_add(&bar[XB_XSUB(bx)], 1u);
        const unsigned gen = old / nloc;
        if (old + 1u == (gen + 1u) * nloc) {
            __builtin_amdgcn_fence(__ATOMIC_RELEASE, "agent");
            asm volatile("s_waitcnt vmcnt(0)" ::: "memory");
            const unsigned og = xb_add(&bar[XB_TOP], 1u);
            const unsigned tg = og / nx;
            if (og + 1u == (tg + 1u) * nx) xb_add(&bar[XB_TOPGEN], 1u);
            else XB_SPIN(xb_ld(&bar[XB_TOPGEN]) == tg, bar);
            __builtin_amdgcn_fence(__ATOMIC_ACQUIRE, "agent");
            xb_add(&bar[XB_XGEN(bx)], 1u);
            asm volatile("s_waitcnt vmcnt(0)" ::: "memory");
        } else {
            XB_SPIN(xb_ld(&bar[XB_XGEN(bx)]) == gen, bar);
            __builtin_amdgcn_fence(__ATOMIC_ACQUIRE, "agent");
            asm volatile("s_waitcnt vmcnt(0)" ::: "memory");
        }
    }
    __syncthreads();
}

struct Args {
    const float* x; const int* pos;
    const float *ev_w_in, *ev_w_out, *mla_g_qa, *mla_w_qb, *mla_g_kva, *mla_w_kvb, *od_w_in, *od_w_out, *swa_sinks, *diff_lambda, *diff_g_subln, *ln_g, *ln_b,
                *moe_w_router, *moe_bias, *moe_w_gate, *moe_w_up, *moe_w_down, *sh_w_gate, *sh_w_up, *sh_w_down;
    float* out; unsigned char* ws;
    int st_lo, st_hi, use_bar, pad;
};

__device__ __forceinline__ int wrow_map(int mode, int n);
__device__ __forceinline__ void transpose_item(const float* W, int N, int k0, int n0, bf16_t* WT, int ldk, int dst_row0, LAS float* scr, int lane, int mode = 0) {
#pragma unroll 8
    for (int i = 0; i < 32; ++i) { const int kk = 2 * i + (lane >> 5); scr[kk * 33 + (lane & 31)] = W[(size_t)(k0 + kk) * N + n0 + (lane & 31)]; }
    asm volatile("s_waitcnt lgkmcnt(0)" ::: "memory");
    const int c = lane & 7;
#pragma unroll
    for (int j = 0; j < 4; ++j) { const int n = (lane >> 3) + 8 * j; const LAS float* s = scr + (8 * c) * 33 + n;
        u32x4 o; o.x = pk2(s[0 * 33], s[1 * 33]); o.y = pk2(s[2 * 33], s[3 * 33]); o.z = pk2(s[4 * 33], s[5 * 33]); o.w = pk2(s[6 * 33], s[7 * 33]);
        const int drow = mode ? wrow_map(mode, n0 + n) : dst_row0 + n;
        *(u32x4*)(WT + (size_t)drow * ldk + k0 + 8 * c) = o; }
    asm volatile("s_waitcnt lgkmcnt(0)" ::: "memory");
}
__device__ __forceinline__ void sincos_acc(float angf, float& c, float& s) {
    const double x = (double)angf;
    const double n = __builtin_rint(x * 0.63661977236758134308);
    double r = x - n * 1.57079632679489655800; r -= n * 6.12323399573676603587e-17;
    const long q = (long)n;
    const double r2 = r * r;
    double sp = -2.5052108385441718775e-08; sp = sp * r2 + 2.7557319223985890653e-06; sp = sp * r2 - 1.9841269841269841270e-04; sp = sp * r2 + 8.3333333333333333333e-03; sp = sp * r2 - 1.6666666666666666667e-01;
    const double sn = r + r * r2 * sp;
    double cp = 2.0876756987868098979e-09; cp = cp * r2 - 2.7557319223985890653e-07; cp = cp * r2 + 2.4801587301587301587e-05; cp = cp * r2 - 1.3888888888888888889e-03; cp = cp * r2 + 4.1666666666666666667e-02; cp = cp * r2 - 0.5;
    const double cs = 1.0 + r2 * cp;
    double so, co;
    switch ((int)(q & 3)) { case 0: so = sn; co = cs; break; case 1: so = cs; co = -sn; break; case 2: so = -sn; co = -cs; break; default: so = -cs; co = sn; break; }
    s = (float)so; c = (float)co;
}
__host__ __device__ __forceinline__ int perm64(int f) { const int n = f >> 5, r = f & 31, G = r >> 4, fq = (r & 15) >> 2, i = r & 3; return 32 * G + 8 * fq + 4 * n + i; }
__host__ __device__ __forceinline__ int perm_pe(int f) { const int n = f >> 4, r = f & 15, fq = r >> 2, i = r & 3; return 8 * fq + 4 * n + i; }
__device__ __forceinline__ int wrow_map(int mode, int n) {
    if (mode == 1) { if (n < 1024) return (n & ~63) + perm64(n & 63); if (n >= 1920) return 1920 + perm_pe(n - 1920); return n; }
    if (mode == 2) { if (n < 640 || (n >= 768 && n < 1792)) return (n & ~63) + perm64(n & 63); return n; }
    if (mode == 3) { const int h = n / 96, w = n - 96 * h; return w < 64 ? n : 96 * h + 64 + perm_pe(w - 64); }
    if (mode == 4) { const int o = n & 255, wc = o >> 6, fq = (o >> 4) & 3, bj = (o >> 3) & 1, j = o & 7; return (n & ~255) + 128 * bj + 32 * wc + 8 * fq + j; }
    return n;
}
constexpr float QS_64 = 0.125f * LOG2E;
constexpr float QS_96 = 0.10206207261596577f * LOG2E;

__device__ __forceinline__ u32x2 pack4(float a, float b, float c, float d) { u32x2 w; w.x = pg8::cvt_pk_bf16(a, b); w.y = pg8::cvt_pk_bf16(c, d); return w; }
__device__ __forceinline__ u32x4 pack8(const f32x4& v0, const f32x4& v1) { u32x4 w; w.x = pg8::cvt_pk_bf16(v0[0], v0[1]); w.y = pg8::cvt_pk_bf16(v0[2], v0[3]); w.z = pg8::cvt_pk_bf16(v1[0], v1[1]); w.w = pg8::cvt_pk_bf16(v1[2], v1[3]); return w; }

struct EpiWin {
    static constexpr bool PERM = true;
    unsigned char* ws; int even; const float* g_qa; const float* g_kva;
    __device__ __forceinline__ void rope_half(const f32x4 (&acc)[2][2][4][2], int bj, const pg8::Unit& u, int rowl, int wr, int wc, int fr, int fq, bf16_t* dst, int ld, int head0, float sc, bool km) const {
        const f32x2* rope = (const f32x2*)(ws + WS_ROPE);
        const int head = head0 + (wc >> 1), G = wc & 1, f0 = 16 * G + 4 * fq;
        float s1[4] = {0.f, 0.f, 0.f, 0.f}, s2[4] = {0.f, 0.f, 0.f, 0.f};
#pragma unroll
        for (int ai = 0; ai < 2; ++ai)
#pragma unroll
            for (int m = 0; m < 4; ++m) { const size_t r = (size_t)(u.orow + rowl + ai * 128 + m * 16);
                const f32x4 c01 = *(const f32x4*)(rope + r * 32 + f0), c23 = *(const f32x4*)(rope + r * 32 + f0 + 2);
                const f32x4 x1 = acc[ai][bj][m][0], x2 = acc[ai][bj][m][1];
                float o1[4], o2[4];
                o1[0] = x1[0] * c01[0] - x2[0] * c01[1]; o2[0] = x2[0] * c01[0] + x1[0] * c01[1];
                o1[1] = x1[1] * c01[2] - x2[1] * c01[3]; o2[1] = x2[1] * c01[2] + x1[1] * c01[3];
                o1[2] = x1[2] * c23[0] - x2[2] * c23[1]; o2[2] = x2[2] * c23[0] + x1[2] * c23[1];
                o1[3] = x1[3] * c23[2] - x2[3] * c23[3]; o2[3] = x2[3] * c23[2] + x1[3] * c23[3];
                bf16_t* dp = dst + r * ld + 64 * head + f0;
                *(u32x2*)dp = pack4(o1[0] * sc, o1[1] * sc, o1[2] * sc, o1[3] * sc); *(u32x2*)(dp + 32) = pack4(o2[0] * sc, o2[1] * sc, o2[2] * sc, o2[3] * sc);
                if (km) {
#pragma unroll
                    for (int i = 0; i < 4; ++i) { s1[i] += o1[i]; s2[i] += o2[i]; } } }
        if (km) {
#pragma unroll
            for (int i = 0; i < 4; ++i) {
                s1[i] += shx<1>(s1[i]); s1[i] += shx<2>(s1[i]); s1[i] += shx<4>(s1[i]); s1[i] += shx<8>(s1[i]);
                s2[i] += shx<1>(s2[i]); s2[i] += shx<2>(s2[i]); s2[i] += shx<4>(s2[i]); s2[i] += shx<8>(s2[i]); }
            if (fr == 0) { const int t = u.orow >> 8, b = t >> 4, j = t & 15; float* kp = (float*)(ws + WS_KMEAN) + ((((size_t)b * 8 + head) * 16 + j) * 2 + wr) * 64 + f0;
                *(f32x4*)kp = (f32x4){s1[0], s1[1], s1[2], s1[3]}; *(f32x4*)(kp + 32) = (f32x4){s2[0], s2[1], s2[2], s2[3]}; }
        }
    }
    __device__ __forceinline__ void plain_half(const f32x4 (&acc)[2][2][4][2], int bj, const pg8::Unit& u, int rowl, int wc, int fq, bf16_t* dst, int ld) const {
#pragma unroll
        for (int ai = 0; ai < 2; ++ai)
#pragma unroll
            for (int m = 0; m < 4; ++m) { const size_t r = (size_t)(u.orow + rowl + ai * 128 + m * 16); *(u32x4*)(dst + r * ld + 32 * wc + 8 * fq) = pack8(acc[ai][bj][m][0], acc[ai][bj][m][1]); }
    }
    __device__ __forceinline__ void lat_half(const f32x4 (&acc)[2][2][4][2], int bj, const pg8::Unit& u, int rowl, int wc, int fq, bf16_t* dst, int col0, const float* g, float* ssq, int nparts, int part) const {
        const int c = col0 + 32 * wc + 8 * fq; const f32x4 g0 = *(const f32x4*)(g + c), g1 = *(const f32x4*)(g + c + 4);
#pragma unroll
        for (int ai = 0; ai < 2; ++ai)
#pragma unroll
            for (int m = 0; m < 4; ++m) { const size_t r = (size_t)(u.orow + rowl + ai * 128 + m * 16); const f32x4 x0 = acc[ai][bj][m][0], x1 = acc[ai][bj][m][1];
                float ss = (x0[0] * x0[0] + x0[1] * x0[1]) + (x0[2] * x0[2] + x0[3] * x0[3]) + (x1[0] * x1[0] + x1[1] * x1[1]) + (x1[2] * x1[2] + x1[3] * x1[3]);
                ss += shx<16>(ss); ss += shx<32>(ss);
                *(u32x4*)(dst + r * 256 + c) = pack8(x0 * g0, x1 * g1);
                if (fq == 0) ssq[r * nparts + part] = ss; }
    }
    __device__ __forceinline__ void operator()(const f32x4 (&acc)[2][2][4][2], const pg8::Unit& u, int wr, int wc, int fr, int fq) const {
        const int rowl = wr * 64 + fr;
#pragma unroll
        for (int bj = 0; bj < 2; ++bj) {
            const int hk = (u.ocol >> 7) + bj;
            if (even) {
                if (hk < 4) rope_half(acc, bj, u, rowl, wr, wc, fr, fq, (bf16_t*)(ws + A_Q1), 512, 2 * hk, QS_64, false);
                else if (hk < 8) rope_half(acc, bj, u, rowl, wr, wc, fr, fq, (bf16_t*)(ws + A_K1), 512, 2 * (hk - 4), 1.0f, true);
                else if (hk < 12) plain_half(acc, bj, u, rowl, wc, fq, (bf16_t*)(ws + A_V1) + 128 * (hk - 8), 512);
                else if (hk < 14) lat_half(acc, bj, u, rowl, wc, fq, (bf16_t*)(ws + A_X1), 128 * (hk - 12), g_qa, (float*)(ws + A_SSQ), 8, 4 * (hk - 12) + wc);
                else if (hk == 14) lat_half(acc, bj, u, rowl, wc, fq, (bf16_t*)(ws + A_X1 + 16 * MiB), 0, g_kva, (float*)(ws + A_SSQ + 1 * MiB), 4, wc);
                else {
                    bf16_t* kvlat = (bf16_t*)(ws + A_X1 + 16 * MiB); bf16_t* Kb = (bf16_t*)(ws + A_Q2 + 48 * MiB); const f32x2* rope = (const f32x2*)(ws + WS_ROPE);
                    unsigned z0 = 0u; asm volatile("" : "+v"(z0));
#pragma unroll
                    for (int ai = 0; ai < 2; ++ai)
#pragma unroll
                        for (int m = 0; m < 4; ++m) { const size_t r = (size_t)(u.orow + rowl + ai * 128 + m * 16);
                            *(u32x4*)(kvlat + r * 256 + 128 + 32 * wc + 8 * fq) = (u32x4){z0, z0, z0, z0};
                            if (wc == 0) { const f32x4 x1 = acc[ai][bj][m][0], x2 = acc[ai][bj][m][1]; const f32x2* rt = rope + r * 32 + 8 * fq;
                                const f32x2 c0 = rt[0], c1 = rt[2], c2 = rt[4], c3 = rt[6];
                                const u32x2 w1 = pack4(x1[0] * c0.x - x2[0] * c0.y, x1[1] * c1.x - x2[1] * c1.y, x1[2] * c2.x - x2[2] * c2.y, x1[3] * c3.x - x2[3] * c3.y);
                                const u32x2 w2 = pack4(x2[0] * c0.x + x1[0] * c0.y, x2[1] * c1.x + x1[1] * c1.y, x2[2] * c2.x + x1[2] * c2.y, x2[3] * c3.x + x1[3] * c3.y);
#pragma unroll
                                for (int hh = 0; hh < 8; ++hh) { bf16_t* kp = Kb + r * 768 + 96 * hh + 64 + 4 * fq; *(u32x2*)kp = w1; *(u32x2*)(kp + 16) = w2; } } }
                }
            } else {
                if (hk < 4) rope_half(acc, bj, u, rowl, wr, wc, fr, fq, (bf16_t*)(ws + A_Q1), 512, 2 * hk, QS_64, false);
                else if (hk == 4) rope_half(acc, bj, u, rowl, wr, wc, fr, fq, (bf16_t*)(ws + A_K1), 128, 0, 1.0f, false);
                else if (hk == 5) plain_half(acc, bj, u, rowl, wc, fq, (bf16_t*)(ws + A_K1 + 8 * MiB), 128);
                else if (hk < 10) rope_half(acc, bj, u, rowl, wr, wc, fr, fq, (bf16_t*)(ws + A_V1), 512, 2 * (hk - 6), QS_64, false);
                else if (hk < 14) rope_half(acc, bj, u, rowl, wr, wc, fr, fq, (bf16_t*)(ws + A_X1), 512, 2 * (hk - 10), 1.0f, false);
                else plain_half(acc, bj, u, rowl, wc, fq, (bf16_t*)(ws + A_X2) + 128 * (hk - 14), 512);
            }
        }
    }
};
struct EpiMlaQ {
    static constexpr bool PERM = true;
    unsigned char* ws;
    __device__ __forceinline__ void operator()(const f32x4 (&acc)[2][2][4][2], const pg8::Unit& u, int wr, int wc, int fr, int fq) const {
        const int rowl = wr * 64 + fr; bf16_t* Qb = (bf16_t*)(ws + A_Q2); const float* ssq = (const float*)(ws + A_SSQ); const f32x2* rope = (const f32x2*)(ws + WS_ROPE);
#pragma unroll
        for (int ai = 0; ai < 2; ++ai)
#pragma unroll
            for (int m = 0; m < 4; ++m) { const size_t r = (size_t)(u.orow + rowl + ai * 128 + m * 16);
                const f32x4 q0 = *(const f32x4*)(ssq + r * 8), q1 = *(const f32x4*)(ssq + r * 8 + 4);
                const float rr = QS_96 / sqrtf(((q0[0] + q0[1]) + (q0[2] + q0[3]) + (q1[0] + q1[1]) + (q1[2] + q1[3])) * (1.0f / 256.0f) + 1e-6f);
#pragma unroll
                for (int bj = 0; bj < 2; ++bj) { const int gidx = (u.ocol >> 5) + 4 * bj + wc, head = gidx / 3, part = gidx - 3 * head;
                    const f32x4 x1 = acc[ai][bj][m][0] * rr, x2 = acc[ai][bj][m][1] * rr;
                    if (part < 2) *(u32x4*)(Qb + r * 768 + 96 * head + 32 * part + 8 * fq) = pack8(x1, x2);
                    else { const f32x2* rt = rope + r * 32 + 8 * fq; const f32x2 c0 = rt[0], c1 = rt[2], c2 = rt[4], c3 = rt[6]; bf16_t* qp = Qb + r * 768 + 96 * head + 64 + 4 * fq;
                        *(u32x2*)qp = pack4(x1[0] * c0.x - x2[0] * c0.y, x1[1] * c1.x - x2[1] * c1.y, x1[2] * c2.x - x2[2] * c2.y, x1[3] * c3.x - x2[3] * c3.y);
                        *(u32x2*)(qp + 16) = pack4(x2[0] * c0.x + x1[0] * c0.y, x2[1] * c1.x + x1[1] * c1.y, x2[2] * c2.x + x1[2] * c2.y, x2[3] * c3.x + x1[3] * c3.y); } } }
    }
};
struct EpiMlaKV {
    static constexpr bool PERM = true;
    unsigned char* ws;
    __device__ __forceinline__ void operator()(const f32x4 (&acc)[2][2][4][2], const pg8::Unit& u, int wr, int wc, int fr, int fq) const {
        const int rowl = wr * 64 + fr; bf16_t* Kb = (bf16_t*)(ws + A_Q2 + 48 * MiB); bf16_t* Vb = (bf16_t*)(ws + A_Q2 + 96 * MiB); const float* ssq = (const float*)(ws + A_SSQ + 1 * MiB);
#pragma unroll
        for (int ai = 0; ai < 2; ++ai)
#pragma unroll
            for (int m = 0; m < 4; ++m) { const size_t r = (size_t)(u.orow + rowl + ai * 128 + m * 16);
                const f32x4 q0 = *(const f32x4*)(ssq + r * 4);
                const float rr = 1.0f / sqrtf(((q0[0] + q0[1]) + (q0[2] + q0[3])) * (1.0f / 128.0f) + 1e-6f);
#pragma unroll
                for (int bj = 0; bj < 2; ++bj) { const int gidx = (u.ocol >> 5) + 4 * bj + wc, head = gidx >> 2, part = gidx & 3;
                    const u32x4 w = pack8(acc[ai][bj][m][0] * rr, acc[ai][bj][m][1] * rr);
                    if (part < 2) *(u32x4*)(Kb + r * 768 + 96 * head + 32 * part + 8 * fq) = w; else *(u32x4*)(Vb + r * 512 + 64 * head + 32 * (part - 2) + 8 * fq) = w; } }
    }
};

constexpr float YS_SCALE = 64.0f;
__device__ __forceinline__ unsigned pk_fp8x4(float a, float b, float c, float d) {
    a = __builtin_amdgcn_fmed3f(a, -440.f, 440.f); b = __builtin_amdgcn_fmed3f(b, -440.f, 440.f); c = __builtin_amdgcn_fmed3f(c, -440.f, 440.f); d = __builtin_amdgcn_fmed3f(d, -440.f, 440.f);
    int w = __builtin_amdgcn_cvt_pk_fp8_f32(a, b, 0, false); w = __builtin_amdgcn_cvt_pk_fp8_f32(c, d, w, true); return (unsigned)w; }
template <bool DUMMY = false> struct EpiDownAllT {
    static constexpr bool PERM = true;
    unsigned char* ws;
    __device__ __forceinline__ void operator()(const f32x4 (&acc)[2][2][4][2], const pg8::Unit& u, int wr, int wc, int fr, int fq) const {
        const int rowl = wr * 64 + fr, c0 = u.ocol + 64 * wc + 16 * fq;
        if (u.e == 64) { bf16_t* Ysh = (bf16_t*)(ws + (DUMMY ? A_HB + 2 * MiB : WS_YSH));
#pragma unroll
            for (int ai = 0; ai < 2; ++ai)
#pragma unroll
                for (int m = 0; m < 4; ++m) { bf16_t* rp = Ysh + (size_t)(u.lt * 256 + rowl + ai * 128 + m * 16) * DM + c0;
                    *(u32x4*)rp = pack8(acc[ai][0][m][0], acc[ai][0][m][1]); *(u32x4*)(rp + 8) = pack8(acc[ai][1][m][0], acc[ai][1][m][1]); }
        } else { unsigned char* Y8 = ws + WS_YS;
#pragma unroll
            for (int ai = 0; ai < 2; ++ai)
#pragma unroll
                for (int m = 0; m < 4; ++m) { unsigned char* rp = Y8 + (size_t)(u.orow + rowl + ai * 128 + m * 16) * DM + c0;
                    const f32x4 v0 = acc[ai][0][m][0] * YS_SCALE, v1 = acc[ai][0][m][1] * YS_SCALE, v2 = acc[ai][1][m][0] * YS_SCALE, v3 = acc[ai][1][m][1] * YS_SCALE;
                    u32x4 w; w.x = pk_fp8x4(v0[0], v0[1], v0[2], v0[3]); w.y = pk_fp8x4(v1[0], v1[1], v1[2], v1[3]); w.z = pk_fp8x4(v2[0], v2[1], v2[2], v2[3]); w.w = pk_fp8x4(v3[0], v3[1], v3[2], v3[3]);
                    *(u32x4*)rp = w; }
        }
    }
};
typedef EpiDownAllT<false> EpiDownAll;
struct Ctx {
    LAS unsigned char* lds; unsigned char* ws; int tid, lane, wave, G, bid, gw, NGW;
};
#define WSP(T, off) ((T*)(C.ws + (off)))

__device__ __forceinline__ void phase_convert(const Ctx& C, const Args& a, int L) {
    LAS float* scr = (LAS float*)(C.lds + C.wave * 16384);
    {
        constexpr int IT_G = (1024 / 64) * (256 / 32);
        constexpr int IT_D = (256 / 64) * (1024 / 32);
        const int total = 65 * (2 * IT_G + IT_D);
        bf16_t* Wgu = WSP(bf16_t, WS_WGU); bf16_t* Wd = WSP(bf16_t, WS_WD);
        for (int it = C.gw; it < total; it += C.NGW) {
            const int e = it / (2 * IT_G + IT_D); int r = it % (2 * IT_G + IT_D);
            if (r < 2 * IT_G) {
                const int up = r >= IT_G; if (up) r -= IT_G;
                const float* W = e < 64 ? (up ? a.moe_w_up : a.moe_w_gate) + ((size_t)L * 64 + e) * 1024 * 256 : (up ? a.sh_w_up : a.sh_w_gate) + (size_t)L * 1024 * 256;
                const int kb = r / 8, nb = r % 8, n0 = nb * 32;
                transpose_item(W, 256, kb * 64, n0, Wgu + (size_t)e * 512 * 1024, 1024, (n0 >> 7) * 256 + up * 128 + (n0 & 127), scr, C.lane);
            } else {
                r -= 2 * IT_G;
                const float* W = e < 64 ? a.moe_w_down + ((size_t)L * 64 + e) * 256 * 1024 : a.sh_w_down + (size_t)L * 256 * 1024;
                const int kb = r / 32, nb = r % 32, n0 = nb * 32;
                transpose_item(W, 1024, kb * 64, n0, Wd + (size_t)e * 1024 * 256, 256, n0, scr, C.lane, 4);
            }
        }
    }
}
__device__ __forceinline__ void phase_init(const Ctx& C, const Args& a) {
    LAS float* scr = (LAS float*)(C.lds + C.wave * 16384);
    for (int l = 0; l < DEPTH; ++l) {
        const int i = l >> 1; const bool even = !(l & 1);
        bf16_t* Win = WSP(bf16_t, WS_SMALLW + l * SW_LAYER); bf16_t* Wout = WSP(bf16_t, WS_SMALLW + l * SW_LAYER + SW_WOUT);
        const int nin = even ? EV_IN : OD_IN;
        const float* win = even ? a.ev_w_in + (size_t)i * 1024 * EV_IN : a.od_w_in + (size_t)i * 1024 * OD_IN;
        const float* wout = even ? a.ev_w_out + (size_t)i * 1024 * 1024 : a.od_w_out + (size_t)i * 1024 * 1024;
        const int it_in = 16 * (nin / 32), it_out = 16 * 32;
        for (int it = C.gw; it < it_in + it_out; it += C.NGW) {
            if (it < it_in) { const int kb = it / (nin / 32), nb = it % (nin / 32); transpose_item(win, nin, kb * 64, nb * 32, Win, 1024, nb * 32, scr, C.lane, even ? 1 : 2); }
            else { const int r = it - it_in, kb = r / 32, nb = r % 32; transpose_item(wout, 1024, kb * 64, nb * 32, Wout, 1024, nb * 32, scr, C.lane); }
        }
        if (even) {
            for (int idx = C.bid * NTHREADS + C.tid; idx < (2048 - EV_IN) * 1024 / 8; idx += C.G * NTHREADS) *(u32x4*)(Win + (size_t)EV_IN * 1024 + (size_t)idx * 8) = (u32x4){0u, 0u, 0u, 0u};
            bf16_t* Wqb = WSP(bf16_t, WS_SMALLW + l * SW_LAYER + SW_WQB); bf16_t* Wkvb = WSP(bf16_t, WS_SMALLW + l * SW_LAYER + SW_WKVB);
            const float* wqb = a.mla_w_qb + (size_t)i * 256 * 768; const float* wkvb = a.mla_w_kvb + (size_t)i * 128 * 1024;
            const int it_q = 4 * 24, it_kv = 2 * 32;
            for (int it = C.gw; it < it_q + it_kv; it += C.NGW) {
                if (it < it_q) { const int kb = it / 24, nb = it % 24; transpose_item(wqb, 768, kb * 64, nb * 32, Wqb, 256, nb * 32, scr, C.lane, 3); }
                else { const int r = it - it_q, kb = r / 32, nb = r % 32; transpose_item(wkvb, 1024, kb * 64, nb * 32, Wkvb, 256, nb * 32, scr, C.lane); }
            }
            for (int idx = C.bid * NTHREADS + C.tid; idx < 1024 * 16; idx += C.G * NTHREADS) { const int row = idx >> 4, ch = idx & 15; *(u32x4*)(Wkvb + (size_t)row * 256 + 128 + ch * 8) = (u32x4){0u, 0u, 0u, 0u}; }
        }
        bf16_t* Wr = WSP(bf16_t, WS_WR + (size_t)l * MiB); const float* wr = a.moe_w_router + (size_t)l * 1024 * 64;
        for (int idx = C.bid * NTHREADS + C.tid; idx < 2 * 256 * 1024; idx += C.G * NTHREADS) {
            const int kh = idx >> 18, n = (idx >> 10) & 255, k = idx & 1023; unsigned v = 0;
            if (n < 128) { const float w = wr[(size_t)k * 64 + (n & 63)]; const unsigned wh = f2bf(w);
                if (n < 64) v = wh; else if (kh == 0) v = f2bf(w - bf2f(wh)); }
            Wr[idx] = (bf16_t)v;
        }
    }
    { f32x2* rope = WSP(f32x2, WS_ROPE);
      for (int idx = C.bid * NTHREADS + C.tid; idx < NTOK * 32; idx += C.G * NTHREADS) { const int tok = idx >> 5, j = idx & 31;
          const float inv = (float)exp2(-(double)j * (13.287712379549449 / 32.0));
          const float ang = (float)a.pos[tok] * inv; float cs, sn; sincos_acc(ang, cs, sn); rope[idx] = (f32x2){cs, sn}; } }
    { bf16_t* xb = WSP(bf16_t, WS_HS);
      for (size_t idx = (size_t)C.bid * NTHREADS + C.tid; idx < (size_t)NTOK * DM / 8; idx += (size_t)C.G * NTHREADS) { const f32x4 v0 = *(const f32x4*)(a.x + idx * 8), v1 = *(const f32x4*)(a.x + idx * 8 + 4);
          u32x4 o; o.x = pk2(v0[0], v0[1]); o.y = pk2(v0[2], v0[3]); o.z = pk2(v1[0], v1[1]); o.w = pk2(v1[2], v1[3]); *(u32x4*)(xb + idx * 8) = o; } }
}

template <int HW>
__device__ __forceinline__ void rope_heads(const bf16_t* src, bf16_t* dst, int nh, const f32x2* rope_tok, float scale, int lane) {
    const int npairs = nh * HW;
    for (int p = lane; p < npairs; p += 64) { const int hh = p / HW, i = p % HW;
        const float x1 = bf2f(src[hh * 2 * HW + i]), x2 = bf2f(src[hh * 2 * HW + i + HW]); const f32x2 cs = rope_tok[i * (32 / HW)];
        dst[hh * 2 * HW + i] = (bf16_t)f2bf((x1 * cs.x - x2 * cs.y) * scale); dst[hh * 2 * HW + i + HW] = (bf16_t)f2bf((x2 * cs.x + x1 * cs.y) * scale); }
}
__device__ __forceinline__ void copy_cols(const bf16_t* src, bf16_t* dst, int n, int lane) { for (int c = lane; c < n / 8; c += 64) *(u32x4*)(dst + c * 8) = *(const u32x4*)(src + c * 8); }

__device__ __forceinline__ void phase_prep_even(const Ctx& C, const Args& a, int i) {
    const bf16_t* hb = WSP(bf16_t, A_HB); const f32x2* rope = WSP(f32x2, WS_ROPE);
    bf16_t *Qa = WSP(bf16_t, A_Q1), *Ka = WSP(bf16_t, A_K1), *Va = WSP(bf16_t, A_V1), *qlat = WSP(bf16_t, A_X1), *kvlat = WSP(bf16_t, A_X1 + 16 * MiB), *kpe = WSP(bf16_t, A_X2);
    const float* gqa = a.mla_g_qa + i * 256; const float* gkva = a.mla_g_kva + i * 128;
    const float sc = 0.125f * LOG2E;
    for (int tok = C.gw; tok < NTOK; tok += C.NGW) {
        const bf16_t* h = hb + (size_t)tok * HB_LD; const f32x2* rt = rope + (size_t)tok * 32;
        rope_heads<32>(h, Qa + (size_t)tok * 512, 8, rt, sc, C.lane);
        rope_heads<32>(h + 512, Ka + (size_t)tok * 512, 8, rt, 1.0f, C.lane);
        copy_cols(h + 1024, Va + (size_t)tok * 512, 512, C.lane);
        { float v[4]; float ss = 0.f;
#pragma unroll
          for (int j = 0; j < 4; ++j) { v[j] = bf2f(h[1536 + C.lane + 64 * j]); ss += v[j] * v[j]; }
          const float r = 1.0f / sqrtf(wave_sum(ss) * (1.0f / 256.0f) + 1e-6f);
#pragma unroll
          for (int j = 0; j < 4; ++j) qlat[(size_t)tok * 256 + C.lane + 64 * j] = (bf16_t)f2bf(v[j] * r * gqa[C.lane + 64 * j]); }
        { float v[2]; float ss = 0.f;
#pragma unroll
          for (int j = 0; j < 2; ++j) { v[j] = bf2f(h[1792 + C.lane + 64 * j]); ss += v[j] * v[j]; }
          const float r = 1.0f / sqrtf(wave_sum(ss) * (1.0f / 128.0f) + 1e-6f);
#pragma unroll
          for (int j = 0; j < 2; ++j) { kvlat[(size_t)tok * 256 + C.lane + 64 * j] = (bf16_t)f2bf(v[j] * r * gkva[C.lane + 64 * j]); kvlat[(size_t)tok * 256 + 128 + C.lane + 64 * j] = 0; } }
        rope_heads<16>(h + 1920, kpe + (size_t)tok * 32, 1, rt, 1.0f, C.lane);
    }
}
__device__ __forceinline__ void phase_kmean(const Ctx& C) {
    const bf16_t* Ka = WSP(bf16_t, A_K1); float* km = WSP(float, WS_KMEAN);
    for (int idx = C.bid * NTHREADS + C.tid; idx < NBATCH * 16 * 512; idx += C.G * NTHREADS) {
        const int c = idx & 511, bj = idx >> 9, b = bj >> 4, j = bj & 15; const bf16_t* p = Ka + ((size_t)b * SEQ + j * 256) * 512 + c;
        float s = 0.f;
        for (int r = 0; r < 256; ++r) s += bf2f(p[(size_t)r * 512]);
        km[(((size_t)b * 8 + (c >> 6)) * 16 + j) * 64 + (c & 63)] = s * (1.0f / 256.0f);
    }
}
__device__ __forceinline__ void phase_prep_mla(const Ctx& C) {
    const bf16_t *qf = WSP(bf16_t, A_QF), *kvf = WSP(bf16_t, A_KVF), *kpe = WSP(bf16_t, A_X2); const f32x2* rope = WSP(f32x2, WS_ROPE);
    bf16_t *Qb = WSP(bf16_t, A_Q2), *Kb = WSP(bf16_t, A_Q2 + 48 * MiB), *Vb = WSP(bf16_t, A_Q2 + 96 * MiB);
    const float sc = 0.10206207261596577f * LOG2E;
    for (int tok = C.gw; tok < NTOK; tok += C.NGW) {
        const bf16_t* q = qf + (size_t)tok * 768; const bf16_t* kv = kvf + (size_t)tok * 1024; const f32x2* rt = rope + (size_t)tok * 32;
        bf16_t* qo = Qb + (size_t)tok * 768; bf16_t* ko = Kb + (size_t)tok * 768; bf16_t* vo = Vb + (size_t)tok * 512;
        for (int p = C.lane; p < 512; p += 64) { const int hh = p >> 6, d = p & 63; qo[hh * 96 + d] = (bf16_t)f2bf(bf2f(q[hh * 96 + d]) * sc); ko[hh * 96 + d] = kv[hh * 128 + d]; vo[hh * 64 + d] = kv[hh * 128 + 64 + d]; }
        for (int p = C.lane; p < 128; p += 64) { const int hh = p >> 4, i2 = p & 15;
            const float x1 = bf2f(q[hh * 96 + 64 + i2]), x2 = bf2f(q[hh * 96 + 80 + i2]); const f32x2 cs = rt[2 * i2];
            qo[hh * 96 + 64 + i2] = (bf16_t)f2bf((x1 * cs.x - x2 * cs.y) * sc); qo[hh * 96 + 80 + i2] = (bf16_t)f2bf((x2 * cs.x + x1 * cs.y) * sc); }
        for (int p = C.lane; p < 256; p += 64) { const int hh = p >> 5, d = p & 31; ko[hh * 96 + 64 + d] = kpe[(size_t)tok * 32 + d]; }
    }
}
__device__ __forceinline__ void phase_prep_odd(const Ctx& C) {
    const bf16_t* hb = WSP(bf16_t, A_HB); const f32x2* rope = WSP(f32x2, WS_ROPE);
    bf16_t *Qc = WSP(bf16_t, A_Q1), *Kc = WSP(bf16_t, A_K1), *Vc = WSP(bf16_t, A_K1 + 8 * MiB), *Qd = WSP(bf16_t, A_V1), *Kd = WSP(bf16_t, A_X1), *Vd = WSP(bf16_t, A_X2);
    const float sc = 0.125f * LOG2E;
    for (int tok = C.gw; tok < NTOK; tok += C.NGW) {
        const bf16_t* h = hb + (size_t)tok * HB_LD; const f32x2* rt = rope + (size_t)tok * 32;
        rope_heads<32>(h, Qc + (size_t)tok * 512, 8, rt, sc, C.lane);
        rope_heads<32>(h + 512, Kc + (size_t)tok * 128, 2, rt, 1.0f, C.lane);
        copy_cols(h + 640, Vc + (size_t)tok * 128, 128, C.lane);
        rope_heads<32>(h + 768, Qd + (size_t)tok * 512, 8, rt, sc, C.lane);
        rope_heads<32>(h + 1280, Kd + (size_t)tok * 512, 8, rt, 1.0f, C.lane);
        copy_cols(h + 1792, Vd + (size_t)tok * 512, 512, C.lane);
    }
}
template <int ABL = 0> __device__ __forceinline__ void phase_attn_even(const Ctx& C) {
    const int vc = (C.G & 7) ? C.bid : (C.bid & 7) * (C.G >> 3) + (C.bid >> 3);
    const bf16_t *Qa = WSP(bf16_t, A_Q1), *Ka = WSP(bf16_t, A_K1), *Va = WSP(bf16_t, A_V1), *Qb = WSP(bf16_t, A_Q2), *Kb = WSP(bf16_t, A_Q2 + 48 * MiB), *Vb = WSP(bf16_t, A_Q2 + 96 * MiB);
    bf16_t* ob = ABL ? WSP(bf16_t, A_HB + 8 * MiB) : WSP(bf16_t, A_OB); const float* km = WSP(float, WS_KMEAN);
    for (int P = vc; P < 512; P += C.G) { const int bh = P >> 3, pi = P & 7, b = bh >> 3, h = bh & 7;
#pragma unroll 1
        for (int s = 0; s < 2; ++s) { const int qb = s ? pi : 15 - pi;
            att::Tens T{Qb + 96 * h, Kb + 96 * h, Vb + 64 * h, ob + 512 + 64 * h, 768, 768, 512, 1024};
            att::unit<96, 64, att::M_CAUSAL, ABL>(T, b, qb, nullptr, 0.f, 0.f, nullptr, 0.f, C.lds, C.tid); } }
    int tid2 = C.tid; asm volatile("" : "+v"(tid2));
    for (int P = vc; P < 512; P += C.G) { const int bh = P >> 3, pi = P & 7, b = bh >> 3, h = bh & 7;
#pragma unroll 1
        for (int s = 0; s < 2; ++s) { const int qb = s ? pi : 15 - pi;
            att::Tens T{Qa + 64 * h, Ka + 64 * h, Va + 64 * h, ob + 64 * h, 512, 512, 512, 1024};
            att::unit<64, 64, att::M_MOBA, ABL>(T, b, qb, km + ((size_t)b * 8 + h) * 2048, 0.f, 0.f, nullptr, 0.f, C.lds, tid2); } }
}
template <int ABL = 0> __device__ __forceinline__ void phase_attn_odd(const Ctx& C, const Args& a, int i, int l) {
    const int vc = (C.G & 7) ? C.bid : (C.bid & 7) * (C.G >> 3) + (C.bid >> 3);
    const bf16_t *Qc = WSP(bf16_t, A_Q1), *Kc = WSP(bf16_t, A_K1), *Vc = WSP(bf16_t, A_K1 + 8 * MiB), *Qd = WSP(bf16_t, A_V1), *Kd = WSP(bf16_t, A_X1), *Vd = WSP(bf16_t, A_X2);
    bf16_t* ob = ABL ? WSP(bf16_t, A_HB + 8 * MiB) : WSP(bf16_t, A_OB);
    const float* lp = a.diff_lambda + i * 256;
    const float d01 = wave_sum(lp[C.lane] * lp[64 + C.lane]), d23 = wave_sum(lp[128 + C.lane] * lp[192 + C.lane]);
    const float lam_init = 0.8f - 0.6f * expf(-0.3f * (float)l);
    const float lam = expf(d01) - expf(d23) + lam_init;
    for (int P = vc; P < 512; P += C.G) { const int bh = P >> 4, pi = P & 15, b = bh >> 2, h = bh & 3;
#pragma unroll 1
        for (int s = 0; s < 2; ++s) { const int qb = s ? pi : 31 - pi;
            att::Tens T{Qd + 128 * h, Kd + 128 * h, Vd + 128 * h, ob + 512 + 128 * h, 512, 512, 512, 1024};
            att::unit<64, 128, att::M_DIFF, ABL>(T, b, qb, nullptr, 0.f, lam, a.diff_g_subln + i * 128, 1.0f - lam_init, C.lds, C.tid); } }
    int tid2 = C.tid; asm volatile("" : "+v"(tid2));
    for (int P = vc; P < 512; P += C.G) { const int bh = P >> 3, pi = P & 7, b = bh >> 3, h = bh & 7;
        const float sink = a.swa_sinks[i * 8 + h] * LOG2E;
#pragma unroll 1
        for (int s = 0; s < 2; ++s) { const int qb = s ? pi : 15 - pi;
            att::Tens T{Qc + 64 * h, Kc + 64 * (h >> 2), Vc + 64 * (h >> 2), ob + 64 * h, 512, 128, 128, 1024};
            att::unit<64, 64, att::M_SWA, ABL>(T, b, qb, nullptr, sink, 0.f, nullptr, 0.f, C.lds, tid2); } }
}
__device__ __forceinline__ void ln_row(f32x4 (&v)[4], const float* g, const float* bb, int c0, int cs) {
    float s = 0.f;
#pragma unroll
    for (int j = 0; j < 4; ++j) s += (v[j][0] + v[j][1]) + (v[j][2] + v[j][3]);
    const float mean = wave_sum(s) * (1.0f / DM); float s2 = 0.f;
#pragma unroll
    for (int j = 0; j < 4; ++j) { v[j] = v[j] - mean; s2 += (v[j][0] * v[j][0] + v[j][1] * v[j][1]) + (v[j][2] * v[j][2] + v[j][3] * v[j][3]); }
    const float rstd = 1.0f / sqrtf(wave_sum(s2) * (1.0f / DM) + 1e-5f);
#pragma unroll
    for (int j = 0; j < 4; ++j) { const f32x4 gg = *(const f32x4*)(g + c0 + cs * j), b4 = *(const f32x4*)(bb + c0 + cs * j); v[j] = v[j] * rstd * gg + b4; }
}
template <bool DUMMY = false> __device__ __forceinline__ void phase_ln1(const Ctx& C, const Args& a, int l) {
    const float* xf = WSP(float, A_Y); bf16_t* xs = DUMMY ? WSP(bf16_t, WS_YS + 300 * MiB) : WSP(bf16_t, WS_XF);
    const float* g = a.ln_g + (size_t)(l * 2) * DM; const float* bb = a.ln_b + (size_t)(l * 2) * DM;
    for (int tok = C.gw; tok < NTOK; tok += C.NGW) {
        f32x4 v[4]; const float* xr = xf + (size_t)tok * DM + 4 * C.lane;
#pragma unroll
        for (int j = 0; j < 4; ++j) v[j] = *(const f32x4*)(xr + 256 * j);
        ln_row(v, g, bb, 4 * C.lane, 256);
        bf16_t* xo = xs + (size_t)tok * 2048 + 4 * C.lane;
#pragma unroll
        for (int j = 0; j < 4; ++j) {
            const unsigned h0 = f2bf(v[j][0]), h1 = f2bf(v[j][1]), h2 = f2bf(v[j][2]), h3 = f2bf(v[j][3]);
            u32x2 hi2 = {h0 | (h1 << 16), h2 | (h3 << 16)}; *(u32x2*)(xo + 256 * j) = hi2;
            u32x2 lo2 = {pk2(v[j][0] - bf2f(h0), v[j][1] - bf2f(h1)), pk2(v[j][2] - bf2f(h2), v[j][3] - bf2f(h3))}; *(u32x2*)(xo + 1024 + 256 * j) = lo2; }
    }
}
__device__ __forceinline__ void phase_route(const Ctx& C, const Args& a, int l, const int tok0, const int tpb) {
    const float* lg = WSP(float, A_LOG);
    int* rowtok = WSP(int, WS_ROWTOK); float* tokw = WSP(float, WS_WSLOT); int* toke = WSP(int, WS_TOKE); int* tokp = WSP(int, WS_TOKP);
    unsigned* cnt = WSP(unsigned, WS_CTL) + CW_CNT + 64 * l;
    LAS int* cntw = (LAS int*)C.lds; LAS int* base = cntw + 64; LAS int* ent_e = base + 64; LAS int* ent_r = ent_e + 2048; LAS float* ent_w = (LAS float*)(ent_r + 2048);
    __syncthreads();
    if (C.tid < 64) cntw[C.tid] = 0;
    __syncthreads();
    const float bias = a.moe_bias[l * 64 + C.lane];
    const int g = C.lane >> 3;
    for (int tl = C.wave; tl < tpb; tl += NWAVES) {
        const int tok = tok0 + tl;
        const float* lr = lg + (size_t)tok * 512 + C.lane; const float z = (lr[0] + lr[256]) + (lr[64] + lr[320]);
        const float s = 1.0f / (1.0f + expf(-z));
        const float c = s + bias;
        float m1 = c; m1 = fmaxf(m1, shx<1>(m1)); m1 = fmaxf(m1, shx<2>(m1)); m1 = fmaxf(m1, shx<4>(m1));
        const unsigned long long eq = __ballot(c == m1);
        const unsigned geq = (unsigned)(eq >> (8 * g)) & 0xffu;
        const bool is_first = (C.lane & 7) == (int)__builtin_ctz(geq);
        float m2 = is_first ? -INFINITY : c; m2 = fmaxf(m2, shx<1>(m2)); m2 = fmaxf(m2, shx<2>(m2)); m2 = fmaxf(m2, shx<4>(m2));
        const float gs = m1 + m2;
        int grank = 0;
#pragma unroll
        for (int j = 0; j < 8; ++j) { const float gj = __builtin_bit_cast(float, __builtin_amdgcn_readlane(__builtin_bit_cast(int, gs), 8 * j)); grank += (gj > gs || (gj == gs && j < g)) ? 1 : 0; }
        const float v = grank < 4 ? c : -INFINITY;
        int rank = 0;
        unsigned long long gm = __ballot(grank < 4 && (C.lane & 7) == 0);
#pragma unroll 1
        while (gm) { const int gl = __builtin_ctzll(gm); gm &= gm - 1;
#pragma unroll
            for (int j = 0; j < 8; ++j) { const float vj = __builtin_bit_cast(float, __builtin_amdgcn_readlane(__builtin_bit_cast(int, v), gl + j)); rank += (vj > v || (vj == v && gl + j < C.lane)) ? 1 : 0; } }
        const bool sel = rank < 8;
        const float ssum = wave_sum(sel ? s : 0.f);
        if (sel) { const int r = __hip_atomic_fetch_add(&cntw[C.lane], 1, __ATOMIC_RELAXED, __HIP_MEMORY_SCOPE_WORKGROUP);
            ent_e[tl * 8 + rank] = C.lane; ent_r[tl * 8 + rank] = r; ent_w[tl * 8 + rank] = s / ssum * 2.5f; }
    }
    __syncthreads();
    if (C.tid < 64) base[C.tid] = (int)atomicAdd(&cnt[C.tid], (unsigned)cntw[C.tid]);
    __syncthreads();
    for (int idx = C.tid; idx < tpb * 8; idx += NTHREADS) { const int e = ent_e[idx], pos = base[e] + ent_r[idx], tok = tok0 + (idx >> 3);
        if (pos < CAP) rowtok[(size_t)e * CAP + pos] = tok;
        toke[(size_t)tok0 * 8 + idx] = e; tokp[(size_t)tok0 * 8 + idx] = pos; tokw[(size_t)tok0 * 8 + idx] = ent_w[idx]; }
    __syncthreads();
}
struct RouterOrder { static constexpr bool GATHER = false; int G, c;
    __device__ __forceinline__ bool next(int i, pg8::Unit& u) const { const int L = i * G + c; if (L >= 256) return false; u.pm = L >> 1; u.pn = L & 1; u.orow = u.pm * 256; u.ocol = 256 * u.pn; u.e = 0; u.lt = u.pm; u.aoffb = 2048 * u.pn; return true; }
    __device__ __forceinline__ unsigned arow(const pg8::Unit& u, int r) const { return (unsigned)(u.pm * 256 + r); } };
__device__ __forceinline__ void moe_tables(const Ctx& C, int l) {
    const unsigned* cnt = WSP(unsigned, WS_CTL) + CW_CNT + 64 * l;
    LAS int* lcnt = (LAS int*)(C.lds + LX_CNT); LAS int* tst = (LAS int*)(C.lds + LX_TST); LAS unsigned char* texp = (LAS unsigned char*)(C.lds + LX_TEXP);
    __syncthreads();
    if (C.tid < 64) { int c = (int)__hip_atomic_load(cnt + C.tid, __ATOMIC_RELAXED, __HIP_MEMORY_SCOPE_AGENT); if (c > CAP) c = CAP; lcnt[C.tid] = c; }
    __syncthreads();
    if (C.tid == 0) { int acc = 0; for (int e = 0; e < 64; ++e) { tst[e] = acc; acc += (lcnt[e] + 255) >> 8; } tst[64] = acc; }
    __syncthreads();
    if (C.tid < 64) { const int t0 = tst[C.tid], t1 = tst[C.tid + 1]; for (int t = t0; t < t1; ++t) texp[t] = (unsigned char)C.tid; }
    __syncthreads();
}
template <bool GATHER_> struct MoeOrder {
    static constexpr bool GATHER = GATHER_;
    const LAS int* lcnt; const LAS int* tst; const LAS unsigned char* texp; const int* rowtok;
    int TR, nsh, NC, G, c; int sh_orow0;
    __device__ __forceinline__ bool next(int i, pg8::Unit& u) const {
        const int vc = (G & 7) ? c : (c & 7) * (G >> 3) + (c >> 3);
        const long L = (long)i * G + vc; if (L >= (long)(TR + nsh) * NC) return false;
        const int r = (int)(L / NC), cn = (int)(L % NC);
        if (r < TR) { const int e = __builtin_amdgcn_readfirstlane((int)texp[r]); u.e = e; u.lt = r - __builtin_amdgcn_readfirstlane(tst[e]); u.pm = r; u.orow = r * 256; }
        else { u.e = 64; u.lt = r - TR; u.pm = TR_MAX + (r - TR); u.orow = sh_orow0 + u.lt * 256; }
        u.pn = u.e * NC + cn; u.ocol = cn * (NC == 2 ? 128 : 256); u.aoffb = 0;
        return true;
    }
    __device__ __forceinline__ unsigned arow(const pg8::Unit& u, int r) const {
        if (!GATHER) return (unsigned)(u.pm * 256 + r);
        const int loc = u.lt * 256 + r;
        if (u.e == 64) return (unsigned)loc;
        return loc < __builtin_amdgcn_readfirstlane(lcnt[u.e]) ? (unsigned)rowtok[(size_t)u.e * CAP + loc] : 0u;
    }
};
template <bool DUMMY = false> __device__ __forceinline__ void phase_combine_ln2(const Ctx& C, const Args& a, int l) {
    float* xf = WSP(float, WS_XF); const unsigned char* Ys = WSP(unsigned char, WS_YS);
    const int* toke = WSP(int, WS_TOKE); const int* tokp = WSP(int, WS_TOKP); const float* tokw = WSP(float, WS_WSLOT);
    const LAS int* tst = (const LAS int*)(C.lds + LX_TST);
    const float* g = a.ln_g + (size_t)(l * 2 + 1) * DM; const float* bb = a.ln_b + (size_t)(l * 2 + 1) * DM;
    for (int tok = C.gw; tok < NTOK; tok += C.NGW) {
        f32x4 v[4]; float* xr = xf + (size_t)tok * DM + 4 * C.lane;
        const bf16_t* shr = WSP(bf16_t, WS_YSH) + (size_t)tok * DM + 4 * C.lane;
#pragma unroll
        for (int j = 0; j < 4; ++j) { const u32x2 sw = *(const u32x2*)(shr + 256 * j); const bf16_t* xh = (const bf16_t*)(xf + (size_t)tok * DM) + 4 * C.lane + 256 * j;
            const u32x2 hw = *(const u32x2*)xh, lw = *(const u32x2*)(xh + 1024);
            const f32x4 x1 = {bf2f(hw.x & 0xffffu) + bf2f(lw.x & 0xffffu), bf2f(hw.x >> 16) + bf2f(lw.x >> 16), bf2f(hw.y & 0xffffu) + bf2f(lw.y & 0xffffu), bf2f(hw.y >> 16) + bf2f(lw.y >> 16)};
            v[j] = x1 * DN_ALPHA + (f32x4){bf2f(sw.x & 0xffffu), bf2f(sw.x >> 16), bf2f(sw.y & 0xffffu), bf2f(sw.y >> 16)}; }
#pragma unroll
        for (int k = 0; k < 8; ++k) { const int e = toke[(size_t)tok * 8 + k], pos = tokp[(size_t)tok * 8 + k]; const float gw = tokw[(size_t)tok * 8 + k] * (1.0f / YS_SCALE); const size_t slot = (size_t)tst[e] * 256 + pos;
            const unsigned char* yr = Ys + slot * DM + 4 * C.lane;
#pragma unroll
            for (int j = 0; j < 4; ++j) { const int w = *(const int*)(yr + 256 * j);
                v[j][0] += gw * __builtin_amdgcn_cvt_f32_fp8(w, 0); v[j][1] += gw * __builtin_amdgcn_cvt_f32_fp8(w, 1); v[j][2] += gw * __builtin_amdgcn_cvt_f32_fp8(w, 2); v[j][3] += gw * __builtin_amdgcn_cvt_f32_fp8(w, 3); } }
        ln_row(v, g, bb, 4 * C.lane, 256);
        bf16_t* xo = (DUMMY ? WSP(bf16_t, WS_YS + 300 * MiB) : (bf16_t*)xf) + (size_t)tok * 2048 + 4 * C.lane;
#pragma unroll
        for (int j = 0; j < 4; ++j) {
            const unsigned h0 = f2bf(v[j][0]), h1 = f2bf(v[j][1]), h2 = f2bf(v[j][2]), h3 = f2bf(v[j][3]);
            u32x2 hi2 = {h0 | (h1 << 16), h2 | (h3 << 16)}; *(u32x2*)(xo + 256 * j) = hi2;
            u32x2 lo2 = {pk2(v[j][0] - bf2f(h0), v[j][1] - bf2f(h1)), pk2(v[j][2] - bf2f(h2), v[j][3] - bf2f(h3))}; *(u32x2*)(xo + 1024 + 256 * j) = lo2;
            if (l == DEPTH - 1 && !DUMMY) *(f32x4*)(a.out + (size_t)tok * DM + 4 * C.lane + 256 * j) = v[j]; }
    }
}
constexpr int STEPS_PER_LAYER = 15, NSTEPS = 1 + STEPS_PER_LAYER * DEPTH;
#define CAS __attribute__((address_space(4)))
template <int STEP> __device__ __forceinline__ void step_fn(const CAS Args* ka, LAS unsigned char* lds_base, int l, int wv) {
#if defined(__HIP_DEVICE_COMPILE__)
    const Args a = *ka;
#else
    const Args a{};
#endif
    int lane_; asm volatile("v_mbcnt_lo_u32_b32 %0, -1, 0\n\tv_mbcnt_hi_u32_b32 %0, -1, %0" : "=v"(lane_)); asm volatile("" : "+s"(wv)); int tid_ = wv * 64 + lane_; asm volatile("" : "+v"(tid_));
    LAS unsigned char* lds_l = lds_base; asm volatile("" : "+s"(lds_l));
    Ctx C; C.lds = lds_l; C.ws = a.ws; C.tid = tid_; C.lane = C.tid & 63; C.wave = __builtin_amdgcn_readfirstlane(C.tid >> 6);
    int G_ = gridDim.x, bid_ = blockIdx.x; asm volatile("" : "+s"(G_), "+s"(bid_));
    C.G = G_; C.bid = bid_; C.gw = C.bid * NWAVES + C.wave; C.NGW = C.G * NWAVES;
    asm volatile("; STEP_BEGIN %0" :: "n"(STEP));
    const int i = l >> 1; const bool even = !(l & 1);
    const size_t swl = WS_SMALLW + (size_t)l * SW_LAYER;
    if constexpr (STEP == 99) phase_init(C, a);
    if constexpr (STEP == 0) phase_convert(C, a, l);
    if constexpr (STEP == 1) { phase_convert(C, a, l); __syncthreads();
        pg8::Gemm g{l == 0 ? WSP(bf16_t, WS_HS) : WSP(bf16_t, WS_XF), WSP(bf16_t, swl), l == 0 ? DM : 2048, DM}; pg8::StaticOrder S; S.init(NTOK, even ? 2048 : 2304, C.G, C.bid);
        EpiWin E{C.ws, even ? 1 : 0, a.mla_g_qa + i * 256, a.mla_g_kva + i * 128}; pg8::gemm_phase<EpiWin, pg8::StaticOrder, true>(C.lds, g, S, E, C.tid); }
    if constexpr (STEP == 3) {
        { pg8::Gemm g{WSP(bf16_t, A_X1), WSP(bf16_t, swl + SW_WQB), 256, 256}; pg8::StaticOrder S; S.init(NTOK, 768, C.G, C.bid);
          EpiMlaQ E{C.ws}; pg8::gemm_phase<EpiMlaQ, pg8::StaticOrder, true>(C.lds, g, S, E, C.tid); }
        { int lane3; asm volatile("v_mbcnt_lo_u32_b32 %0, -1, 0\n\tv_mbcnt_hi_u32_b32 %0, -1, %0" : "=v"(lane3)); int tid3 = C.wave * 64 + lane3; asm volatile("" : "+v"(tid3)); unsigned char* ws3 = C.ws; asm volatile("" : "+s"(ws3));
          pg8::Gemm g{(bf16_t*)(ws3 + A_X1 + 16 * MiB), (bf16_t*)(ws3 + swl + SW_WKVB), 256, 256}; pg8::StaticOrder S; S.init(NTOK, 1024, C.G, C.bid);
          EpiMlaKV E{ws3}; pg8::gemm_phase<EpiMlaKV, pg8::StaticOrder, true>(C.lds, g, S, E, tid3); } }
    if constexpr (STEP == 5) { if (even) phase_attn_even(C); else phase_attn_odd(C, a, i, l); }
#ifdef PROBE_X
    if constexpr (STEP == 42) { pg8::Gemm g{WSP(bf16_t, A_OB), WSP(bf16_t, swl + SW_WOUT), DM, DM}; pg8::StaticOrder S; S.init(NTOK, DM, C.G, C.bid);
        pg8::EpiResid E{l == 0 ? a.x : WSP(float, WS_XF), WSP(float, A_HB + 2 * MiB), DN_ALPHA, l == 0 ? 0 : 1}; pg8::gemm_phase<pg8::EpiResid, pg8::StaticOrder, true>(C.lds, g, S, E, C.tid); }
    if constexpr (STEP == 43) phase_ln1<true>(C, a, l);
    if constexpr (STEP == 44) { moe_tables(C, l);
        const LAS int* tst = (const LAS int*)(C.lds + LX_TST);
        MoeOrder<false> S{(const LAS int*)(C.lds + LX_CNT), tst, (const LAS unsigned char*)(C.lds + LX_TEXP), WSP(int, WS_ROWTOK), __builtin_amdgcn_readfirstlane(tst[64]), 128, 4, C.G, C.bid, 0};
        pg8::Gemm g{WSP(bf16_t, WS_HS), WSP(bf16_t, WS_WD), DE, DE}; EpiDownAllT<true> E{C.ws};
        pg8::gemm_phase<EpiDownAllT<true>, MoeOrder<false>, true>(C.lds, g, S, E, C.tid); }
    if constexpr (STEP == 45) { moe_tables(C, l); phase_combine_ln2<true>(C, a, l); }
    if constexpr (STEP == 46) phase_route(C, a, l, C.bid * (NTOK / C.G), NTOK / C.G);
#endif
#ifdef WIN_PLAIN
    if constexpr (STEP == 41) { pg8::Gemm g{WSP(bf16_t, WS_HS), WSP(bf16_t, swl), DM, DM}; pg8::StaticOrder S; S.init(NTOK, even ? 2048 : 2304, C.G, C.bid);
        pg8::EpiBf16 E{WSP(bf16_t, A_HB + 2 * MiB), 2048}; pg8::gemm_phase<pg8::EpiBf16, pg8::StaticOrder, WIN_PLAIN_ALIGN>(WIN_PLAIN_LDS, g, S, E, C.tid); }
#endif
#ifdef ATT_ABL
    if constexpr (STEP == 40) { if (even) phase_attn_even<ATT_ABL>(C); else phase_attn_odd<ATT_ABL>(C, a, i, l); }
#endif
    if constexpr (STEP == 7) { pg8::Gemm g{WSP(bf16_t, A_OB), WSP(bf16_t, swl + SW_WOUT), DM, DM}; pg8::StaticOrder S; S.init(NTOK, DM, C.G, C.bid);
        pg8::EpiResid E{l == 0 ? a.x : WSP(float, WS_XF), WSP(float, A_Y), DN_ALPHA, l == 0 ? 0 : 1}; pg8::gemm_phase<pg8::EpiResid, pg8::StaticOrder, true>(C.lds, g, S, E, C.tid); }
    if constexpr (STEP == 8) phase_ln1(C, a, l);
    if constexpr (STEP == 9) {
        RouterOrder S{C.G, C.bid};
        pg8::Gemm g{WSP(bf16_t, WS_XF), WSP(bf16_t, WS_WR + (size_t)l * MiB), 2048, 1024};
        pg8::EpiF32 E{WSP(float, A_LOG), 512}; pg8::gemm_phase<pg8::EpiF32, RouterOrder, true>(C.lds, g, S, E, C.tid);
    }
    if constexpr (STEP == 10) phase_route(C, a, l, C.bid * (NTOK / C.G), NTOK / C.G);
    if constexpr (STEP == 11) { moe_tables(C, l);
        const LAS int* tst = (const LAS int*)(C.lds + LX_TST);
        MoeOrder<true> S{(const LAS int*)(C.lds + LX_CNT), tst, (const LAS unsigned char*)(C.lds + LX_TEXP), WSP(int, WS_ROWTOK), __builtin_amdgcn_readfirstlane(tst[64]), 128, 2, C.G, C.bid, SLOTS_R};
        pg8::Gemm g{WSP(bf16_t, WS_XF), WSP(bf16_t, WS_WGU), 2048, DM}; pg8::EpiSwiGLU E{WSP(bf16_t, WS_HS)};
        pg8::gemm_phase<pg8::EpiSwiGLU, MoeOrder<true>, true>(C.lds, g, S, E, C.tid); }
    if constexpr (STEP == 12) { moe_tables(C, l);
        const LAS int* tst = (const LAS int*)(C.lds + LX_TST);
        MoeOrder<false> S{(const LAS int*)(C.lds + LX_CNT), tst, (const LAS unsigned char*)(C.lds + LX_TEXP), WSP(int, WS_ROWTOK), __builtin_amdgcn_readfirstlane(tst[64]), 128, 4, C.G, C.bid, 0};
        pg8::Gemm g{WSP(bf16_t, WS_HS), WSP(bf16_t, WS_WD), DE, DE}; EpiDownAll E{C.ws};
        pg8::gemm_phase<EpiDownAll, MoeOrder<false>, true>(C.lds, g, S, E, C.tid); }
    if constexpr (STEP == 14) { moe_tables(C, l); phase_combine_ln2(C, a, l); }
}
__global__ void __launch_bounds__(NTHREADS, 2) mega_fwd(Args a) {
    extern __shared__ __attribute__((aligned(16))) unsigned char lds_raw[];
    LAS unsigned char* lds = (LAS unsigned char*)lds_raw;
    const CAS Args* ka = (const CAS Args*)__builtin_amdgcn_kernarg_segment_ptr();
    const int wv = __builtin_amdgcn_readfirstlane(threadIdx.x >> 6);
    if (threadIdx.x < 4) ((LAS unsigned*)(lds + LX_BAR))[threadIdx.x] = 0u;
    __syncthreads();
    unsigned* barw = (unsigned*)(a.ws + WS_CTL) + CW_BAR;
    XcdBarrier bar; bar.bar = barw; bar.x = 0; bar.st = nullptr;
    if (a.use_bar) bar = xcd_barrier_post(barw, (volatile LAS unsigned*)(lds + LX_BAR));
    int step = 0;
#ifndef DUP_MASK
#define DUP_MASK 0u
#endif
#define BARRIER_NOW() do { XcdBarrier b2 = bar; asm volatile("" : "+s"(b2.bar)); int w2 = wv; asm volatile("" : "+s"(w2)); int l2_; asm volatile("v_mbcnt_lo_u32_b32 %0, -1, 0\n\tv_mbcnt_hi_u32_b32 %0, -1, %0" : "=v"(l2_)); xcd_barrier(b2, w2 == 0 && l2_ == 0); } while (0)
#define RUN(K, cond) do { if (step >= a.st_lo && step < a.st_hi) { if (cond) { const CAS Args* kp = ka; asm volatile("" : "+s"(kp)); step_fn<K>(kp, lds, l, wv); \
        if constexpr (K < 32 && ((DUP_MASK >> (K & 31)) & 1u)) { BARRIER_NOW(); const CAS Args* kp2 = ka; asm volatile("" : "+s"(kp2)); step_fn<K>(kp2, lds, l, wv); } if (a.use_bar && step + 1 < a.st_hi) BARRIER_NOW(); } } ++step; } while (0)
    { const int l = 0; RUN(99, true); }
#pragma unroll 1
    for (int l = 0; l < DEPTH; ++l) {
        const bool even = !(l & 1);
        RUN(0, false); RUN(1, true);
#ifdef WIN_PLAIN
        --step; RUN(41, true);
#endif
#ifdef EXTRA_BAR
        for (int xb = 0; xb < EXTRA_BAR; ++xb) BARRIER_NOW();
#endif
 RUN(2, false); RUN(3, even); RUN(4, false); RUN(5, true);
#ifdef ATT_ABL
        --step; RUN(40, true);
#endif
        RUN(6, false);
#if defined(PROBE_X) && PROBE_X == 42
        RUN(42, true); --step;
#endif
        RUN(7, true);
#if defined(PROBE_X) && PROBE_X == 43
        RUN(43, true); --step;
#endif
        RUN(8, true); RUN(9, true); RUN(10, true); RUN(11, true);
#if defined(PROBE_X) && PROBE_X == 44
        RUN(44, true); --step;
#endif
        RUN(12, true); RUN(13, false);
#if defined(PROBE_X) && PROBE_X == 45
        RUN(45, true); --step;
#endif
        RUN(14, true);
    }
#undef RUN
}

extern "C" void kernel_launch(void* const* d_in, const int* in_sizes, int n_in, void* d_out, int out_size, void* d_ws, size_t ws_size, hipStream_t stream) {
    static int grid = 0;
    if (grid == 0) {
        if (n_in != 23 || out_size != NTOK * DM || ws_size < WS_END) { fprintf(stderr, "kernel_launch: unexpected problem shape (n_in %d out %d ws %zu)\n", n_in, out_size, ws_size); grid = -1; return; }
        int dev = 0, cus = 0;
        if (hipGetDevice(&dev) != hipSuccess || hipDeviceGetAttribute(&cus, hipDeviceAttributeMultiprocessorCount, dev) != hipSuccess) { grid = -1; return; }
        if (hipFuncSetAttribute((const void*)mega_fwd, hipFuncAttributeMaxDynamicSharedMemorySize, LDS_BYTES) != hipSuccess) { fprintf(stderr, "kernel_launch: hipFuncSetAttribute failed\n"); grid = -1; return; }
        int per_cu = 0;
        if (hipOccupancyMaxActiveBlocksPerMultiprocessor(&per_cu, (const void*)mega_fwd, NTHREADS, LDS_BYTES) != hipSuccess || per_cu < 1) { fprintf(stderr, "kernel_launch: occupancy query says %d\n", per_cu); }
        (void)hipGetLastError();
        grid = cus;
    }
    if (grid < 0) return;
    if (hipMemsetAsync((char*)d_ws + WS_CTL, 0, CTL_ZERO_BYTES, stream) != hipSuccess) return;
    Args a{};
    a.x = (const float*)d_in[0]; a.pos = (const int*)d_in[1];
    a.ev_w_in = (const float*)d_in[2]; a.ev_w_out = (const float*)d_in[3]; a.mla_g_qa = (const float*)d_in[4]; a.mla_w_qb = (const float*)d_in[5]; a.mla_g_kva = (const float*)d_in[6]; a.mla_w_kvb = (const float*)d_in[7];
    a.od_w_in = (const float*)d_in[8]; a.od_w_out = (const float*)d_in[9]; a.swa_sinks = (const float*)d_in[10]; a.diff_lambda = (const float*)d_in[11]; a.diff_g_subln = (const float*)d_in[12];
    a.ln_g = (const float*)d_in[13]; a.ln_b = (const float*)d_in[14]; a.moe_w_router = (const float*)d_in[15]; a.moe_bias = (const float*)d_in[16];
    a.moe_w_gate = (const float*)d_in[17]; a.moe_w_up = (const float*)d_in[18]; a.moe_w_down = (const float*)d_in[19]; a.sh_w_gate = (const float*)d_in[20]; a.sh_w_up = (const float*)d_in[21]; a.sh_w_down = (const float*)d_in[22];
    a.out = (float*)d_out; a.ws = (unsigned char*)d_ws;
#ifndef MK_ONE_LAUNCH
#define MK_ONE_LAUNCH 1
#endif
    if (MK_ONE_LAUNCH) {
        a.st_lo = 0; a.st_hi = NSTEPS; a.use_bar = 1;
        hipLaunchKernelGGL(mega_fwd, dim3(grid), dim3(NTHREADS), LDS_BYTES, stream, a);
    } else {
        for (int s = 0; s < NSTEPS; ++s) {
            if (s > 0) { const int ls = (s - 1) % STEPS_PER_LAYER, l = (s - 1) / STEPS_PER_LAYER; const bool even = !(l & 1);
                if (ls == 0 || ls == 2 || ls == 4 || ls == 6 || ls == 13) continue; if (!even && ls == 3) continue; }
            a.st_lo = s; a.st_hi = s + 1; a.use_bar = 0;
            hipLaunchKernelGGL(mega_fwd, dim3(grid), dim3(NTHREADS), LDS_BYTES, stream, a);
        }
    }
}
```
